# Optimizing an MI355X kernel written in HIP

```python
import jax, jax.numpy as jnp
from jax import lax
import numpy as np

D_MODEL = 1024
BATCH = 8
SEQ = 4096
DEPTH = 1

CTX_LEN = 256
GRID_W = 64
RWKV_HEADS = 8
RWKV_HEAD_DIM = 64
RWKV_WIDTH = RWKV_HEADS * RWKV_HEAD_DIM
RWKV_W_RANK = 64
RWKV_A_RANK = 64
RWKV_G_RANK = 128
LNX_EPS = 64e-5
LRU_BLOCKS = 8
LRU_BLOCK_DIM = 64
LRU_WIDTH = LRU_BLOCKS * LRU_BLOCK_DIM
CONV_W = 4
LRU_C = 8.0
N_EXPERTS = 16
EC_CAPACITY = 2
D_EXPERT = 1024
N_DIR = 2
RMS_EPS = 1e-6
RWKV_COLS = 3 * RWKV_WIDTH + RWKV_W_RANK + RWKV_A_RANK + RWKV_G_RANK
LRU_COLS = 2 * LRU_WIDTH
GATE_COLS = 2 * D_MODEL
IN_COLS = RWKV_COLS + LRU_COLS + GATE_COLS

kernel_name = 'hybrid_rwkv7_rglru_ec_moe_dit'


def rms_norm(x, g):
    xf = x.astype(jnp.float32)
    y = xf * lax.rsqrt(jnp.mean(xf * xf, axis=-1, keepdims=True) + RMS_EPS)
    return (y * g.astype(jnp.float32)).astype(x.dtype)


def modulate(h, shift, scale):
    return h * (1.0 + scale) + shift


def in_dir(z, d):
    return z if d == 0 else jnp.flip(z, axis=1)


def to_col_major(z):
    b, l, ch = z.shape
    rows = l // GRID_W
    return z.reshape(b, rows, GRID_W, ch).transpose(0, 2, 1, 3).reshape(b, l, ch)


def to_raster(z):
    b, l, ch = z.shape
    rows = l // GRID_W
    return z.reshape(b, GRID_W, rows, ch).transpose(0, 2, 1, 3).reshape(b, l, ch)


def centred_shift_mix(p, mu):
    pad = jnp.pad(p, ((0, 0), (1, 1), (0, 0)))
    nb = 0.5 * (pad[:, :-2] + pad[:, 2:])
    return p + mu * (nb - p)


def rwkv7_shared(p, lp):
    b, t, _ = p.shape
    splits = [RWKV_WIDTH, 2 * RWKV_WIDTH, 3 * RWKV_WIDTH,
              3 * RWKV_WIDTH + RWKV_W_RANK, 3 * RWKV_WIDTH + RWKV_W_RANK + RWKV_A_RANK]
    r, k, v, wd, ad, gd = jnp.split(p, splits, axis=-1)
    heads = lambda z: z.reshape(b, t, RWKV_HEADS, RWKV_HEAD_DIM)
    kk = heads((k * lp['k_k']).astype(jnp.float32))
    kk = kk / jnp.maximum(jnp.sqrt(jnp.sum(kk * kk, axis=-1, keepdims=True)), 1e-12)
    g = jax.nn.sigmoid(gd) @ lp['g2']
    return {'r': heads(r), 'k': k, 'v': heads(v), 'kk': kk,
            'wd': jnp.tanh(wd), 'ad': ad, 'g': g}


def rwkv7_direction_inputs(f, lp, d):
    b, t, _ = f['k'].shape
    heads = lambda z: z.reshape(b, t, RWKV_HEADS, RWKV_HEAD_DIM)
    w = -jax.nn.softplus(-(lp['w0'][d] + f['wd'] @ lp['w2'][d])) - 0.5
    decay = jnp.exp(-jnp.exp(w.astype(jnp.float32)))
    a = jax.nn.sigmoid(lp['a0'][d] + f['ad'] @ lp['a2'][d])
    k = f['k'] * (1.0 + (a - 1.0) * lp['k_a'])
    return (f['r'], heads(decay), heads(k), f['v'], f['kk'], heads(a))


def rwkv7_scan(inputs, s0):
    def step(s, inp):
        r_t, w_t, k_t, v_t, kk_t, a_t = inp
        sa = jnp.einsum('bhvk,bhk->bhv', s, -kk_t)
        s = (s * w_t[:, :, None, :] + sa[..., None] * (kk_t * a_t)[:, :, None, :]
             + v_t[..., None] * k_t[:, :, None, :])
        return s, jnp.einsum('bhvk,bhk->bhv', s, r_t)
    xs = tuple(jnp.moveaxis(z.astype(jnp.float32), 1, 0) for z in inputs)
    s_last, y = lax.scan(step, s0, xs)
    return jnp.moveaxis(y, 0, 1), s_last


def rwkv7_output(y, f, k_sum, lp):
    b, t = y.shape[:2]
    mean = jnp.mean(y, axis=-1, keepdims=True)
    var = jnp.mean(jnp.square(y - mean), axis=-1, keepdims=True)
    yn = ((y - mean) * lax.rsqrt(var + LNX_EPS)).reshape(b, t, RWKV_WIDTH) * lp['lnx_g'] + lp['lnx_b']
    bonus = jnp.sum(f['r'] * k_sum * lp['r_k'], axis=-1, keepdims=True) * f['v']
    o = (yn + bonus.reshape(b, t, RWKV_WIDTH)) * f['g']
    return o @ lp['w_proj_rwkv']


def rwkv7_mixer(p_ctx, p_lat, lp, need_ctx):
    f_ctx = rwkv7_shared(p_ctx, lp)
    f_lat = rwkv7_shared(p_lat, lp)
    b = p_lat.shape[0]
    y_lat, k_lat, y_ctx, k_ctx = [], [], [], []
    for d in range(N_DIR):
        in_c = rwkv7_direction_inputs(f_ctx, lp, d)
        in_l = rwkv7_direction_inputs(f_lat, lp, d)
        s0 = jnp.zeros((b, RWKV_HEADS, RWKV_HEAD_DIM, RWKV_HEAD_DIM), jnp.float32)
        yc, s_ctx = rwkv7_scan(tuple(in_dir(z, d) for z in in_c), s0)
        yl, _ = rwkv7_scan(tuple(in_dir(z, d) for z in in_l), s_ctx)
        y_lat.append(in_dir(yl, d))
        k_lat.append(in_l[2])
        if need_ctx:
            y_ctx.append(in_dir(yc, d))
            k_ctx.append(in_c[2])
    out_lat = rwkv7_output(y_lat[0] + y_lat[1], f_lat, k_lat[0] + k_lat[1], lp)
    out_ctx = rwkv7_output(y_ctx[0] + y_ctx[1], f_ctx, k_ctx[0] + k_ctx[1], lp) if need_ctx else None
    return out_lat, out_ctx


def causal_dwconv(z, w, bias):
    t = z.shape[1]
    zp = jnp.pad(z, ((0, 0), (CONV_W - 1, 0), (0, 0)))
    y = bias + w[0] * zp[:, 0:t]
    for j in range(1, CONV_W):
        y = y + w[j] * zp[:, j:j + t]
    return y


def block_diag_linear(z, w, bias):
    b, t, _ = z.shape
    y = jnp.einsum('bthi,hij->bthj', z.reshape(b, t, LRU_BLOCKS, LRU_BLOCK_DIM), w)
    return y.reshape(b, t, LRU_WIDTH) + bias


def lru_combine(left, right):
    a1, b1 = left
    a2, b2 = right
    return a1 * a2, a2 * b1 + b2


def rglru_direction(xb, lp, d, h0):
    xc = causal_dwconv(xb.astype(jnp.float32), lp['conv_w'][d], lp['conv_b'][d])
    rg = jax.nn.sigmoid(block_diag_linear(xc, lp['wa'][d], lp['ba'][d]))
    ig = jax.nn.sigmoid(block_diag_linear(xc, lp['wx'][d], lp['bx'][d]))
    log_a = -LRU_C * rg * jax.nn.softplus(-lp['lam'][d])
    a = jnp.exp(log_a)
    bt = jnp.sqrt(-jnp.expm1(2.0 * log_a)) * (ig * xc)
    bt = bt.at[:, 0].add(a[:, 0] * h0)
    _, h = lax.associative_scan(lru_combine, (a, bt), axis=1)
    return h, h[:, -1]


def rglru_mixer(xb_ctx, gb_ctx, xb_lat, gb_lat, lp, need_ctx):
    b = xb_lat.shape[0]
    xl = to_col_major(xb_lat)
    h_lat, h_ctx = [], []
    for d in range(N_DIR):
        h0 = jnp.zeros((b, LRU_WIDTH), jnp.float32)
        hc, hc_last = rglru_direction(in_dir(xb_ctx, d), lp, d, h0)
        hl, _ = rglru_direction(in_dir(xl, d), lp, d, hc_last)
        h_lat.append(in_dir(hl, d))
        if need_ctx:
            h_ctx.append(in_dir(hc, d))
    out_lat = (to_raster(h_lat[0] + h_lat[1]) * jax.nn.gelu(gb_lat)) @ lp['w_proj_lru']
    out_ctx = ((h_ctx[0] + h_ctx[1]) * jax.nn.gelu(gb_ctx)) @ lp['w_proj_lru'] if need_ctx else None
    return out_lat, out_ctx


def split_columns(p):
    o1 = RWKV_COLS
    o2 = o1 + LRU_WIDTH
    o3 = o1 + LRU_COLS
    return p[..., :o1], p[..., o1:o2], p[..., o2:o3], p[..., o3:]


def branch_merge(gates, y_a, y_b, w_out):
    g_a, g_b = jnp.split(gates, 2, axis=-1)
    return (jax.nn.sigmoid(g_a) * y_a + jax.nn.sigmoid(g_b) * y_b) @ w_out


def mixer_sublayer(u_lat, u_ctx, lp, need_ctx):
    rw_l, xb_l, gb_l, gt_l = split_columns(u_lat @ lp['w_in'])
    rw_c, xb_c, gb_c, gt_c = split_columns(u_ctx @ lp['w_in'])
    ya_l, ya_c = rwkv7_mixer(centred_shift_mix(rw_c, lp['mu']), centred_shift_mix(rw_l, lp['mu']), lp, need_ctx)
    yb_l, yb_c = rglru_mixer(xb_c, gb_c, xb_l, gb_l, lp, need_ctx)
    out_lat = branch_merge(gt_l, ya_l, yb_l, lp['w_out'])
    out_ctx = branch_merge(gt_c, ya_c, yb_c, lp['w_out']) if need_ctx else None
    return out_lat, out_ctx


def expert_choice_moe(h, lp):
    b, t, dm = h.shape
    cap = EC_CAPACITY * t // N_EXPERTS
    affinity = jax.nn.softmax((h @ lp['router']).astype(jnp.float32), axis=-1)
    gate, idx = lax.top_k(jnp.swapaxes(affinity, 1, 2), cap)
    xs = jax.vmap(lambda hb, ib: hb[ib])(h, idx)
    hid = (jax.nn.silu(jnp.einsum('becd,edf->becf', xs, lp['moe_w1']))
           * jnp.einsum('becd,edf->becf', xs, lp['moe_w3']))
    y = jnp.einsum('becf,efd->becd', hid, lp['moe_w2']) * gate[..., None].astype(h.dtype)
    return jax.vmap(lambda yb, ib: jnp.zeros((t, dm), y.dtype).at[ib.reshape(-1)].add(yb.reshape(-1, dm)))(y, idx)


def setup_inputs(seed: int = 0) -> dict:
    key = jax.random.key(seed)
    ks = iter(jax.random.split(key, 48))
    f32 = jnp.float32
    L = DEPTH
    D = D_MODEL

    def nrm(shape, scale):
        return jax.random.normal(next(ks), shape, f32) * scale

    x = nrm((BATCH, SEQ, D), 1.0)
    c = nrm((BATCH, D), 1.0)
    ctx = nrm((BATCH, CTX_LEN, D), 1.0)
    c_ctx = nrm((D,), 1.0)
    w_mod = nrm((L, D, 6 * D), 0.3 * D ** -0.5)
    b_mod = nrm((L, 6 * D), 0.02)
    norm1_g = 1.0 + nrm((L, D), 0.02)
    norm2_g = 1.0 + nrm((L, D), 0.02)
    w_in = nrm((L, D, IN_COLS), D ** -0.5)
    mu_rwkv = jax.random.uniform(next(ks), (L, RWKV_COLS), f32, 0.0, 1.0)
    rwkv_w0 = jax.random.uniform(next(ks), (L, N_DIR, RWKV_WIDTH), f32, -6.0, -1.0)
    rwkv_w2 = nrm((L, N_DIR, RWKV_W_RANK, RWKV_WIDTH), 0.1 * RWKV_W_RANK ** -0.5)
    rwkv_a0 = nrm((L, N_DIR, RWKV_WIDTH), 0.1)
    rwkv_a2 = nrm((L, N_DIR, RWKV_A_RANK, RWKV_WIDTH), 0.5 * RWKV_A_RANK ** -0.5)
    rwkv_g2 = nrm((L, RWKV_G_RANK, RWKV_WIDTH), RWKV_G_RANK ** -0.5)
    rwkv_k_k = 0.85 + nrm((L, RWKV_WIDTH), 0.02)
    rwkv_k_a = 1.0 + nrm((L, RWKV_WIDTH), 0.02)
    rwkv_r_k = nrm((L, RWKV_HEADS, RWKV_HEAD_DIM), 0.1)
    lnx_g = 1.0 + nrm((L, RWKV_WIDTH), 0.02)
    lnx_b = nrm((L, RWKV_WIDTH), 0.02)
    w_proj_rwkv = nrm((L, RWKV_WIDTH, D), RWKV_WIDTH ** -0.5)
    conv_w = nrm((L, N_DIR, CONV_W, LRU_WIDTH), CONV_W ** -0.5)
    conv_b = nrm((L, N_DIR, LRU_WIDTH), 0.02)
    lru_wa = nrm((L, N_DIR, LRU_BLOCKS, LRU_BLOCK_DIM, LRU_BLOCK_DIM), LRU_BLOCK_DIM ** -0.5)
    lru_ba = nrm((L, N_DIR, LRU_WIDTH), 0.02)
    lru_wx = nrm((L, N_DIR, LRU_BLOCKS, LRU_BLOCK_DIM, LRU_BLOCK_DIM), LRU_BLOCK_DIM ** -0.5)
    lru_bx = nrm((L, N_DIR, LRU_WIDTH), 0.02)
    a_target = jax.random.uniform(next(ks), (L, N_DIR, LRU_WIDTH), f32, 0.9, 0.999)
    p_lam = a_target ** (1.0 / LRU_C)
    lru_lam = jnp.log(p_lam) - jnp.log1p(-p_lam)
    w_proj_lru = nrm((L, LRU_WIDTH, D), LRU_WIDTH ** -0.5)
    w_out = nrm((L, D, D), D ** -0.5)
    router = nrm((L, D, N_EXPERTS), D ** -0.5)
    moe_w1 = nrm((L, N_EXPERTS, D, D_EXPERT), D ** -0.5)
    moe_w3 = nrm((L, N_EXPERTS, D, D_EXPERT), D ** -0.5)
    moe_w2 = nrm((L, N_EXPERTS, D_EXPERT, D), D_EXPERT ** -0.5)
    final_g = 1.0 + nrm((D,), 0.02)
    return {'x': x, 'c': c, 'ctx': ctx, 'c_ctx': c_ctx, 'w_mod': w_mod, 'b_mod': b_mod,
            'norm1_g': norm1_g, 'norm2_g': norm2_g, 'w_in': w_in, 'mu_rwkv': mu_rwkv,
            'rwkv_w0': rwkv_w0, 'rwkv_w2': rwkv_w2, 'rwkv_a0': rwkv_a0, 'rwkv_a2': rwkv_a2,
            'rwkv_g2': rwkv_g2, 'rwkv_k_k': rwkv_k_k, 'rwkv_k_a': rwkv_k_a, 'rwkv_r_k': rwkv_r_k,
            'lnx_g': lnx_g, 'lnx_b': lnx_b, 'w_proj_rwkv': w_proj_rwkv, 'conv_w': conv_w,
            'conv_b': conv_b, 'lru_wa': lru_wa, 'lru_ba': lru_ba, 'lru_wx': lru_wx, 'lru_bx': lru_bx,
            'lru_lam': lru_lam, 'w_proj_lru': w_proj_lru, 'w_out': w_out, 'router': router,
            'moe_w1': moe_w1, 'moe_w3': moe_w3, 'moe_w2': moe_w2, 'final_g': final_g}


def reference(x, c, ctx, c_ctx, w_mod, b_mod, norm1_g, norm2_g, w_in, mu_rwkv,
              rwkv_w0, rwkv_w2, rwkv_a0, rwkv_a2, rwkv_g2, rwkv_k_k, rwkv_k_a, rwkv_r_k,
              lnx_g, lnx_b, w_proj_rwkv, conv_w, conv_b, lru_wa, lru_ba, lru_wx, lru_bx,
              lru_lam, w_proj_lru, w_out, router, moe_w1, moe_w3, moe_w2, final_g):
    silu_c = jax.nn.silu(c)
    silu_cc = jax.nn.silu(c_ctx)
    for layer in range(DEPTH):
        need_ctx = layer + 1 < DEPTH
        m_lat = (silu_c @ w_mod[layer] + b_mod[layer])[:, None, :]
        m_ctx = (silu_cc @ w_mod[layer] + b_mod[layer])[None, None, :]
        sh1, sc1, gt1, sh2, sc2, gt2 = jnp.split(m_lat, 6, axis=-1)
        csh1, csc1, cgt1, csh2, csc2, cgt2 = jnp.split(m_ctx, 6, axis=-1)
        lp = {'w_in': w_in[layer], 'mu': mu_rwkv[layer], 'w0': rwkv_w0[layer], 'w2': rwkv_w2[layer],
              'a0': rwkv_a0[layer], 'a2': rwkv_a2[layer], 'g2': rwkv_g2[layer], 'k_k': rwkv_k_k[layer],
              'k_a': rwkv_k_a[layer], 'r_k': rwkv_r_k[layer], 'lnx_g': lnx_g[layer], 'lnx_b': lnx_b[layer],
              'w_proj_rwkv': w_proj_rwkv[layer], 'conv_w': conv_w[layer], 'conv_b': conv_b[layer],
              'wa': lru_wa[layer], 'ba': lru_ba[layer], 'wx': lru_wx[layer], 'bx': lru_bx[layer],
              'lam': lru_lam[layer], 'w_proj_lru': w_proj_lru[layer], 'w_out': w_out[layer],
              'router': router[layer], 'moe_w1': moe_w1[layer], 'moe_w3': moe_w3[layer],
              'moe_w2': moe_w2[layer]}
        u_lat = modulate(rms_norm(x, norm1_g[layer]), sh1, sc1)
        u_ctx = modulate(rms_norm(ctx, norm1_g[layer]), csh1, csc1)
        mix_lat, mix_ctx = mixer_sublayer(u_lat, u_ctx, lp, need_ctx)
        x = x + gt1 * mix_lat
        x = x + gt2 * expert_choice_moe(modulate(rms_norm(x, norm2_g[layer]), sh2, sc2), lp)
        if need_ctx:
            ctx = ctx + cgt1 * mix_ctx
            ctx = ctx + cgt2 * expert_choice_moe(modulate(rms_norm(ctx, norm2_g[layer]), csh2, csc2), lp)
    return rms_norm(x, final_g)
```

```cpp
#include <hip/hip_runtime.h>
#include <cstdio>
#include <cstdint>

typedef unsigned short bf16_t;
typedef short bf16x8 __attribute__((ext_vector_type(8)));
typedef float f32x4 __attribute__((ext_vector_type(4)));
typedef unsigned u32x4 __attribute__((ext_vector_type(4)));
typedef unsigned u32x2 __attribute__((ext_vector_type(2)));
typedef float f32x2_ __attribute__((ext_vector_type(2)));

constexpr int D = 1024, NB = 8, T = 4096, TC = 256, GW = 64;
constexpr int NLAT = NB * T, NCTX = NB * TC, NTOK = NLAT + NCTX;
constexpr int RH = 8, RN = 64, RWD = 512, RWR = 64, RAR = 64, RGR = 128;
constexpr int RW_COLS = 3 * RWD + RWR + RAR + RGR;
constexpr int LWD = 512;
constexpr int IN_COLS = RW_COLS + 2 * LWD + 2 * D;
constexpr int NE = 16, CAP = 512, DE = 1024;
constexpr float RMS_EPS = 1e-6f, LNX_EPS = 64e-5f;
constexpr int NSLOT = NB * NE * CAP;

constexpr size_t MiB = 1u << 20;
constexpr size_t WS_CTL = 0;
constexpr size_t WS_MOD = 1 * MiB;
constexpr size_t WS_WIN = 2 * MiB;
constexpr size_t WS_WPR = 12 * MiB;
constexpr size_t WS_WPL = 13 * MiB;
constexpr size_t WS_WOUT = 14 * MiB;
constexpr size_t WS_GT = 16 * MiB;
constexpr size_t WS_XMID = 16 * MiB;
constexpr size_t WS_U = 144 * MiB;
constexpr size_t WS_Y = 144 * MiB;
constexpr size_t WS_RW = 212 * MiB;
constexpr size_t WS_MERGED = 212 * MiB;
constexpr size_t WS_XB = 331 * MiB;
constexpr size_t WS_GB = 365 * MiB;
constexpr size_t WS_H = 397 * MiB;
constexpr size_t WS_O = 461 * MiB;
constexpr size_t WS_TAB = 496 * MiB;
constexpr size_t WS_W2 = 144 * MiB;
constexpr size_t WS_W13 = 176 * MiB;
constexpr size_t WS_XS = 240 * MiB;
constexpr size_t WS_H2 = 240 * MiB;
constexpr size_t WS_HID = 368 * MiB;
constexpr size_t WS_YE = 176 * MiB;
constexpr size_t WS_END = 512 * MiB;
constexpr size_t TAB_AFF = WS_TAB;
constexpr size_t TAB_IDX = WS_TAB + 2 * MiB;
constexpr size_t TAB_GATE = WS_TAB + 3 * MiB;
constexpr size_t TAB_SLOT = WS_TAB + 4 * MiB;
constexpr size_t TAB_RSTD = WS_TAB + 6 * MiB;
constexpr size_t TAB_SIDE = WS_TAB + 8 * MiB;
constexpr size_t TAB_SSQ = WS_TAB + 8 * MiB;

__device__ __forceinline__ unsigned f2bf(float f) { return (unsigned)__builtin_bit_cast(unsigned short, (__bf16)f); }
typedef float f32x2_t_ __attribute__((ext_vector_type(2))); typedef __bf16 bf16x2_t_ __attribute__((ext_vector_type(2)));
__device__ __forceinline__ unsigned pk2(float lo, float hi) { const f32x2_t_ v = {lo, hi}; const bf16x2_t_ b = __builtin_convertvector(v, bf16x2_t_); return __builtin_bit_cast(unsigned, b); }
__device__ __forceinline__ float bf2f(bf16_t b) { return __builtin_bit_cast(float, ((unsigned)b) << 16); }
__device__ __forceinline__ float softplusf_(float x) { return fmaxf(x, 0.f) + log1pf(__expf(-fabsf(x))); }
__device__ __forceinline__ float siluf_(float x) { return x / (1.f + __expf(-x)); }
__device__ __forceinline__ float fsigmoid(float x) { return __builtin_amdgcn_rcpf(1.f + __builtin_amdgcn_exp2f(-1.4426950408889634f * x)); }
__device__ __forceinline__ float fgelu_tanh(float x) { return x * fsigmoid(1.5957691216057308f * (x + 0.044715f * x * x * x)); }
__device__ __forceinline__ float fsilu(float x) { return x * fsigmoid(x); }
__device__ __forceinline__ float wave_sum(float v) {
#pragma unroll
    for (int o = 1; o < 64; o <<= 1) v += __shfl_xor(v, o);
    return v;
}
constexpr size_t WS_W2T = WS_MOD + 256 * 1024, WS_A2T = WS_MOD + 384 * 1024, WS_WAT = WS_MOD + 512 * 1024, WS_WXT = WS_MOD + 640 * 1024, WS_G2T = WS_MOD + 768 * 1024;
constexpr size_t WS_HL = WS_XB;


__device__ __forceinline__ void st_bf16x4(bf16_t* p, f32x4 v) { u32x2 w; w.x = pk2(v.x, v.y); w.y = pk2(v.z, v.w); *(u32x2*)p = w; }
__device__ __forceinline__ f32x4 ld_bf16x4(const bf16_t* p) { const u32x2 w = *(const u32x2*)p; return (f32x4){__builtin_bit_cast(float, w.x << 16), __builtin_bit_cast(float, w.x & 0xffff0000u), __builtin_bit_cast(float, w.y << 16), __builtin_bit_cast(float, w.y & 0xffff0000u)}; }
namespace pg8 {
#define PG8_LAS __attribute__((address_space(3)))
constexpr int BM = 256, BK = 64, HALF = 128, HTB = HALF * BK * 2, STAGE_BYTES = 8 * HTB, NXCD = 8, WGM = 8;
__host__ __device__ __forceinline__ int lds_byte(int r, int c) { const int st = (r >> 4) * 2 + (c >> 5), rr = r & 15, cc = c & 31, ob = rr * 64 + cc * 2; return st * 1024 + (ob ^ (((ob >> 9) & 1) << 5)); }
__host__ __device__ __forceinline__ void stage_rc(int b, int& R, int& C) { const int st = b / 1024, sb = b % 1024, swz = sb ^ (((sb >> 9) & 1) << 5); R = (st >> 1) * 16 + swz / 64; C = (st & 1) * 32 + (swz % 64) / 2; }
__host__ __device__ __forceinline__ int perm32(int rho) { const int n = rho >> 4, i = rho & 15; return 8 * (i >> 2) + 4 * n + (i & 3); }
struct Unit { int pm, pn, aux; };
__device__ __forceinline__ void grid_order(int L, int nM, int nN, int& pm, int& pn) {
    const int nwg = nM * nN; int wgid = L; { const int q = nwg / NXCD, r = nwg % NXCD, xcd = wgid % NXCD, off = wgid / NXCD; wgid = (xcd < r ? xcd * (q + 1) : r * (q + 1) + (xcd - r) * q) + off; }
    const int nig = WGM * nN, gid = wgid / nig, fm = gid * WGM, gsz = (nM - fm) < WGM ? (nM - fm) : WGM;
    pm = fm + ((wgid % nig) % gsz); pn = (wgid % nig) / gsz;
}

template <class Epi, class Sched, bool ALIGN_EPI = true>
__device__ __forceinline__ void gemm_phase(PG8_LAS unsigned char* lds, const int K, const Sched& S, const Epi& E) {
    int tid = threadIdx.x; asm volatile("" : "+v"(tid));
    const int wid = __builtin_amdgcn_readfirstlane(tid >> 6), lane = tid & 63, wr = wid >> 2, wc = wid & 3, fr = lane & 15, fq = lane >> 4;
    const int nt = K / BK;
    unsigned voffB[2]; int RA[2]; unsigned CA[2];
#pragma unroll
    for (int i = 0; i < 2; ++i) { int R, C; stage_rc(tid * 16 + i * 8192, R, C); const int Rb = Epi::PERM ? ((R & ~31) + perm32(R & 31)) : R;
        RA[i] = R; CA[i] = (unsigned)C * 2u; voffB[i] = (unsigned)(Rb * K + C) * 2u; }
    unsigned vc[2][2], vn[2][2];
#define PG8_AOFF(dst, u) do { _Pragma("unroll") for (int _h = 0; _h < 2; ++_h) _Pragma("unroll") for (int _i = 0; _i < 2; ++_i) dst[_h][_i] = S.a_rowoff(u, _h * HALF + RA[_i], K) + CA[_i]; } while (0)
#define PG8_SEL(h) { last ? vn[h][0] : vc[h][0], last ? vn[h][1] : vc[h][1] }
    const size_t kstep = (size_t)(BK * 2);
    const size_t hstep = (size_t)HALF * K * 2;
    const unsigned ldsw = (unsigned)wid * 1024u;
    const int aoff = lds_byte(wr * 64 + fr, fq * 8), boff = lds_byte(wc * 32 + fr, fq * 8);
#define PG8_SA(b, h) (((b) * 2 + (h)) * HTB)
#define PG8_SB(b, h) ((4 + (b) * 2 + (h)) * HTB)
#define PG8_STAGE(bufoff, gbase, voff) do { _Pragma("unroll") for (int _i = 0; _i < 2; ++_i) \
        __builtin_amdgcn_global_load_lds((const unsigned*)((const char*)(gbase) + (voff)[_i]), (PG8_LAS unsigned*)(lds + (bufoff) + ldsw + _i * 8192), 16, 0, 0); } while (0)
#define PG8_LDA(dst, b, h) do { _Pragma("unroll") for (int m = 0; m < 4; ++m) _Pragma("unroll") for (int k = 0; k < 2; ++k) dst[m][k] = *(const PG8_LAS bf16x8*)(lds + PG8_SA(b, h) + aoff + m * 2048 + k * 1024); } while (0)
#define PG8_LDB(dst, b, h) do { _Pragma("unroll") for (int n = 0; n < 2; ++n) _Pragma("unroll") for (int k = 0; k < 2; ++k) dst[n][k] = *(const PG8_LAS bf16x8*)(lds + PG8_SB(b, h) + boff + n * 2048 + k * 1024); } while (0)
#define PG8_MMA(ai, bj, At, Bt) do { __builtin_amdgcn_s_setprio(1); _Pragma("unroll") for (int m = 0; m < 4; ++m) _Pragma("unroll") for (int n = 0; n < 2; ++n) _Pragma("unroll") for (int k = 0; k < 2; ++k) \
        acc[ai][bj][m][n] = __builtin_amdgcn_mfma_f32_16x16x32_bf16(Bt[n][k], At[m][k], acc[ai][bj][m][n], 0, 0, 0); __builtin_amdgcn_s_setprio(0); } while (0)
#define PG8_WAIT_V(n) asm volatile("s_waitcnt vmcnt(" #n ")" ::: "memory")
#define PG8_WAIT_L(n) asm volatile("s_waitcnt lgkmcnt(" #n ")" ::: "memory")
#define PG8_BAR __builtin_amdgcn_s_barrier()
#define PG8_SCHED __builtin_amdgcn_sched_barrier(0)
    Unit cur, nxt; int ui = 0;
    if (!S.next(0, cur)) return;
    f32x4 acc[2][2][4][2];
#pragma unroll
    for (int a = 0; a < 2; ++a)
#pragma unroll
        for (int b = 0; b < 2; ++b)
#pragma unroll
            for (int m = 0; m < 4; ++m)
#pragma unroll
                for (int n = 0; n < 2; ++n) acc[a][b][m][n] = (f32x4){0.f, 0.f, 0.f, 0.f};
    bf16x8 At[4][2], B0[2][2], B1[2][2];
    const char* cA = S.a_base(cur); const char* cB = S.b_base(cur);
    PG8_AOFF(vc, cur);
    PG8_STAGE(PG8_SB(0, 0), cB, voffB); PG8_STAGE(PG8_SB(0, 1), cB + hstep, voffB); PG8_STAGE(PG8_SA(0, 0), cA, vc[0]); PG8_STAGE(PG8_SA(0, 1), cA, vc[1]);
    if (wr == 1) PG8_BAR;
    PG8_WAIT_V(2); PG8_BAR;
    PG8_STAGE(PG8_SB(1, 0), cB + kstep, voffB); PG8_STAGE(PG8_SA(1, 0), cA + kstep, vc[0]); PG8_STAGE(PG8_SB(1, 1), cB + hstep + kstep, voffB);
    PG8_WAIT_V(6); PG8_BAR;
    for (;;) {
        const bool has_next = S.next(ui + 1, nxt);
        const char* nA = has_next ? S.a_base(nxt) : cA; const char* nB = has_next ? S.b_base(nxt) : cB;
        if (has_next) PG8_AOFF(vn, nxt); else { vn[0][0] = vc[0][0]; vn[0][1] = vc[0][1]; vn[1][0] = vc[1][0]; vn[1][1] = vc[1][1]; }
        for (int t = 0; t < nt; t += 2) {
            const bool last = (t == nt - 2);
            const char* a1 = cA + (size_t)(t + 1) * kstep;
            const char* a2 = last ? nA : cA + (size_t)(t + 2) * kstep; const char* b2 = last ? nB : cB + (size_t)(t + 2) * kstep;
            const char* a3 = a2 + kstep; const char* b3 = b2 + kstep;
            PG8_LDB(B0, 0, 0); PG8_LDB(B1, 0, 1); PG8_SCHED; PG8_LDA(At, 0, 0); PG8_STAGE(PG8_SA(1, 1), a1, vc[1]);
            PG8_WAIT_V(8); PG8_WAIT_L(0); PG8_BAR; PG8_MMA(0, 0, At, B0); PG8_MMA(0, 1, At, B1); PG8_BAR; PG8_SCHED;
            PG8_LDA(At, 0, 1); PG8_STAGE(PG8_SB(0, 0), b2, voffB); PG8_STAGE(PG8_SB(0, 1), b2 + hstep, voffB); { const unsigned vs[2] = PG8_SEL(0); PG8_STAGE(PG8_SA(0, 0), a2, vs); }
            PG8_WAIT_V(8); PG8_WAIT_L(0); PG8_BAR; PG8_MMA(1, 0, At, B0); PG8_MMA(1, 1, At, B1); PG8_BAR; PG8_SCHED;
            PG8_LDB(B0, 1, 0); PG8_LDB(B1, 1, 1); PG8_SCHED; PG8_LDA(At, 1, 0); { const unsigned vs[2] = PG8_SEL(1); PG8_STAGE(PG8_SA(0, 1), a2, vs); }
            PG8_WAIT_V(8); PG8_WAIT_L(0); PG8_BAR; PG8_MMA(0, 0, At, B0); PG8_MMA(0, 1, At, B1); PG8_BAR; PG8_SCHED;
            PG8_LDA(At, 1, 1); PG8_STAGE(PG8_SB(1, 0), b3, voffB); PG8_STAGE(PG8_SB(1, 1), b3 + hstep, voffB); { const unsigned vs[2] = PG8_SEL(0); PG8_STAGE(PG8_SA(1, 0), a3, vs); }
            PG8_WAIT_V(8); PG8_WAIT_L(0); PG8_BAR; PG8_MMA(1, 0, At, B0); PG8_MMA(1, 1, At, B1); PG8_BAR; PG8_SCHED;
        }
        if constexpr (ALIGN_EPI) { if (wr == 0) PG8_BAR; }
        E(acc, cur, wr, wc, fr, fq);
        if (!has_next) break;
#pragma unroll
        for (int a = 0; a < 2; ++a)
#pragma unroll
            for (int b = 0; b < 2; ++b)
#pragma unroll
                for (int m = 0; m < 4; ++m)
#pragma unroll
                    for (int n = 0; n < 2; ++n) acc[a][b][m][n] = (f32x4){0.f, 0.f, 0.f, 0.f};
        cur = nxt; cA = nA; cB = nB; ++ui; vc[0][0] = vn[0][0]; vc[0][1] = vn[0][1]; vc[1][0] = vn[1][0]; vc[1][1] = vn[1][1];
        if constexpr (ALIGN_EPI) { if (wr == 1) PG8_BAR; }
    }
    PG8_WAIT_V(0);
    if constexpr (!ALIGN_EPI) { if (wr == 0) PG8_BAR; }
    PG8_BAR;
#undef PG8_AOFF
#undef PG8_SEL
#undef PG8_SA
#undef PG8_SB
#undef PG8_STAGE
#undef PG8_LDA
#undef PG8_LDB
#undef PG8_MMA
#undef PG8_WAIT_V
#undef PG8_WAIT_L
#undef PG8_BAR
#undef PG8_SCHED
}
}

struct SWin {
    const bf16_t* U; const bf16_t* W; int G, c;
    __device__ __forceinline__ bool next(int i, pg8::Unit& u) const { const int L = i * G + c; if (L < 128 * 19) { pg8::grid_order(L, 128, 19, u.pm, u.pn); u.aux = 0; return true; }
        const int r = L - 128 * 19; if (r >= 72) return false; u.pm = 128 + (r & 7); u.pn = r >> 3; u.aux = 0; return true; }
    __device__ __forceinline__ const char* a_base(const pg8::Unit& u) const { return (const char*)(U + (size_t)u.pm * 256 * D); }
    __device__ __forceinline__ unsigned a_rowoff(const pg8::Unit&, int r, int K) const { return (unsigned)(r * K) * 2u; }
    __device__ __forceinline__ const char* b_base(const pg8::Unit& u) const { return (const char*)(W + (size_t)u.pn * 256 * D); }
};
struct EWin {
    static constexpr bool PERM = true;
    bf16_t* RW; bf16_t* XB; bf16_t* GB; bf16_t* GT;
    __device__ __forceinline__ void operator()(const f32x4 (&acc)[2][2][4][2], const pg8::Unit& u, int wr, int wc, int fr, int fq) const {
        const int row0 = u.pm * 256 + wr * 64 + fr, colt = u.pn * 256, cl = wc * 32 + 8 * fq;
        bf16_t* base; int ldc, act;
        if (colt < 1792) { base = RW + colt; ldc = RW_COLS; act = 0; } else if (colt < 2304) { base = XB + (colt - 1792); ldc = LWD; act = 0; }
        else if (colt < 2816) { base = GB + (colt - 2304); ldc = LWD; act = 1; } else { base = GT + (colt - 2816); ldc = 2048; act = 2; }
#pragma unroll
        for (int ai = 0; ai < 2; ++ai)
#pragma unroll
            for (int m = 0; m < 4; ++m) { bf16_t* rowp = base + (size_t)(row0 + ai * 128 + m * 16) * ldc + cl;
#pragma unroll
                for (int bj = 0; bj < 2; ++bj) { f32x4 v0 = acc[ai][bj][m][0], v1 = acc[ai][bj][m][1];
                    if (act == 1) {
#pragma unroll
                        for (int j = 0; j < 4; ++j) { v0[j] = fgelu_tanh(v0[j]); v1[j] = fgelu_tanh(v1[j]); } }
                    else if (act == 2) {
#pragma unroll
                        for (int j = 0; j < 4; ++j) { v0[j] = fsigmoid(v0[j]); v1[j] = fsigmoid(v1[j]); } }
                    u32x4 w; w.x = pk2(v0[0], v0[1]); w.y = pk2(v0[2], v0[3]); w.z = pk2(v1[0], v1[1]); w.w = pk2(v1[2], v1[3]);
                    *(u32x4*)(rowp + bj * 128) = w; } }
    }
};
struct SProj {
    const bf16_t* O; const bf16_t* HL; const bf16_t* Wr; const bf16_t* Wl; int G, c;
    __device__ __forceinline__ bool next(int i, pg8::Unit& u) const { const int L = (i >> 1) * G + c; if (L >= 128 * 4) return false; pg8::grid_order(L, 128, 4, u.pm, u.pn); u.aux = i & 1; return true; }
    __device__ __forceinline__ const char* a_base(const pg8::Unit& u) const { return (const char*)((u.aux ? HL : O) + (size_t)u.pm * 256 * 512); }
    __device__ __forceinline__ unsigned a_rowoff(const pg8::Unit&, int r, int K) const { return (unsigned)(r * K) * 2u; }
    __device__ __forceinline__ const char* b_base(const pg8::Unit& u) const { return (const char*)((u.aux ? Wl : Wr) + (size_t)u.pn * 256 * 512); }
};
struct EProj {
    static constexpr bool PERM = true;
    const bf16_t* GT; bf16_t* MG;
    __device__ __forceinline__ void operator()(const f32x4 (&acc)[2][2][4][2], const pg8::Unit& u, int wr, int wc, int fr, int fq) const {
        const int row0 = u.pm * 256 + wr * 64 + fr, col0 = u.pn * 256 + wc * 32 + 8 * fq;
#pragma unroll
        for (int ai = 0; ai < 2; ++ai)
#pragma unroll
            for (int m = 0; m < 4; ++m) { const size_t r = (size_t)(row0 + ai * 128 + m * 16);
#pragma unroll
                for (int bj = 0; bj < 2; ++bj) { const int cc = col0 + bj * 128; const bf16_t* gp = GT + r * 2048 + (u.aux ? 1024 : 0) + cc; bf16_t* op = MG + r * D + cc;
                    const f32x4 g0 = ld_bf16x4(gp), g1 = ld_bf16x4(gp + 4); f32x4 v0 = g0 * acc[ai][bj][m][0], v1 = g1 * acc[ai][bj][m][1];
                    if (u.aux) { v0 += ld_bf16x4(op); v1 += ld_bf16x4(op + 4); }
                    u32x4 w; w.x = pk2(v0[0], v0[1]); w.y = pk2(v0[2], v0[3]); w.z = pk2(v1[0], v1[1]); w.w = pk2(v1[2], v1[3]);
                    *(u32x4*)op = w; } }
    }
};
struct SWout {
    const bf16_t* MG; const bf16_t* W; int G, c;
    __device__ __forceinline__ bool next(int i, pg8::Unit& u) const { const int L = i * G + c; if (L >= 128 * 4) return false; pg8::grid_order(L, 128, 4, u.pm, u.pn); u.aux = 0; return true; }
    __device__ __forceinline__ const char* a_base(const pg8::Unit& u) const { return (const char*)(MG + (size_t)u.pm * 256 * D); }
    __device__ __forceinline__ unsigned a_rowoff(const pg8::Unit&, int r, int K) const { return (unsigned)(r * K) * 2u; }
    __device__ __forceinline__ const char* b_base(const pg8::Unit& u) const { return (const char*)(W + (size_t)u.pn * 256 * D); }
};
struct EWout {
    static constexpr bool PERM = false;
    const float* x; const float* MOD; float* XMID; float* SSQ;
    __device__ __forceinline__ void operator()(const f32x4 (&acc)[2][2][4][2], const pg8::Unit& u, int wr, int wc, int fr, int fq) const {
        const int row0 = u.pm * 256 + wr * 64 + fr, col0 = u.pn * 256 + wc * 32 + 4 * fq; const float* gt1 = MOD + (size_t)(u.pm >> 4) * 6144 + 2048;
        f32x4 gv[2][2];
#pragma unroll
        for (int bj = 0; bj < 2; ++bj)
#pragma unroll
            for (int n = 0; n < 2; ++n) gv[bj][n] = *(const f32x4*)(gt1 + col0 + bj * 128 + n * 16);
#pragma unroll
        for (int ai = 0; ai < 2; ++ai)
#pragma unroll
            for (int m = 0; m < 4; ++m) { const size_t row = (size_t)(row0 + ai * 128 + m * 16), off = row * D + col0; float ss = 0.f;
#pragma unroll
                for (int bj = 0; bj < 2; ++bj)
#pragma unroll
                    for (int n = 0; n < 2; ++n) { const f32x4 v = *(const f32x4*)(x + off + bj * 128 + n * 16) + gv[bj][n] * acc[ai][bj][m][n]; *(f32x4*)(XMID + off + bj * 128 + n * 16) = v; ss += (v.x * v.x + v.y * v.y) + (v.z * v.z + v.w * v.w); }
                ss += __shfl_xor(ss, 16); ss += __shfl_xor(ss, 32);
                if (fq == 0) SSQ[row * 16 + u.pn * 4 + wc] = ss; }
    }
};
struct SMoe1 {
    const bf16_t* H2; const bf16_t* W13; const int* IDX; int G, c;
    __device__ __forceinline__ bool next(int i, pg8::Unit& u) const { const int L = i * G + c; if (L >= 256 * 8) return false; pg8::grid_order(L, 256, 8, u.pm, u.pn); u.aux = (u.pm >> 1) & 15; return true; }
    __device__ __forceinline__ const char* a_base(const pg8::Unit&) const { return (const char*)H2; }
    __device__ __forceinline__ unsigned a_rowoff(const pg8::Unit& u, int r, int K) const { return (unsigned)((u.pm >> 5) * T + IDX[u.pm * 256 + r]) * (unsigned)(K * 2); }
    __device__ __forceinline__ const char* b_base(const pg8::Unit& u) const { return (const char*)(W13 + ((size_t)u.aux * 2048 + (size_t)u.pn * 256) * D); }
};
struct EMoe1 {
    static constexpr bool PERM = true;
    bf16_t* HID;
    __device__ __forceinline__ void operator()(const f32x4 (&acc)[2][2][4][2], const pg8::Unit& u, int wr, int wc, int fr, int fq) const {
        const int row0 = u.pm * 256 + wr * 64 + fr, col0 = (u.pn * 256 + wc * 32 + 8 * fq) >> 1;
#pragma unroll
        for (int ai = 0; ai < 2; ++ai)
#pragma unroll
            for (int m = 0; m < 4; ++m) { bf16_t* rowp = HID + (size_t)(row0 + ai * 128 + m * 16) * DE + col0;
#pragma unroll
                for (int bj = 0; bj < 2; ++bj) { const f32x4 a = acc[ai][bj][m][0], b = acc[ai][bj][m][1]; u32x2 w;
                    w.x = pk2(fsilu(a[0]) * b[0], fsilu(a[1]) * b[1]); w.y = pk2(fsilu(a[2]) * b[2], fsilu(a[3]) * b[3]);
                    *(u32x2*)(rowp + bj * 64) = w; } }
    }
};
struct SMoe2 {
    const bf16_t* HID; const bf16_t* W2; int G, c;
    __device__ __forceinline__ bool next(int i, pg8::Unit& u) const { const int L = i * G + c; if (L >= 256 * 4) return false; pg8::grid_order(L, 256, 4, u.pm, u.pn); u.aux = (u.pm >> 1) & 15; return true; }
    __device__ __forceinline__ const char* a_base(const pg8::Unit& u) const { return (const char*)(HID + (size_t)u.pm * 256 * DE); }
    __device__ __forceinline__ unsigned a_rowoff(const pg8::Unit&, int r, int K) const { return (unsigned)(r * K) * 2u; }
    __device__ __forceinline__ const char* b_base(const pg8::Unit& u) const { return (const char*)(W2 + ((size_t)u.aux * D + (size_t)u.pn * 256) * DE); }
};
struct EMoe2 {
    static constexpr bool PERM = true;
    const float* GATE; bf16_t* YE;
    __device__ __forceinline__ void operator()(const f32x4 (&acc)[2][2][4][2], const pg8::Unit& u, int wr, int wc, int fr, int fq) const {
        const int row0 = u.pm * 256 + wr * 64 + fr, col0 = u.pn * 256 + wc * 32 + 8 * fq;
#pragma unroll
        for (int ai = 0; ai < 2; ++ai)
#pragma unroll
            for (int m = 0; m < 4; ++m) { const int r = row0 + ai * 128 + m * 16; const float gt = GATE[r]; bf16_t* rowp = YE + (size_t)r * D + col0;
#pragma unroll
                for (int bj = 0; bj < 2; ++bj) { const f32x4 v0 = acc[ai][bj][m][0] * gt, v1 = acc[ai][bj][m][1] * gt;
                    u32x4 w; w.x = pk2(v0[0], v0[1]); w.y = pk2(v0[2], v0[3]); w.z = pk2(v1[0], v1[1]); w.w = pk2(v1[2], v1[3]);
                    *(u32x4*)(rowp + bj * 128) = w; } }
    }
};
#ifndef PROBE
#define PROBE (-1)
#endif
#define LAS __attribute__((address_space(3)))
__device__ __forceinline__ int otid() { int t = threadIdx.x; asm volatile("" : "+v"(t)); return t; }
#define XB_TMO      128
#define XB_XCNT(j)  (256  + 64 * (j))
#define XB_XSUB(j)  (1280 + 64 * (j))
#define XB_XGEN(j)  (2304 + 64 * (j))
#define XB_TOP      3328
#define XB_TOPGEN   3392
#define XCD_BAR_WORDS 3456
#define XB_SPIN_CAP (1u << 22)
__device__ __forceinline__ unsigned xb_ld(unsigned* p)              { return __hip_atomic_load(p, __ATOMIC_RELAXED, __HIP_MEMORY_SCOPE_AGENT); }
__device__ __forceinline__ unsigned xb_add(unsigned* p, unsigned v) { return __hip_atomic_fetch_add(p, v, __ATOMIC_RELAXED, __HIP_MEMORY_SCOPE_AGENT); }
__device__ __forceinline__ unsigned xb_xcc_id() { return (unsigned)__builtin_amdgcn_s_getreg((3 << 11) | 20) & 0xFu; }
#define XB_SPIN(cond, bar) do { unsigned _sp = 0; while (cond) { __builtin_amdgcn_s_sleep(1); \
    if ((++_sp & 255u) == 0u) { if (xb_ld(&(bar)[XB_TMO])) break; if (_sp > XB_SPIN_CAP) { atomicAdd(&(bar)[XB_TMO], 1u); break; } } } } while (0)
struct XcdBarrier { unsigned* bar; unsigned x; volatile LAS unsigned* st; };
__device__ __forceinline__ XcdBarrier xcd_barrier_post(unsigned* bar, volatile LAS unsigned* st) {
    XcdBarrier b; b.bar = bar; b.x = xb_xcc_id(); b.st = st;
    if (threadIdx.x == 0) (void)xb_add(&bar[XB_XCNT(b.x)], 1u);
    return b;
}
__device__ __forceinline__ void xcd_barrier_complete(unsigned* bar, unsigned x, unsigned& nloc, unsigned& nx) {
    const unsigned G = gridDim.x * gridDim.y * gridDim.z;
    unsigned sum, cnt, mine, sp = 0u;
    for (;;) {
        sum = 0u; cnt = 0u; mine = 0u;
#pragma unroll
        for (unsigned j = 0; j < 16; ++j) { const unsigned c = xb_ld(&bar[XB_XCNT(j)]); sum += c; cnt += (c > 0u) ? 1u : 0u; mine = (j == x) ? c : mine; }
        if (sum == G) break;
        __builtin_amdgcn_s_sleep(1);
        if ((++sp & 255u) == 0u) { if (xb_ld(&bar[XB_TMO])) break; if (sp > XB_SPIN_CAP) { atomicAdd(&bar[XB_TMO], 1u); break; } }
    }
    nloc = mine > 0u ? mine : 1u; nx = cnt > 0u ? cnt : 1u;
}
__device__ __forceinline__ void xcd_barrier(const XcdBarrier& b) {
    asm volatile("s_waitcnt vmcnt(0)" ::: "memory");
    __syncthreads();
    if (threadIdx.x == 0) {
        unsigned* bar = b.bar;
        __builtin_amdgcn_s_waitcnt(0);
        unsigned nloc = b.st[0], nx = b.st[1];
        if (nloc == 0u) { xcd_barrier_complete(bar, b.x, nloc, nx); b.st[0] = nloc; b.st[1] = nx; }
        const unsigned old = xb_add(&bar[XB_XSUB(b.x)], 1u);
        const unsigned gen = old / nloc;
        if (old + 1u == (gen + 1u) * nloc) {
            __builtin_amdgcn_fence(__ATOMIC_RELEASE, "agent");
            asm volatile("s_waitcnt vmcnt(0)" ::: "memory");
            const unsigned og = xb_add(&bar[XB_TOP], 1u);
            const unsigned tg = og / nx;
            if (og + 1u == (tg + 1u) * nx) xb_add(&bar[XB_TOPGEN], 1u);
            else XB_SPIN(xb_ld(&bar[XB_TOPGEN]) == tg, bar);
            __builtin_amdgcn_fence(__ATOMIC_ACQUIRE, "agent");
            xb_add(&bar[XB_XGEN(b.x)], 1u);
            asm volatile("s_waitcnt vmcnt(0)" ::: "memory");
        } else {
            XB_SPIN(xb_ld(&bar[XB_XGEN(b.x)]) == gen, bar);
            __builtin_amdgcn_fence(__ATOMIC_ACQUIRE, "agent");
            asm volatile("s_waitcnt vmcnt(0)" ::: "memory");
        }
    }
    __syncthreads();
}

struct Args { const float* in[35]; float* out; unsigned char* ws; };

__device__ __forceinline__ void phase_modvec(const float* __restrict__ c, const float* __restrict__ c_ctx, const float* __restrict__ w_mod, const float* __restrict__ b_mod, float* __restrict__ MOD, unsigned char* lds, int bid, int nb) {
    float (*sv)[1024] = (float (*)[1024])lds; float (*red)[9][32] = (float (*)[9][32])(lds + 9 * 1024 * 4);
    const int tid = otid(), lane = tid & 63, w = tid >> 6;
    if (bid >= 192) return;
    for (int i = tid; i < 9 * 1024; i += 512) { const int r = i >> 10, k = i & 1023; const float v = r < 8 ? c[r * 1024 + k] : c_ctx[k]; sv[r][k] = siluf_(v); }
    __syncthreads();
    for (int item = bid; item < 192; item += nb) {
        const int col = item * 32 + (lane & 31), kg = w * 2 + (lane >> 5);
        float acc[9];
#pragma unroll
        for (int r = 0; r < 9; ++r) acc[r] = 0.f;
#pragma unroll 8
        for (int kk = 0; kk < 64; ++kk) { const int k = kg * 64 + kk; const float wv = w_mod[(size_t)k * 6144 + col];
#pragma unroll
            for (int r = 0; r < 9; ++r) acc[r] += sv[r][k] * wv; }
#pragma unroll
        for (int r = 0; r < 9; ++r) red[kg][r][lane & 31] = acc[r];
        __syncthreads();
        if (tid < 288) { const int r = tid >> 5, cc = tid & 31; float s = b_mod[item * 32 + cc];
#pragma unroll
            for (int g = 0; g < 16; ++g) s += red[g][r][cc];
            MOD[r * 6144 + item * 32 + cc] = s; }
        __syncthreads();
    }
}
__device__ __forceinline__ void phase_wconv(const float* __restrict__ src0, bf16_t* __restrict__ dst0, int K, int N, int rmul, int radd, int nbatch, size_t sstride, size_t dstride, unsigned char* lds, int bid, int nb) {
    const int tid = otid(), lane = tid & 63, wv = tid >> 6, gw = bid * 8 + wv, NGW = nb * 8, nkt = K / 64, nnt = N / 64, per = nkt * nnt;
    u32x4* wl = (u32x4*)(lds + wv * 9216);
    for (int it = gw; it < per * nbatch; it += NGW) {
        const int bt = it / per, r = it % per; const float* src = src0 + (size_t)bt * sstride; bf16_t* dst = dst0 + (size_t)bt * dstride;
        const int k0 = (r / nnt) * 64, n0 = (r % nnt) * 64;
        const float* sp = src + (size_t)k0 * N + n0 + lane; float v[64];
#pragma unroll
        for (int i = 0; i < 64; ++i) v[i] = sp[(size_t)i * N];
#pragma unroll
        for (int c = 0; c < 8; ++c) { u32x4 o; o.x = pk2(v[8 * c], v[8 * c + 1]); o.y = pk2(v[8 * c + 2], v[8 * c + 3]); o.z = pk2(v[8 * c + 4], v[8 * c + 5]); o.w = pk2(v[8 * c + 6], v[8 * c + 7]); wl[lane * 9 + c] = o; }
        asm volatile("s_waitcnt lgkmcnt(0)" ::: "memory");
#pragma unroll
        for (int j = 0; j < 8; ++j) { const int n = (lane >> 3) + 8 * j, c = lane & 7; const u32x4 o = wl[n * 9 + c];
            const int nn = n0 + n, row = (nn >> 2) * rmul + (nn & 3) + radd; *(u32x4*)(dst + (size_t)row * K + k0 + 8 * c) = o; }
        asm volatile("s_waitcnt lgkmcnt(0)" ::: "memory");
    }
}
__device__ __forceinline__ void phase_normmod(const float* __restrict__ x, const float* __restrict__ ctx, const float* __restrict__ g1, const float* __restrict__ MOD, bf16_t* __restrict__ U, int bid, int nb) {
    const int tid = otid(), lane = tid & 63, gw = bid * 8 + (tid >> 6), NGW = nb * 8;
    for (int r0 = gw * 4; r0 < NTOK; r0 += NGW * 4) {
        const float* src = r0 < NLAT ? x + (size_t)r0 * D : ctx + (size_t)(r0 - NLAT) * D;
        f32x4 v[4][4]; float ss[4];
#pragma unroll
        for (int q = 0; q < 4; ++q) { ss[q] = 0.f;
#pragma unroll
            for (int j = 0; j < 4; ++j) { v[q][j] = ((const f32x4*)(src + (size_t)q * D))[lane + 64 * j]; } }
#pragma unroll
        for (int q = 0; q < 4; ++q) {
#pragma unroll
            for (int j = 0; j < 4; ++j) ss[q] += (v[q][j].x * v[q][j].x + v[q][j].y * v[q][j].y) + (v[q][j].z * v[q][j].z + v[q][j].w * v[q][j].w);
            const int r = r0 + q; const float* mr = MOD + (size_t)(r < NLAT ? r / T : 8) * 6144;
            const float rstd = rsqrtf(wave_sum(ss[q]) * (1.f / D) + RMS_EPS);
#pragma unroll
            for (int j = 0; j < 4; ++j) { const f32x4 g = ((const f32x4*)g1)[lane + 64 * j], sh = ((const f32x4*)mr)[lane + 64 * j], sc = ((const f32x4*)(mr + 1024))[lane + 64 * j];
                const f32x4 o = (v[q][j] * rstd * g) * (sc + 1.f) + sh; u32x2 w; w.x = pk2(o.x, o.y); w.y = pk2(o.z, o.w);
                ((u32x2*)(U + (size_t)r * D))[lane + 64 * j] = w; } }
    }
}
template <int CTRL> __device__ __forceinline__ float dpp_mov(float x) { return __builtin_bit_cast(float, __builtin_amdgcn_update_dpp(0, __builtin_bit_cast(int, x), CTRL, 0xF, 0xF, true)); }
__device__ __forceinline__ float red16(float x) { x += dpp_mov<0xB1>(x); x += dpp_mov<0x4E>(x); x += dpp_mov<0x141>(x); x += dpp_mov<0x140>(x); return x; }
__device__ __forceinline__ float fmul_s(float a, float b) { float r; asm("v_mul_f32_e32 %0, %1, %2" : "=v"(r) : "v"(a), "v"(b)); return r; }
__device__ __forceinline__ float ffma_s(float a, float b, float c) { float r; asm("v_fma_f32 %0, %1, %2, %3" : "=v"(r) : "v"(a), "v"(b), "v"(c)); return r; }
__device__ __forceinline__ float fnma_s(float a, float b, float c) { float r; asm("v_fma_f32 %0, -%1, %2, %3" : "=v"(r) : "v"(a), "v"(b), "v"(c)); return r; }
__device__ __forceinline__ float ftanh(float x) { return 2.f * fsigmoid(2.f * x) - 1.f; }
__device__ __forceinline__ void unpack8(const u32x4 v, float (&f)[8]) {
    f[0] = __builtin_bit_cast(float, v.x << 16); f[1] = __builtin_bit_cast(float, v.x & 0xffff0000u); f[2] = __builtin_bit_cast(float, v.y << 16); f[3] = __builtin_bit_cast(float, v.y & 0xffff0000u);
    f[4] = __builtin_bit_cast(float, v.z << 16); f[5] = __builtin_bit_cast(float, v.z & 0xffff0000u); f[6] = __builtin_bit_cast(float, v.w << 16); f[7] = __builtin_bit_cast(float, v.w & 0xffff0000u); }
__device__ __forceinline__ void phase_lru_seq(const bf16_t* __restrict__ XB, bf16_t* __restrict__ H0, bf16_t* __restrict__ H1, const float* __restrict__ conv_w, const float* __restrict__ conv_b, const bf16_t* __restrict__ WAT,
                                              const float* __restrict__ ba, const bf16_t* __restrict__ WXT, const float* __restrict__ bx, const float* __restrict__ lam, unsigned char* lds, int bid, int nb) {
    const int tid = otid(), lane = tid & 63, w = __builtin_amdgcn_readfirstlane(tid >> 6), fr = lane & 15, fq = lane >> 4;
    bf16_t* RAW = (bf16_t*)(lds + w * 18944);
    bf16_t* XC = (bf16_t*)(lds + w * 18944 + 9728);
    float* CW = (float*)(lds + 151552);
    float* TOT = (float*)(lds + 152832);
    for (int item = bid; item < 256; item += nb) {
        const int b = item >> 5, g = (item >> 2) & 7, d = (item >> 1) & 1, half = item & 1;
        bf16_t* Hd = d ? H1 : H0;
        __syncthreads();
        float cwr[5][8];
#pragma unroll
        for (int k = 0; k < 5; ++k)
#pragma unroll
            for (int e = 0; e < 8; ++e) cwr[k][e] = k < 4 ? conv_w[(d * 4 + k) * 512 + g * 64 + 8 * (lane & 7) + e] : conv_b[d * 512 + g * 64 + 8 * (lane & 7) + e];
        bf16x8 waf[2][2], wxf[2][2]; float bav[2], bxv[2], spv[2], hcar[2];
#pragma unroll
        for (int mt = 0; mt < 2; ++mt) { const int co = half * 32 + 16 * mt + fr, cg = d * 512 + g * 64 + co; bav[mt] = ba[cg]; bxv[mt] = bx[cg]; spv[mt] = softplusf_(-lam[cg]); hcar[mt] = 0.f;
#pragma unroll
            for (int ks = 0; ks < 2; ++ks) { const size_t off = (((size_t)d * 8 + g) * 64 + co) * 64 + ks * 32 + fq * 8; waf[mt][ks] = *(const bf16x8*)(WAT + off); wxf[mt][ks] = *(const bf16x8*)(WXT + off); } }
        __syncthreads();
        for (int sc = 0; sc < 9; ++sc) {
            const int ch = sc * 8 + w; const bool active = ch < 68; const bool isctx = ch < 4; const int len = isctx ? TC : T; const int s0 = isctx ? ch * 64 : (ch - 4) * 64;
            float Atot[2] = {1.f, 1.f}, Btot[2] = {0.f, 0.f}, Aex[2] = {1.f, 1.f}, Bex[2] = {0.f, 0.f};
            float av[2][16], bv[2][16];
            if (active) {
                auto rowof = [&](int sseg) -> size_t { const int i = d ? len - 1 - sseg : sseg; return isctx ? (size_t)NLAT + (size_t)b * TC + i : (size_t)b * T + (size_t)((i & 63) * 64 + (i >> 6)); };
                { const int lr = lane >> 3, lc = lane & 7; const u32x4 z = {0u, 0u, 0u, 0u};
#pragma unroll
                  for (int g8 = 0; g8 < 9; ++g8) { const int rr = 8 * g8 + lr; if (rr < 67) { const int sh = s0 - 3 + rr; *(u32x4*)(RAW + rr * 72 + 8 * lc) = sh >= 0 ? *(const u32x4*)(XB + rowof(sh) * LWD + g * 64 + 8 * lc) : z; } } }
                { const int j8 = lane & 7, p0 = 8 * (lane >> 3); float win[4][8];
#pragma unroll
                  for (int q = 0; q < 3; ++q) unpack8(*(const u32x4*)(RAW + (p0 + q) * 72 + 8 * j8), win[q]);
#pragma unroll
                  for (int q = 0; q < 8; ++q) { const int s = p0 + q, rho = 16 * ((s >> 2) & 3) + 4 * (s >> 4) + (s & 3); unpack8(*(const u32x4*)(RAW + (s + 3) * 72 + 8 * j8), win[(q + 3) & 3]);
                      float o[8];
#pragma unroll
                      for (int e = 0; e < 8; ++e) o[e] = cwr[4][e] + cwr[0][e] * win[q & 3][e] + cwr[1][e] * win[(q + 1) & 3][e] + cwr[2][e] * win[(q + 2) & 3][e] + cwr[3][e] * win[(q + 3) & 3][e];
                      u32x4 pk; pk.x = pk2(o[0], o[1]); pk.y = pk2(o[2], o[3]); pk.z = pk2(o[4], o[5]); pk.w = pk2(o[6], o[7]); *(u32x4*)(XC + rho * 72 + 8 * j8) = pk; } }
                f32x4 pa[2][4], px[2][4];
#pragma unroll
                for (int mt = 0; mt < 2; ++mt)
#pragma unroll
                    for (int nt = 0; nt < 4; ++nt) { pa[mt][nt] = (f32x4){0.f, 0.f, 0.f, 0.f}; px[mt][nt] = (f32x4){0.f, 0.f, 0.f, 0.f}; }
#pragma unroll
                for (int nt = 0; nt < 4; ++nt)
#pragma unroll
                    for (int ks = 0; ks < 2; ++ks) { const bf16x8 xf = *(const bf16x8*)(XC + (16 * nt + fr) * 72 + ks * 32 + fq * 8);
#pragma unroll
                        for (int mt = 0; mt < 2; ++mt) { pa[mt][nt] = __builtin_amdgcn_mfma_f32_16x16x32_bf16(xf, waf[mt][ks], pa[mt][nt], 0, 0, 0); px[mt][nt] = __builtin_amdgcn_mfma_f32_16x16x32_bf16(xf, wxf[mt][ks], px[mt][nt], 0, 0, 0); } }
#pragma unroll
                for (int mt = 0; mt < 2; ++mt) { float A = 1.f, B = 0.f;
#pragma unroll
                    for (int nt = 0; nt < 4; ++nt)
#pragma unroll
                        for (int j = 0; j < 4; ++j) { const float xc = bf2f(XC[(16 * nt + 4 * fq + j) * 72 + half * 32 + 16 * mt + fr]);
                            const float rg = fsigmoid(pa[mt][nt][j] + bav[mt]), ig = fsigmoid(px[mt][nt][j] + bxv[mt]); const float a = __expf(-8.f * rg * spv[mt]); const float bt = sqrtf((1.f - a) * (1.f + a)) * (ig * xc);
                            av[mt][nt * 4 + j] = a; bv[mt][nt * 4 + j] = bt; B = a * B + bt; A = A * a; }
                    { const float Al = __shfl_up(A, 16), Bl = __shfl_up(B, 16); if (fq >= 1) { B = A * Bl + B; A = A * Al; } }
                    { const float Al = __shfl_up(A, 32), Bl = __shfl_up(B, 32); if (fq >= 2) { B = A * Bl + B; A = A * Al; } }
                    { const float Al = __shfl_up(A, 16), Bl = __shfl_up(B, 16); Aex[mt] = fq >= 1 ? Al : 1.f; Bex[mt] = fq >= 1 ? Bl : 0.f; }
                    Atot[mt] = __shfl(A, 48 + fr); Btot[mt] = __shfl(B, 48 + fr); }
            }
            if (fq == 3) {
#pragma unroll
                for (int mt = 0; mt < 2; ++mt) { TOT[(w * 32 + 16 * mt + fr) * 2] = Atot[mt]; TOT[(w * 32 + 16 * mt + fr) * 2 + 1] = Btot[mt]; } }
            __syncthreads();
            float hin[2];
#pragma unroll
            for (int mt = 0; mt < 2; ++mt) { float h = hcar[mt]; hin[mt] = h;
#pragma unroll
                for (int ww = 0; ww < 8; ++ww) { const float At = TOT[(ww * 32 + 16 * mt + fr) * 2], Bt = TOT[(ww * 32 + 16 * mt + fr) * 2 + 1]; h = At * h + Bt; if (ww + 1 == w) hin[mt] = h; }
                hcar[mt] = h; }
            if (active && !isctx) {
                bf16_t* OUT = RAW;
#pragma unroll
                for (int mt = 0; mt < 2; ++mt) { float h = Aex[mt] * hin[mt] + Bex[mt];
#pragma unroll
                    for (int q = 0; q < 16; ++q) { h = av[mt][q] * h + bv[mt][q]; OUT[(16 * fq + q) * 40 + 16 * mt + fr] = (bf16_t)f2bf(h); } }
#pragma unroll
                for (int j = 0; j < 4; ++j) { const int ps = 16 * j + (lane >> 2), lc = lane & 3; const int sseg = s0 + ps; const int i = d ? len - 1 - sseg : sseg; const size_t row = (size_t)b * T + (size_t)((i & 63) * 64 + (i >> 6));
                    *(u32x4*)(Hd + row * LWD + g * 64 + half * 32 + 8 * lc) = *(const u32x4*)(OUT + ps * 40 + 8 * lc); }
            }
            __syncthreads();
        }
    }
}

constexpr int NSTRIP = NTOK / 32, NCHUNK = RW_COLS / 8;
__device__ __forceinline__ void phase_mixA(const bf16_t* __restrict__ RW, bf16_t* __restrict__ SIDE, int bid, int nb) {
    const int tid = otid(), lane = tid & 63, gw = bid * 8 + (tid >> 6), NGW = nb * 8;
    for (int it = gw; it < NSTRIP * 2; it += NGW) { const int sidx = it >> 1, wh = it & 1; const u32x4* src = (const u32x4*)(RW + (size_t)(sidx * 32 + wh * 31) * RW_COLS); u32x4* dst = (u32x4*)(SIDE + (size_t)it * RW_COLS);
        for (int ch = lane; ch < NCHUNK; ch += 64) dst[ch] = src[ch]; }
}
__device__ __forceinline__ void phase_mixB(bf16_t* __restrict__ RW, const bf16_t* __restrict__ SIDE, const float* __restrict__ mu, const float* __restrict__ k_k, float* __restrict__ KN, int bid, int nb) {
    const int tid = otid();
    for (int it = bid * 512 + tid; it < NSTRIP * NCHUNK; it += nb * 512) {
        const int sidx = it / NCHUNK, ch = it - sidx * NCHUNK, r0 = sidx * 32;
        const bool first = r0 < NLAT ? (r0 & (T - 1)) == 0 : ((r0 - NLAT) & (TC - 1)) == 0, last = r0 < NLAT ? ((r0 + 32) & (T - 1)) == 0 : ((r0 + 32 - NLAT) & (TC - 1)) == 0;
        const int act = (ch >= 192 && ch < 200) ? 1 : (ch >= 208 ? 2 : 0);
        const f32x4 mu0 = *(const f32x4*)(mu + 8 * ch), mu1 = *(const f32x4*)(mu + 8 * ch + 4); const float mm[8] = {mu0.x, mu0.y, mu0.z, mu0.w, mu1.x, mu1.y, mu1.z, mu1.w};
        const bool isk = ch >= 64 && ch < 128; const int kc = isk ? 8 * (ch - 64) : 0; const f32x4 kk0 = *(const f32x4*)(k_k + kc), kk1 = *(const f32x4*)(k_k + kc + 4); const float kkc[8] = {kk0.x, kk0.y, kk0.z, kk0.w, kk1.x, kk1.y, kk1.z, kk1.w};
        const u32x4 z = {0u, 0u, 0u, 0u};
        u32x4* col = (u32x4*)(RW + (size_t)r0 * RW_COLS + 8 * ch);
        u32x4 prev = first ? z : *(const u32x4*)(SIDE + ((size_t)(sidx - 1) * 2 + 1) * RW_COLS + 8 * ch);
        const u32x4 after = last ? z : *(const u32x4*)(SIDE + ((size_t)(sidx + 1) * 2) * RW_COLS + 8 * ch);
#pragma unroll 1
        for (int sb = 0; sb < 4; ++sb) { u32x4 rw[9];
#pragma unroll
            for (int j = 0; j < 8; ++j) rw[j] = col[(size_t)(sb * 8 + j) * NCHUNK];
            rw[8] = sb < 3 ? col[(size_t)(sb * 8 + 8) * NCHUNK] : after;
#pragma unroll
            for (int j = 0; j < 8; ++j) { float p_[8], m_[8], n_[8]; unpack8(rw[j], p_); unpack8(j == 0 ? prev : rw[j - 1], m_); unpack8(rw[j + 1], n_); float o[8];
#pragma unroll
                for (int e = 0; e < 8; ++e) { float v = p_[e] + mm[e] * (0.5f * (m_[e] + n_[e]) - p_[e]); o[e] = act == 1 ? ftanh(v) : act == 2 ? fsigmoid(v) : v; }
                u32x4 pk; pk.x = pk2(o[0], o[1]); pk.y = pk2(o[2], o[3]); pk.z = pk2(o[4], o[5]); pk.w = pk2(o[6], o[7]); col[(size_t)(sb * 8 + j) * NCHUNK] = pk;
                float ss = 0.f;
#pragma unroll
                for (int e = 0; e < 8; ++e) { const float kv = o[e] * kkc[e]; ss += kv * kv; }
                ss += __shfl_xor(ss, 1); ss += __shfl_xor(ss, 2); ss += __shfl_xor(ss, 4);
                if (isk && (ch & 7) == 0) KN[(size_t)(r0 + sb * 8 + j) * 8 + ((ch - 64) >> 3)] = 1.f / fmaxf(sqrtf(ss), 1e-12f); }
            prev = rw[7]; }
    }
}
__device__ __forceinline__ void phase_rwkv_seq2(const bf16_t* __restrict__ RW, const float* __restrict__ KN, bf16_t* __restrict__ Y0, bf16_t* __restrict__ Y1, const float* __restrict__ w0, const bf16_t* __restrict__ W2T,
                                                const float* __restrict__ a0, const bf16_t* __restrict__ A2T, const float* __restrict__ k_k, const float* __restrict__ k_a, unsigned char* lds, int bid, int nb) {
    const int tid0 = otid(), w = __builtin_amdgcn_readfirstlane(tid0 >> 6);
    constexpr int BUFB = 65536 + 8192 + 4096 + 256;
    for (int item = bid; item < 256; item += nb) {
        const int chain = item >> 1, vh = item & 1, b = chain >> 4, h = (chain >> 1) & 7, d = chain & 1;
        bf16_t* Yd = d ? Y1 : Y0;
        auto tok_row = [&](int cc, int j) -> size_t { const bool ic = cc < 4; const int ln = ic ? TC : T; const int ss = (ic ? cc * 64 : (cc - 4) * 64) + j, t = d == 0 ? ss : ln - 1 - ss; return (ic ? (size_t)NLAT + (size_t)b * TC : (size_t)b * T) + t; };
        auto prep = [&](int cc, int lane, int pw) {
            unsigned char* B_ = lds + (cc & 1) * BUFB; float* VEC = (float*)B_; float* VV = (float*)(B_ + 65536); float* PCV = (float*)(B_ + 65536 + 8192 + 4096);
            const int fr = lane & 15, fq = lane >> 4, i0 = 16 * pw + 4 * fq;
            { const int ptid = pw * 64 + lane, tk = ptid >> 2, part = ptid & 3; float v8[8]; unpack8(*(const u32x4*)(RW + tok_row(cc, tk) * RW_COLS + 1024 + h * 64 + vh * 32 + 8 * part), v8);
              *(f32x4*)(VV + tk * 32 + 8 * part) = (f32x4){v8[0], v8[1], v8[2], v8[3]}; *(f32x4*)(VV + tk * 32 + 8 * part + 4) = (f32x4){v8[4], v8[5], v8[6], v8[7]}; }
            bf16x8 bw[2], ba[2];
#pragma unroll
            for (int ks = 0; ks < 2; ++ks) { const size_t off = ((size_t)d * 512 + h * 64 + 16 * pw + fr) * 64 + ks * 32 + fq * 8; bw[ks] = *(const bf16x8*)(W2T + off); ba[ks] = *(const bf16x8*)(A2T + off); }
            const f32x4 w0c = *(const f32x4*)(w0 + d * 512 + h * 64 + i0), a0c = *(const f32x4*)(a0 + d * 512 + h * 64 + i0), kkc = *(const f32x4*)(k_k + h * 64 + i0), kac = *(const f32x4*)(k_a + h * 64 + i0);
            f32x4 run = {0.f, 0.f, 0.f, 0.f};
#pragma unroll 1
            for (int mt = 0; mt < 4; ++mt) {
                const int tk = 16 * mt + fr; const size_t row = tok_row(cc, tk); const bf16_t* p0 = RW + row * RW_COLS;
                f32x4 aw = {0.f, 0.f, 0.f, 0.f}, aa = {0.f, 0.f, 0.f, 0.f};
#pragma unroll
                for (int ks = 0; ks < 2; ++ks) { const bf16x8 fw = *(const bf16x8*)(p0 + 1536 + ks * 32 + fq * 8), fa = *(const bf16x8*)(p0 + 1600 + ks * 32 + fq * 8);
                    aw = __builtin_amdgcn_mfma_f32_16x16x32_bf16(bw[ks], fw, aw, 0, 0, 0); aa = __builtin_amdgcn_mfma_f32_16x16x32_bf16(ba[ks], fa, aa, 0, 0, 0); }
                const f32x4 r4 = ld_bf16x4(p0 + h * 64 + i0), k4 = ld_bf16x4(p0 + 512 + h * 64 + i0); const float inv = KN[row * 8 + h];
                f32x4 kkt, bt, kt, rt, tot;
#pragma unroll
                for (int r = 0; r < 4; ++r) { const float L = -0.6065306597126334f * fsigmoid(aw[r] + w0c[r]); float cs = L;
                    cs += dpp_mov<0x111>(cs); cs += dpp_mov<0x112>(cs); cs += dpp_mov<0x114>(cs); cs += dpp_mov<0x118>(cs);
                    tot[r] = __shfl(cs, (lane & 48) + 15);
                    const float cum = cs + run[r]; const float e1 = __expf(cum), ei = __builtin_amdgcn_rcpf(e1), e0 = __expf(cum - L);
                    const float a = fsigmoid(aa[r] + a0c[r]); const float kkn = k4[r] * kkc[r] * inv;
                    kkt[r] = kkn * e0; bt[r] = kkn * a * ei; kt[r] = k4[r] * (1.f + (a - 1.f) * kac[r]) * ei; rt[r] = r4[r] * e1; }
                run += tot;
                *(f32x4*)(VEC + (tk * 4 + 0) * 64 + i0) = kkt; *(f32x4*)(VEC + (tk * 4 + 1) * 64 + i0) = bt; *(f32x4*)(VEC + (tk * 4 + 2) * 64 + i0) = kt; *(f32x4*)(VEC + (tk * 4 + 3) * 64 + i0) = rt;
            }
            if (fr == 0) *(f32x4*)(PCV + i0) = (f32x4){__expf(run.x), __expf(run.y), __expf(run.z), __expf(run.w)};
        };
        auto yout = [&](int cc, int lane, int pw) { if (cc < 4) return; const bf16_t* YB = (const bf16_t*)(lds + (cc & 1) * BUFB + 65536 + 8192);
            const int ptid = pw * 64 + lane, tk = ptid >> 2, part = ptid & 3;
            *(u32x4*)(Yd + tok_row(cc, tk) * RWD + h * 64 + vh * 32 + 8 * part) = *(const u32x4*)(YB + tk * 32 + 8 * part); };
        f32x4 S = {0.f, 0.f, 0.f, 0.f}, S2 = {0.f, 0.f, 0.f, 0.f};
        __syncthreads();
        if (w >= 4) prep(0, tid0 & 63, w - 4);
        __syncthreads();
        for (int c = 0; c < 68; ++c) {
            int tid = tid0; asm volatile("" : "+v"(tid));
            const int lane = tid & 63;
            if (w < 4) {
                unsigned char* B_ = lds + (c & 1) * BUFB; const float* VEC = (const float*)B_; const float* VV = (const float*)(B_ + 65536); unsigned* YBw = (unsigned*)(B_ + 65536 + 8192); const float* PCV = (const float*)(B_ + 65536 + 8192 + 4096);
                const int sp = lane & 15, fq = lane >> 4, rA = w * 8 + fq * 2;
                const float* vp = VEC + 4 * sp; f32x4 kkv_ = *(const f32x4*)(vp), bv_ = *(const f32x4*)(vp + 64), kdv = *(const f32x4*)(vp + 128), rv = *(const f32x4*)(vp + 192); f32x2_ vv2 = *(const f32x2_*)(VV + rA);
                float a0_ = S.x, a1_ = S.y, a2_ = S.z, a3_ = S.w, b0_ = S2.x, b1_ = S2.y, b2_ = S2.z, b3_ = S2.w;
                f32x4 rpv = {0.f, 0.f, 0.f, 0.f};
                const bool o1 = sp & 1, o2 = sp & 2;
                auto yred = [&](const float (&yA)[4], const float (&yB)[4], int trow) {
                    float a_ = o1 ? yA[1] : yA[0], b_ = o1 ? yA[0] : yA[1], c_ = o1 ? yA[3] : yA[2], d_ = o1 ? yA[2] : yA[3];
                    float g_ = o1 ? yB[1] : yB[0], h_ = o1 ? yB[0] : yB[1], i_ = o1 ? yB[3] : yB[2], j_ = o1 ? yB[2] : yB[3];
                    a_ += dpp_mov<0xB1>(b_); g_ += dpp_mov<0xB1>(h_); c_ += dpp_mov<0xB1>(d_); i_ += dpp_mov<0xB1>(j_);
                    float e_ = o2 ? c_ : a_, f_ = o2 ? a_ : c_, k_ = o2 ? i_ : g_, l_ = o2 ? g_ : i_; e_ += dpp_mov<0x4E>(f_); k_ += dpp_mov<0x4E>(l_);
                    e_ += dpp_mov<0x124>(e_); k_ += dpp_mov<0x124>(k_); e_ += dpp_mov<0x128>(e_); k_ += dpp_mov<0x128>(k_);
                    const int tr = trow + sp; if (sp < 4 && tr >= 0) YBw[tr * 16 + (rA >> 1)] = pk2(e_, k_); };
#pragma unroll 1
                for (int t4 = 0; t4 < 64; t4 += 4) { float yA[4], yB[4];
#pragma unroll
                  for (int u = 0; u < 4; ++u) { const int t = t4 + u;
                    const int tn = t < 63 ? t + 1 : 63; const float* vn = VEC + tn * 256 + 4 * sp;
                    const f32x4 kkn_ = *(const f32x4*)(vn), bn = *(const f32x4*)(vn + 64), kdn = *(const f32x4*)(vn + 128), rn = *(const f32x4*)(vn + 192); const f32x2_ vvn = *(const f32x2_*)(VV + tn * 32 + rA);
                    asm volatile("" ::: "memory");
                    const float vva = vv2.x, vvb = vv2.y; float sa, sb, ya, yb;
                    asm volatile("v_mul_f32_e32 %0, %4, %12\n\tv_mul_f32_e32 %1, %8, %12\n\tv_fmac_f32_e32 %0, %5, %13\n\tv_fmac_f32_e32 %1, %9, %13\n\tv_fmac_f32_e32 %0, %6, %14\n\tv_fmac_f32_e32 %1, %10, %14\n\tv_fmac_f32_e32 %0, %7, %15\n\tv_fmac_f32_e32 %1, %11, %15\n\t"
                                 "v_mul_f32_e32 %2, %4, %16\n\tv_add_f32_dpp %0, %0, %0 quad_perm:[1,0,3,2] row_mask:0xf bank_mask:0xf bound_ctrl:1\n\tv_mul_f32_e32 %3, %8, %16\n\tv_add_f32_dpp %1, %1, %1 quad_perm:[1,0,3,2] row_mask:0xf bank_mask:0xf bound_ctrl:1\n\t"
                                 "v_fmac_f32_e32 %2, %5, %17\n\tv_add_f32_dpp %0, %0, %0 quad_perm:[2,3,0,1] row_mask:0xf bank_mask:0xf bound_ctrl:1\n\tv_fmac_f32_e32 %3, %9, %17\n\tv_add_f32_dpp %1, %1, %1 quad_perm:[2,3,0,1] row_mask:0xf bank_mask:0xf bound_ctrl:1\n\t"
                                 "v_fmac_f32_e32 %2, %6, %18\n\tv_add_f32_dpp %0, %0, %0 row_half_mirror row_mask:0xf bank_mask:0xf bound_ctrl:1\n\tv_fmac_f32_e32 %3, %10, %18\n\tv_add_f32_dpp %1, %1, %1 row_half_mirror row_mask:0xf bank_mask:0xf bound_ctrl:1\n\t"
                                 "v_fmac_f32_e32 %2, %7, %19\n\tv_add_f32_dpp %0, %0, %0 row_mirror row_mask:0xf bank_mask:0xf bound_ctrl:1\n\tv_fmac_f32_e32 %3, %11, %19\n\tv_add_f32_dpp %1, %1, %1 row_mirror row_mask:0xf bank_mask:0xf bound_ctrl:1\n\ts_nop 1"
                                 : "=&v"(sa), "=&v"(sb), "=&v"(ya), "=&v"(yb)
                                 : "v"(a0_), "v"(a1_), "v"(a2_), "v"(a3_), "v"(b0_), "v"(b1_), "v"(b2_), "v"(b3_), "v"(kkv_.x), "v"(kkv_.y), "v"(kkv_.z), "v"(kkv_.w), "v"(rpv.x), "v"(rpv.y), "v"(rpv.z), "v"(rpv.w));
                    yA[u] = ya; yB[u] = yb;
                    a0_ = fnma_s(bv_.x, sa, a0_); b0_ = fnma_s(bv_.x, sb, b0_); a1_ = fnma_s(bv_.y, sa, a1_); b1_ = fnma_s(bv_.y, sb, b1_); a2_ = fnma_s(bv_.z, sa, a2_); b2_ = fnma_s(bv_.z, sb, b2_); a3_ = fnma_s(bv_.w, sa, a3_); b3_ = fnma_s(bv_.w, sb, b3_);
                    a0_ = ffma_s(kdv.x, vva, a0_); b0_ = ffma_s(kdv.x, vvb, b0_); a1_ = ffma_s(kdv.y, vva, a1_); b1_ = ffma_s(kdv.y, vvb, b1_); a2_ = ffma_s(kdv.z, vva, a2_); b2_ = ffma_s(kdv.z, vvb, b2_); a3_ = ffma_s(kdv.w, vva, a3_); b3_ = ffma_s(kdv.w, vvb, b3_);
                    rpv = rv; kkv_ = kkn_; bv_ = bn; kdv = kdn; rv = rn; vv2 = vvn; }
                  yred(yA, yB, t4 - 1); }
                {
                  float ya = fmul_s(a0_, rpv.x), yb = fmul_s(b0_, rpv.x); ya = ffma_s(a1_, rpv.y, ya); yb = ffma_s(b1_, rpv.y, yb); ya = ffma_s(a2_, rpv.z, ya); yb = ffma_s(b2_, rpv.z, yb); ya = ffma_s(a3_, rpv.w, ya); yb = ffma_s(b3_, rpv.w, yb);
                  ya = red16(ya); yb = red16(yb); if (sp == 0) YBw[63 * 16 + (rA >> 1)] = pk2(ya, yb); }
                const f32x4 pc = *(const f32x4*)(PCV + 4 * sp); S = (f32x4){a0_ * pc.x, a1_ * pc.y, a2_ * pc.z, a3_ * pc.w}; S2 = (f32x4){b0_ * pc.x, b1_ * pc.y, b2_ * pc.z, b3_ * pc.w};
            } else {
                if (c >= 1) yout(c - 1, lane, w - 4);
                if (c + 1 < 68) prep(c + 1, lane, w - 4);
            }
            __syncthreads();
        }
        if (w >= 4) yout(67, tid0 & 63, w - 4);
    }
}
__device__ __forceinline__ void phase_rwkv_seq3(const bf16_t* __restrict__ RW, const float* __restrict__ KN, bf16_t* __restrict__ Y0, bf16_t* __restrict__ Y1, const float* __restrict__ w0, const bf16_t* __restrict__ W2T,
                                                const float* __restrict__ a0, const bf16_t* __restrict__ A2T, const float* __restrict__ k_k, const float* __restrict__ k_a, unsigned char* lds, int bid, int nb) {
    const int tid0 = otid(), w = __builtin_amdgcn_readfirstlane(tid0 >> 6);
    constexpr int CH = 32, NCH = (TC + T) / CH, NCX = TC / CH;
    constexpr int VSTR = 196;
    constexpr int A_BYTES = CH * VSTR * 4 + CH * 32 * 4 + 256;
    constexpr int B_BYTES = 3 * CH * 144 + 32 * 80;
    constexpr int C_BYTES = 32 * 144 + 32 * 144;
    constexpr int OFF_B = 2 * A_BYTES, OFF_C = OFF_B + 3 * B_BYTES;
    static_assert(OFF_C + 2 * C_BYTES <= 163584, "LDS");
    for (int item = bid; item < 256; item += nb) {
        const int chain = item >> 1, vh = item & 1, b = chain >> 4, h = (chain >> 1) & 7, d = chain & 1;
        bf16_t* Yd = d ? Y1 : Y0;
        auto tok_row = [&](int cc, int j) -> size_t { const bool ic = cc < NCX; const int ln = ic ? TC : T; const int ss = (ic ? cc : cc - NCX) * CH + j, t = d == 0 ? ss : ln - 1 - ss; return (ic ? (size_t)NLAT + (size_t)b * TC : (size_t)b * T) + t; };
        struct Raw { bf16x8 fw[2][2], fa[2][2], bw[2], ba[2]; u32x2 r4[2], k4[2], v; float inv[2]; f32x4 w0c, a0c, kkc, kac; };
        auto prep_load = [&](int cc, int lane, int pw, Raw& R) {
            const int fr = lane & 15, fq = lane >> 4, i0 = 16 * pw + 4 * fq;
            { const int ptid = pw * 64 + lane, tk = ptid >> 3, part = ptid & 7; R.v = *(const u32x2*)(RW + tok_row(cc, tk) * RW_COLS + 1024 + h * 64 + vh * 32 + 4 * part); }
#pragma unroll
            for (int mt = 0; mt < 2; ++mt) { const size_t row = tok_row(cc, 16 * mt + fr); const bf16_t* p0 = RW + row * RW_COLS;
#pragma unroll
                for (int ks = 0; ks < 2; ++ks) { R.fw[mt][ks] = *(const bf16x8*)(p0 + 1536 + ks * 32 + fq * 8); R.fa[mt][ks] = *(const bf16x8*)(p0 + 1600 + ks * 32 + fq * 8); }
                R.r4[mt] = *(const u32x2*)(p0 + h * 64 + i0); R.k4[mt] = *(const u32x2*)(p0 + 512 + h * 64 + i0); R.inv[mt] = KN[row * 8 + h]; }
#pragma unroll
            for (int ks = 0; ks < 2; ++ks) { const size_t off = ((size_t)d * 512 + h * 64 + 16 * pw + fr) * 64 + ks * 32 + fq * 8; R.bw[ks] = *(const bf16x8*)(W2T + off); R.ba[ks] = *(const bf16x8*)(A2T + off); }
            R.w0c = *(const f32x4*)(w0 + d * 512 + h * 64 + i0); R.a0c = *(const f32x4*)(a0 + d * 512 + h * 64 + i0); R.kkc = *(const f32x4*)(k_k + h * 64 + i0); R.kac = *(const f32x4*)(k_a + h * 64 + i0);
            asm volatile("" ::: "memory");
        };
        auto prep = [&](int cc, int lane, int pw, const Raw& R) {
            unsigned char* A_ = lds + (cc & 1) * A_BYTES; float* VEC = (float*)A_; float* VV = (float*)(A_ + CH * VSTR * 4); float* PCV = (float*)(A_ + CH * VSTR * 4 + CH * 32 * 4);
            bf16_t* RBp = (bf16_t*)(lds + OFF_B + (cc % 3) * B_BYTES); bf16_t* KBp = RBp + CH * 72; bf16_t* BBp = KBp + CH * 72; bf16_t* VTp = BBp + CH * 72;
            const int fr = lane & 15, fq = lane >> 4, i0 = 16 * pw + 4 * fq;
            { const int ptid = pw * 64 + lane, tk = ptid >> 3, part = ptid & 7; const u32x2 raw = R.v;
              *(f32x4*)(VV + tk * 32 + 4 * part) = (f32x4){__builtin_bit_cast(float, raw.x << 16), __builtin_bit_cast(float, raw.x & 0xffff0000u), __builtin_bit_cast(float, raw.y << 16), __builtin_bit_cast(float, raw.y & 0xffff0000u)};
              bf16_t* vt = VTp + (4 * part) * 40 + tk; vt[0] = (bf16_t)raw.x; vt[40] = (bf16_t)(raw.x >> 16); vt[80] = (bf16_t)raw.y; vt[120] = (bf16_t)(raw.y >> 16); }
            const f32x4 w0c = R.w0c, a0c = R.a0c, kkc = R.kkc, kac = R.kac;
            f32x4 run = {0.f, 0.f, 0.f, 0.f};
#pragma unroll
            for (int mt = 0; mt < 2; ++mt) {
                const int tk = 16 * mt + fr;
                f32x4 aw = {0.f, 0.f, 0.f, 0.f}, aa = {0.f, 0.f, 0.f, 0.f};
#pragma unroll
                for (int ks = 0; ks < 2; ++ks) { aw = __builtin_amdgcn_mfma_f32_16x16x32_bf16(R.bw[ks], R.fw[mt][ks], aw, 0, 0, 0); aa = __builtin_amdgcn_mfma_f32_16x16x32_bf16(R.ba[ks], R.fa[mt][ks], aa, 0, 0, 0); }
                const u32x2 rr = R.r4[mt], kr = R.k4[mt];
                const f32x4 r4 = {__builtin_bit_cast(float, rr.x << 16), __builtin_bit_cast(float, rr.x & 0xffff0000u), __builtin_bit_cast(float, rr.y << 16), __builtin_bit_cast(float, rr.y & 0xffff0000u)};
                const f32x4 k4 = {__builtin_bit_cast(float, kr.x << 16), __builtin_bit_cast(float, kr.x & 0xffff0000u), __builtin_bit_cast(float, kr.y << 16), __builtin_bit_cast(float, kr.y & 0xffff0000u)};
                const float inv = R.inv[mt];
                f32x4 kkt, bt, kt, rt, tot;
#pragma unroll
                for (int r = 0; r < 4; ++r) { const float L = -0.6065306597126334f * fsigmoid(aw[r] + w0c[r]); float cs = L;
                    cs += dpp_mov<0x111>(cs); cs += dpp_mov<0x112>(cs); cs += dpp_mov<0x114>(cs); cs += dpp_mov<0x118>(cs);
                    tot[r] = __shfl(cs, (lane & 48) + 15);
                    const float cum = cs + run[r]; const float e1 = __expf(cum), ei = __builtin_amdgcn_rcpf(e1), e0 = __expf(cum - L);
                    const float a = fsigmoid(aa[r] + a0c[r]); const float kkn = k4[r] * kkc[r] * inv;
                    kkt[r] = kkn * e0; bt[r] = kkn * a * ei; kt[r] = k4[r] * (1.f + (a - 1.f) * kac[r]) * ei; rt[r] = r4[r] * e1; }
                run += tot;
                float* vp = VEC + tk * VSTR + i0; *(f32x4*)(vp) = kkt; *(f32x4*)(vp + 64) = bt; *(f32x4*)(vp + 128) = kt;
                *(u32x2*)(RBp + tk * 72 + i0) = (u32x2){pk2(rt.x, rt.y), pk2(rt.z, rt.w)}; *(u32x2*)(KBp + tk * 72 + i0) = (u32x2){pk2(kt.x, kt.y), pk2(kt.z, kt.w)}; *(u32x2*)(BBp + tk * 72 + i0) = (u32x2){pk2(bt.x, bt.y), pk2(bt.z, bt.w)};
            }
            if (fr == 0) *(f32x4*)(PCV + i0) = (f32x4){__expf(run.x), __expf(run.y), __expf(run.z), __expf(run.w)};
        };
        auto ycomp = [&](int cc, int lane, int pw) {
            if (cc < NCX) return;
            const bf16_t* RBp = (const bf16_t*)(lds + OFF_B + (cc % 3) * B_BYTES); const bf16_t* KBp = RBp + CH * 72; const bf16_t* BBp = KBp + CH * 72; const bf16_t* VTp = BBp + CH * 72;
            const float* SAF = (const float*)(lds + OFF_C + (cc & 1) * C_BYTES); const bf16_t* S0B = (const bf16_t*)(lds + OFF_C + (cc & 1) * C_BYTES + 32 * 144);
            const int fr = lane & 15, q = lane >> 4, mt = pw >> 1, nt = pw & 1;
            const bf16x8 r0 = *(const bf16x8*)(RBp + (16 * mt + fr) * 72 + 8 * q), r1 = *(const bf16x8*)(RBp + (16 * mt + fr) * 72 + 32 + 8 * q);
            const f32x4 z4 = {0.f, 0.f, 0.f, 0.f};
            f32x4 gk0, gb0, gk1 = z4, gb1 = z4;
            { const bf16x8 k0 = *(const bf16x8*)(KBp + fr * 72 + 8 * q), k1 = *(const bf16x8*)(KBp + fr * 72 + 32 + 8 * q), b0 = *(const bf16x8*)(BBp + fr * 72 + 8 * q), b1 = *(const bf16x8*)(BBp + fr * 72 + 32 + 8 * q);
              gk0 = __builtin_amdgcn_mfma_f32_16x16x32_bf16(k0, r0, z4, 0, 0, 0); gk0 = __builtin_amdgcn_mfma_f32_16x16x32_bf16(k1, r1, gk0, 0, 0, 0);
              gb0 = __builtin_amdgcn_mfma_f32_16x16x32_bf16(b0, r0, z4, 0, 0, 0); gb0 = __builtin_amdgcn_mfma_f32_16x16x32_bf16(b1, r1, gb0, 0, 0, 0); }
            if (mt == 1) {
              const bf16x8 k0 = *(const bf16x8*)(KBp + (16 + fr) * 72 + 8 * q), k1 = *(const bf16x8*)(KBp + (16 + fr) * 72 + 32 + 8 * q), b0 = *(const bf16x8*)(BBp + (16 + fr) * 72 + 8 * q), b1 = *(const bf16x8*)(BBp + (16 + fr) * 72 + 32 + 8 * q);
              gk1 = __builtin_amdgcn_mfma_f32_16x16x32_bf16(k0, r0, z4, 0, 0, 0); gk1 = __builtin_amdgcn_mfma_f32_16x16x32_bf16(k1, r1, gk1, 0, 0, 0);
              gb1 = __builtin_amdgcn_mfma_f32_16x16x32_bf16(b0, r0, z4, 0, 0, 0); gb1 = __builtin_amdgcn_mfma_f32_16x16x32_bf16(b1, r1, gb1, 0, 0, 0);
#pragma unroll
              for (int r = 0; r < 4; ++r) { const bool keep = 4 * q + r <= fr; gk1[r] = keep ? gk1[r] : 0.f; gb1[r] = keep ? gb1[r] : 0.f; }
            } else {
#pragma unroll
              for (int r = 0; r < 4; ++r) { const bool keep = 4 * q + r <= fr; gk0[r] = keep ? gk0[r] : 0.f; gb0[r] = keep ? gb0[r] : 0.f; }
            }
            const u32x4 gkp = {pk2(gk0[0], gk0[1]), pk2(gk0[2], gk0[3]), pk2(gk1[0], gk1[1]), pk2(gk1[2], gk1[3])};
            const u32x4 gbp = {pk2(-gb0[0], -gb0[1]), pk2(-gb0[2], -gb0[3]), pk2(-gb1[0], -gb1[1]), pk2(-gb1[2], -gb1[3])};
            const int ri = 16 * nt + fr;
            const u32x2 v0 = *(const u32x2*)(VTp + ri * 40 + 4 * q), v1 = *(const u32x2*)(VTp + ri * 40 + 16 + 4 * q);
            const f32x4 s0 = *(const f32x4*)(SAF + ri * 36 + 4 * q), s1 = *(const f32x4*)(SAF + ri * 36 + 16 + 4 * q);
            const u32x4 vtp = {v0.x, v0.y, v1.x, v1.y}, sap = {pk2(s0.x, s0.y), pk2(s0.z, s0.w), pk2(s1.x, s1.y), pk2(s1.z, s1.w)};
            const bf16x8 z0 = *(const bf16x8*)(S0B + ri * 72 + 8 * q), z1 = *(const bf16x8*)(S0B + ri * 72 + 32 + 8 * q);
            f32x4 y = __builtin_amdgcn_mfma_f32_16x16x32_bf16(__builtin_bit_cast(bf16x8, vtp), __builtin_bit_cast(bf16x8, gkp), z4, 0, 0, 0);
            y = __builtin_amdgcn_mfma_f32_16x16x32_bf16(__builtin_bit_cast(bf16x8, sap), __builtin_bit_cast(bf16x8, gbp), y, 0, 0, 0);
            y = __builtin_amdgcn_mfma_f32_16x16x32_bf16(z0, r0, y, 0, 0, 0); y = __builtin_amdgcn_mfma_f32_16x16x32_bf16(z1, r1, y, 0, 0, 0);
            *(u32x2*)(Yd + tok_row(cc, 16 * mt + fr) * RWD + h * 64 + vh * 32 + 16 * nt + 4 * q) = (u32x2){pk2(y[0], y[1]), pk2(y[2], y[3])};
        };
        f32x4 S = {0.f, 0.f, 0.f, 0.f}, S2 = {0.f, 0.f, 0.f, 0.f};
        __syncthreads();
        if (w >= 4) { Raw raw; prep_load(0, tid0 & 63, w - 4, raw); prep(0, tid0 & 63, w - 4, raw); }
        __syncthreads();
        for (int c = 0; c < NCH; ++c) {
            int tid = tid0; asm volatile("" : "+v"(tid));
            const int lane = tid & 63;
            if (w < 4) {
                const unsigned char* A_ = lds + (c & 1) * A_BYTES; const float* VEC = (const float*)A_; const float* VV = (const float*)(A_ + CH * VSTR * 4); const float* PCV = (const float*)(A_ + CH * VSTR * 4 + CH * 32 * 4);
                float* SAF = (float*)(lds + OFF_C + (c & 1) * C_BYTES); bf16_t* S0B = (bf16_t*)(lds + OFF_C + (c & 1) * C_BYTES + 32 * 144);
                const int sp = lane & 15, fq = lane >> 4, rA = w * 8 + fq * 2;
                *(u32x2*)(S0B + rA * 72 + 4 * sp) = (u32x2){pk2(S.x, S.y), pk2(S.z, S.w)}; *(u32x2*)(S0B + (rA + 1) * 72 + 4 * sp) = (u32x2){pk2(S2.x, S2.y), pk2(S2.z, S2.w)};
                unsigned saw = (unsigned)(size_t)(LAS float*)(SAF + rA * 36); asm volatile("" : "+v"(saw));
                const unsigned long long m_sp0 = __ballot(sp == 0);
                const float* vp = VEC + 4 * sp; f32x4 kkv_ = *(const f32x4*)(vp), bv_ = *(const f32x4*)(vp + 64), kdv = *(const f32x4*)(vp + 128); f32x2_ vv2 = *(const f32x2_*)(VV + rA);
                float a0_ = S.x, a1_ = S.y, a2_ = S.z, a3_ = S.w, b0_ = S2.x, b1_ = S2.y, b2_ = S2.z, b3_ = S2.w;
#pragma unroll 1
                for (int t4 = 0; t4 < CH; t4 += 4) {
#pragma unroll
                  for (int u = 0; u < 4; ++u) { const int t = t4 + u;
                    const int tn = t < CH - 1 ? t + 1 : CH - 1; const float* vn = VEC + tn * VSTR + 4 * sp;
                    const f32x4 kkn_ = *(const f32x4*)(vn), bn = *(const f32x4*)(vn + 64), kdn = *(const f32x4*)(vn + 128); const f32x2_ vvn = *(const f32x2_*)(VV + tn * 32 + rA);
                    asm volatile("" ::: "memory");
                    const float vva = vv2.x, vvb = vv2.y; float sa, sb;
                    asm volatile("v_mul_f32_e32 %8, %0, %10\n\tv_mul_f32_e32 %9, %4, %10\n\tv_fmac_f32_e32 %8, %1, %11\n\tv_fmac_f32_e32 %9, %5, %11\n\tv_fmac_f32_e32 %8, %2, %12\n\tv_fmac_f32_e32 %9, %6, %12\n\tv_fmac_f32_e32 %8, %3, %13\n\tv_fmac_f32_e32 %9, %7, %13\n\t"
                                 "v_fmac_f32_e32 %0, %14, %18\n\tv_add_f32_dpp %8, %8, %8 quad_perm:[1,0,3,2] row_mask:0xf bank_mask:0xf bound_ctrl:1\n\tv_fmac_f32_e32 %4, %14, %19\n\tv_add_f32_dpp %9, %9, %9 quad_perm:[1,0,3,2] row_mask:0xf bank_mask:0xf bound_ctrl:1\n\t"
                                 "v_fmac_f32_e32 %1, %15, %18\n\tv_add_f32_dpp %8, %8, %8 quad_perm:[2,3,0,1] row_mask:0xf bank_mask:0xf bound_ctrl:1\n\tv_fmac_f32_e32 %5, %15, %19\n\tv_add_f32_dpp %9, %9, %9 quad_perm:[2,3,0,1] row_mask:0xf bank_mask:0xf bound_ctrl:1\n\t"
                                 "v_fmac_f32_e32 %2, %16, %18\n\tv_add_f32_dpp %8, %8, %8 row_half_mirror row_mask:0xf bank_mask:0xf bound_ctrl:1\n\tv_fmac_f32_e32 %6, %16, %19\n\tv_add_f32_dpp %9, %9, %9 row_half_mirror row_mask:0xf bank_mask:0xf bound_ctrl:1\n\t"
                                 "v_fmac_f32_e32 %3, %17, %18\n\tv_add_f32_dpp %8, %8, %8 row_mirror row_mask:0xf bank_mask:0xf bound_ctrl:1\n\tv_fmac_f32_e32 %7, %17, %19\n\tv_add_f32_dpp %9, %9, %9 row_mirror row_mask:0xf bank_mask:0xf bound_ctrl:1"
                                 : "+v"(a0_), "+v"(a1_), "+v"(a2_), "+v"(a3_), "+v"(b0_), "+v"(b1_), "+v"(b2_), "+v"(b3_), "=&v"(sa), "=&v"(sb)
                                 : "v"(kkv_.x), "v"(kkv_.y), "v"(kkv_.z), "v"(kkv_.w), "v"(kdv.x), "v"(kdv.y), "v"(kdv.z), "v"(kdv.w), "v"(vva), "v"(vvb));
                    asm volatile("s_mov_b64 exec, %3\n\tds_write2_b32 %0, %1, %2 offset0:%4 offset1:%5\n\ts_mov_b64 exec, -1" :: "v"(saw + 4 * t4), "v"(sa), "v"(sb), "s"(m_sp0), "n"(u), "n"(36 + u) : "memory");
                    a0_ = fnma_s(bv_.x, sa, a0_); b0_ = fnma_s(bv_.x, sb, b0_); a1_ = fnma_s(bv_.y, sa, a1_); b1_ = fnma_s(bv_.y, sb, b1_); a2_ = fnma_s(bv_.z, sa, a2_); b2_ = fnma_s(bv_.z, sb, b2_); a3_ = fnma_s(bv_.w, sa, a3_); b3_ = fnma_s(bv_.w, sb, b3_);
                    kkv_ = kkn_; bv_ = bn; kdv = kdn; vv2 = vvn; }
                }
                const f32x4 pc = *(const f32x4*)(PCV + 4 * sp); S = (f32x4){a0_ * pc.x, a1_ * pc.y, a2_ * pc.z, a3_ * pc.w}; S2 = (f32x4){b0_ * pc.x, b1_ * pc.y, b2_ * pc.z, b3_ * pc.w};
            } else {
                Raw raw; prep_load(c + 1 < NCH ? c + 1 : NCH - 1, lane, w - 4, raw);
                if (c >= 1) ycomp(c - 1, lane, w - 4);
                if (c + 1 < NCH) prep(c + 1, lane, w - 4, raw);
            }
            __syncthreads();
        }
        if (w >= 4) ycomp(NCH - 1, tid0 & 63, w - 4);
    }
}
__device__ __forceinline__ void phase_rwkv_seq4(const bf16_t* __restrict__ RW, const float* __restrict__ KN, bf16_t* __restrict__ Y0, bf16_t* __restrict__ Y1, const float* __restrict__ w0, const bf16_t* __restrict__ W2T,
                                                const float* __restrict__ a0, const bf16_t* __restrict__ A2T, const float* __restrict__ k_k, const float* __restrict__ k_a,
                                                const float* __restrict__ mw1, const float* __restrict__ mw3, const float* __restrict__ mw2, bf16_t* __restrict__ W13, bf16_t* __restrict__ W2, unsigned char* lds, int bid, int nb) {
    const int tid0 = otid(), w = __builtin_amdgcn_readfirstlane(tid0 >> 6);
    constexpr int CH = 32, NCH = (TC + T) / CH, NCX = TC / CH;
    constexpr int A_BYTES = 256;
    constexpr int B_BYTES = 3 * CH * 144 + 32 * 80;
    constexpr int E_BYTES = CH * 144 + 2 * 64 * 80;
    constexpr int C_BYTES = 32 * 144 + 32 * 144;
    constexpr int D_BYTES = 4 * CH * 144 + CH * 80 + 128;
    constexpr int OFF_B = 2 * A_BYTES, OFF_C = OFF_B + 3 * B_BYTES, OFF_D = OFF_C + 2 * C_BYTES, OFF_E = OFF_D + 2 * D_BYTES, OFF_W = OFF_E + 2 * E_BYTES;
    static_assert(OFF_W + 9216 <= 163584, "LDS");
    for (int item = bid; item < 256; item += nb) {
        const int chain = item >> 1, vh = item & 1, b = chain >> 4, h = (chain >> 1) & 7, d = chain & 1;
        bf16_t* Yd = d ? Y1 : Y0;
        auto tok_row = [&](int cc, int j) -> size_t { const bool ic = cc < NCX; const int ln = ic ? TC : T; const int ss = (ic ? cc : cc - NCX) * CH + j, t = d == 0 ? ss : ln - 1 - ss; return (ic ? (size_t)NLAT + (size_t)b * TC : (size_t)b * T) + t; };
        auto tok_ri = [&](int cc, int j) -> unsigned { const bool ic = cc < NCX; const int ln = ic ? TC : T; const int ss = (ic ? cc : cc - NCX) * CH + j, t = d == 0 ? ss : ln - 1 - ss; return (unsigned)((ic ? NLAT + b * TC : b * T) + t); };
        struct RawL { u32x4 p[18]; float kn; };
        auto ld_issue = [&](int cc, int lane, RawL& R) {
            const char* RWb = (const char*)RW;
#pragma unroll
            for (int it = 0; it < 8; ++it) { const int tok = it * 4 + (lane >> 4), p = lane & 15; R.p[it] = *(const u32x4*)(RWb + (tok_ri(cc, tok) * (unsigned)(RW_COLS * 2) + (unsigned)(3072 + 16 * p))); }
#pragma unroll
            for (int it = 0; it < 4; ++it) { const int tok = it * 8 + (lane >> 3), p = lane & 7; const unsigned o_ = tok_ri(cc, tok) * (unsigned)(RW_COLS * 2) + (unsigned)(h * 128 + 16 * p); R.p[8 + it] = *(const u32x4*)(RWb + o_); R.p[12 + it] = *(const u32x4*)(RWb + (o_ + 1024u)); }
#pragma unroll
            for (int it = 0; it < 2; ++it) { const int tok = it * 16 + (lane >> 2), p = lane & 3; R.p[16 + it] = *(const u32x4*)(RWb + (tok_ri(cc, tok) * (unsigned)(RW_COLS * 2) + (unsigned)(2048 + h * 128 + vh * 64 + 16 * p))); }
            R.kn = *(const float*)((const char*)KN + (tok_ri(cc, lane & 31) * 32u + (unsigned)(h * 4)));
            asm volatile("" ::: "memory");
        };
        auto ld_commit = [&](int cc, int lane, const RawL& R) {
            bf16_t* WD = (bf16_t*)(lds + OFF_D + (cc & 1) * D_BYTES); bf16_t* RI = WD + 2 * CH * 72; bf16_t* KI = RI + CH * 72; bf16_t* VI = KI + CH * 72; float* KNs = (float*)(VI + CH * 40);
#pragma unroll
            for (int it = 0; it < 8; ++it) { const int tok = it * 4 + (lane >> 4), p = lane & 15; *(u32x4*)(WD + (p >> 3) * (CH * 72) + tok * 72 + 8 * (p & 7)) = R.p[it]; }
#pragma unroll
            for (int it = 0; it < 4; ++it) { const int tok = it * 8 + (lane >> 3), p = lane & 7; *(u32x4*)(RI + tok * 72 + 8 * p) = R.p[8 + it]; *(u32x4*)(KI + tok * 72 + 8 * p) = R.p[12 + it]; }
#pragma unroll
            for (int it = 0; it < 2; ++it) { const int tok = it * 16 + (lane >> 2), p = lane & 3; *(u32x4*)(VI + tok * 40 + 8 * p) = R.p[16 + it]; }
            if (lane < 32) KNs[lane] = R.kn;
        };
        auto wt_src = [&](int it, int& k0, int& n0, int& rmul, int& radd, bf16_t*& dst) -> const float* {
            const int m = it >> 12, r = it & 4095, e = r >> 8, tt = r & 255; k0 = (tt >> 4) * 64; n0 = (tt & 15) * 64;
            const float* src = (m == 0 ? mw1 : m == 1 ? mw3 : mw2) + (size_t)e * 1024 * 1024; rmul = m == 2 ? 4 : 8; radd = m == 1 ? 4 : 0; dst = m == 2 ? W2 + (size_t)e * 1024 * 1024 : W13 + (size_t)e * 2048 * 1024;
            return src + (size_t)k0 * 1024 + n0; };
        auto wt_issue = [&](int it, int lane, float (&v)[64]) { int k0, n0, rmul, radd; bf16_t* dst; const float* sp = wt_src(it, k0, n0, rmul, radd, dst); const unsigned lo = (unsigned)lane * 4u;
            const unsigned long long pb = (unsigned long long)sp; const __attribute__((address_space(1))) char* sb = (const __attribute__((address_space(1))) char*)(((unsigned long long)(unsigned)__builtin_amdgcn_readfirstlane((int)(pb >> 32)) << 32) | (unsigned)__builtin_amdgcn_readfirstlane((int)pb));
#pragma unroll
            for (int i = 0; i < 64; ++i) v[i] = *(const __attribute__((address_space(1))) float*)(sb + ((unsigned)(i * 4096) + lo));
            asm volatile("" ::: "memory"); };
        auto wt_finish = [&](int it, int lane, const float (&v)[64]) { int k0, n0, rmul, radd; bf16_t* dst; (void)wt_src(it, k0, n0, rmul, radd, dst);
            u32x4* wl = (u32x4*)(lds + OFF_W);
            const unsigned long long pd = (unsigned long long)dst; __attribute__((address_space(1))) char* db = (__attribute__((address_space(1))) char*)(((unsigned long long)(unsigned)__builtin_amdgcn_readfirstlane((int)(pd >> 32)) << 32) | (unsigned)__builtin_amdgcn_readfirstlane((int)pd));
#pragma unroll
            for (int c = 0; c < 8; ++c) { u32x4 o; o.x = pk2(v[8 * c], v[8 * c + 1]); o.y = pk2(v[8 * c + 2], v[8 * c + 3]); o.z = pk2(v[8 * c + 4], v[8 * c + 5]); o.w = pk2(v[8 * c + 6], v[8 * c + 7]); wl[lane * 9 + c] = o; }
            asm volatile("s_waitcnt lgkmcnt(0)" ::: "memory");
#pragma unroll
            for (int j = 0; j < 8; ++j) { const int n = (lane >> 3) + 8 * j, c = lane & 7; const u32x4 o = wl[n * 9 + c];
                const int nn = n0 + n, row = (nn >> 2) * rmul + (nn & 3) + radd; *(__attribute__((address_space(1))) u32x4*)(db + (unsigned)((row * 1024 + k0 + 8 * c) * 2)) = o; }
            asm volatile("s_waitcnt lgkmcnt(0)" ::: "memory"); };
        struct PCst { bf16x8 bw[2], ba[2]; f32x4 w0c, a0c, kkc, kac; };
        PCst PC_;
        if (w >= 4) { const int lane = tid0 & 63, pw = w - 4, fr = lane & 15, fq = lane >> 4, i0 = 16 * pw + 4 * fq;
#pragma unroll
            for (int ks = 0; ks < 2; ++ks) { const size_t off = ((size_t)d * 512 + h * 64 + 16 * pw + fr) * 64 + ks * 32 + fq * 8; PC_.bw[ks] = *(const bf16x8*)(W2T + off); PC_.ba[ks] = *(const bf16x8*)(A2T + off); }
            PC_.w0c = *(const f32x4*)(w0 + d * 512 + h * 64 + i0); PC_.a0c = *(const f32x4*)(a0 + d * 512 + h * 64 + i0); PC_.kkc = *(const f32x4*)(k_k + h * 64 + i0); PC_.kac = *(const f32x4*)(k_a + h * 64 + i0); }
        auto prep = [&](int cc, int lane, int pw) {
            float* PCV = (float*)(lds + (cc & 1) * A_BYTES);
            const bf16_t* WD = (const bf16_t*)(lds + OFF_D + (cc & 1) * D_BYTES); const bf16_t* AD = WD + CH * 72; const bf16_t* RI = AD + CH * 72; const bf16_t* KI = RI + CH * 72; const bf16_t* VI = KI + CH * 72; const float* KNs = (const float*)(VI + CH * 40);
            bf16_t* RBp = (bf16_t*)(lds + OFF_B + (cc % 3) * B_BYTES); bf16_t* KBp = RBp + CH * 72; bf16_t* BBp = KBp + CH * 72; bf16_t* VTp = BBp + CH * 72; bf16_t* KKp = (bf16_t*)(lds + OFF_E + (cc & 1) * E_BYTES); bf16_t* KTp = KKp + CH * 72; bf16_t* BTp = KTp + 64 * 40;
            const int fr = lane & 15, fq = lane >> 4, i0 = 16 * pw + 4 * fq;
            { const int ptid = pw * 64 + lane, tk = ptid >> 3, part = ptid & 7; const u32x2 raw = *(const u32x2*)(VI + tk * 40 + 4 * part);
              bf16_t* vt = VTp + (4 * part) * 40 + tk; vt[0] = (bf16_t)raw.x; vt[40] = (bf16_t)(raw.x >> 16); vt[80] = (bf16_t)raw.y; vt[120] = (bf16_t)(raw.y >> 16); }
            const f32x4 w0c = PC_.w0c, a0c = PC_.a0c, kkc = PC_.kkc, kac = PC_.kac;
            f32x4 run = {0.f, 0.f, 0.f, 0.f};
#pragma unroll
            for (int mt = 0; mt < 2; ++mt) {
                const int tk = 16 * mt + fr;
                f32x4 aw = {0.f, 0.f, 0.f, 0.f}, aa = {0.f, 0.f, 0.f, 0.f};
#pragma unroll
                for (int ks = 0; ks < 2; ++ks) { const bf16x8 fw = *(const bf16x8*)(WD + tk * 72 + ks * 32 + fq * 8), fa = *(const bf16x8*)(AD + tk * 72 + ks * 32 + fq * 8);
                    aw = __builtin_amdgcn_mfma_f32_16x16x32_bf16(PC_.bw[ks], fw, aw, 0, 0, 0); aa = __builtin_amdgcn_mfma_f32_16x16x32_bf16(PC_.ba[ks], fa, aa, 0, 0, 0); }
                const u32x2 rr = *(const u32x2*)(RI + tk * 72 + i0), kr = *(const u32x2*)(KI + tk * 72 + i0);
                const f32x4 r4 = {__builtin_bit_cast(float, rr.x << 16), __builtin_bit_cast(float, rr.x & 0xffff0000u), __builtin_bit_cast(float, rr.y << 16), __builtin_bit_cast(float, rr.y & 0xffff0000u)};
                const f32x4 k4 = {__builtin_bit_cast(float, kr.x << 16), __builtin_bit_cast(float, kr.x & 0xffff0000u), __builtin_bit_cast(float, kr.y << 16), __builtin_bit_cast(float, kr.y & 0xffff0000u)};
                const float inv = KNs[tk];
                f32x4 kkt, bt, kt, rt, tot;
#pragma unroll
                for (int r = 0; r < 4; ++r) { const float L = -0.6065306597126334f * fsigmoid(aw[r] + w0c[r]); float cs = L;
                    cs += dpp_mov<0x111>(cs); cs += dpp_mov<0x112>(cs); cs += dpp_mov<0x114>(cs); cs += dpp_mov<0x118>(cs);
                    tot[r] = red16(L);
                    const float cum = cs + run[r]; const float e1 = __expf(cum), ei = __builtin_amdgcn_rcpf(e1), e0 = __expf(cum - L);
                    const float a = fsigmoid(aa[r] + a0c[r]); const float kkn = k4[r] * kkc[r] * inv;
                    kkt[r] = kkn * e0; bt[r] = kkn * a * ei; kt[r] = k4[r] * (1.f + (a - 1.f) * kac[r]) * ei; rt[r] = r4[r] * e1; }
                run += tot;
                const u32x2 kp = {pk2(kt.x, kt.y), pk2(kt.z, kt.w)}, bp = {pk2(bt.x, bt.y), pk2(bt.z, bt.w)};
                *(u32x2*)(RBp + tk * 72 + i0) = (u32x2){pk2(rt.x, rt.y), pk2(rt.z, rt.w)}; *(u32x2*)(KBp + tk * 72 + i0) = kp; *(u32x2*)(BBp + tk * 72 + i0) = bp; *(u32x2*)(KKp + tk * 72 + i0) = (u32x2){pk2(kkt.x, kkt.y), pk2(kkt.z, kkt.w)};
                bf16_t* ktc = KTp + i0 * 40 + tk; ktc[0] = (bf16_t)kp.x; ktc[40] = (bf16_t)(kp.x >> 16); ktc[80] = (bf16_t)kp.y; ktc[120] = (bf16_t)(kp.y >> 16);
                bf16_t* btc = BTp + i0 * 40 + tk; btc[0] = (bf16_t)bp.x; btc[40] = (bf16_t)(bp.x >> 16); btc[80] = (bf16_t)bp.y; btc[120] = (bf16_t)(bp.y >> 16);
            }
            if (fr == 0) *(f32x4*)(PCV + i0) = (f32x4){__expf(run.x), __expf(run.y), __expf(run.z), __expf(run.w)};
        };
        auto ycomp = [&](int cc, int lane, int mt) {
            const bf16_t* RBp = (const bf16_t*)(lds + OFF_B + (cc % 3) * B_BYTES); const bf16_t* KBp = RBp + CH * 72; const bf16_t* BBp = KBp + CH * 72; const bf16_t* VTp = BBp + CH * 72;
            const float* SAF = (const float*)(lds + OFF_C + (cc & 1) * C_BYTES); const bf16_t* S0B = (const bf16_t*)(lds + OFF_C + (cc & 1) * C_BYTES + 32 * 144);
            const int fr = lane & 15, q = lane >> 4;
            const bf16x8 r0 = *(const bf16x8*)(RBp + (16 * mt + fr) * 72 + 8 * q), r1 = *(const bf16x8*)(RBp + (16 * mt + fr) * 72 + 32 + 8 * q);
            const f32x4 z4 = {0.f, 0.f, 0.f, 0.f};
            f32x4 gk0, gb0, gk1 = z4, gb1 = z4;
            { const bf16x8 k0 = *(const bf16x8*)(KBp + fr * 72 + 8 * q), k1 = *(const bf16x8*)(KBp + fr * 72 + 32 + 8 * q), b0 = *(const bf16x8*)(BBp + fr * 72 + 8 * q), b1 = *(const bf16x8*)(BBp + fr * 72 + 32 + 8 * q);
              gk0 = __builtin_amdgcn_mfma_f32_16x16x32_bf16(k0, r0, z4, 0, 0, 0); gk0 = __builtin_amdgcn_mfma_f32_16x16x32_bf16(k1, r1, gk0, 0, 0, 0);
              gb0 = __builtin_amdgcn_mfma_f32_16x16x32_bf16(b0, r0, z4, 0, 0, 0); gb0 = __builtin_amdgcn_mfma_f32_16x16x32_bf16(b1, r1, gb0, 0, 0, 0); }
            if (mt == 1) {
              const bf16x8 k0 = *(const bf16x8*)(KBp + (16 + fr) * 72 + 8 * q), k1 = *(const bf16x8*)(KBp + (16 + fr) * 72 + 32 + 8 * q), b0 = *(const bf16x8*)(BBp + (16 + fr) * 72 + 8 * q), b1 = *(const bf16x8*)(BBp + (16 + fr) * 72 + 32 + 8 * q);
              gk1 = __builtin_amdgcn_mfma_f32_16x16x32_bf16(k0, r0, z4, 0, 0, 0); gk1 = __builtin_amdgcn_mfma_f32_16x16x32_bf16(k1, r1, gk1, 0, 0, 0);
              gb1 = __builtin_amdgcn_mfma_f32_16x16x32_bf16(b0, r0, z4, 0, 0, 0); gb1 = __builtin_amdgcn_mfma_f32_16x16x32_bf16(b1, r1, gb1, 0, 0, 0);
#pragma unroll
              for (int r = 0; r < 4; ++r) { const bool keep = 4 * q + r <= fr; gk1[r] = keep ? gk1[r] : 0.f; gb1[r] = keep ? gb1[r] : 0.f; }
            } else {
#pragma unroll
              for (int r = 0; r < 4; ++r) { const bool keep = 4 * q + r <= fr; gk0[r] = keep ? gk0[r] : 0.f; gb0[r] = keep ? gb0[r] : 0.f; }
            }
            const u32x4 gkp = {pk2(gk0[0], gk0[1]), pk2(gk0[2], gk0[3]), pk2(gk1[0], gk1[1]), pk2(gk1[2], gk1[3])};
            const u32x4 gbp = {pk2(-gb0[0], -gb0[1]), pk2(-gb0[2], -gb0[3]), pk2(-gb1[0], -gb1[1]), pk2(-gb1[2], -gb1[3])};
            bf16_t* yrow = Yd + tok_row(cc, 16 * mt + fr) * RWD + h * 64 + vh * 32 + 4 * q;
#pragma unroll
            for (int nt = 0; nt < 2; ++nt) { const int ri = 16 * nt + fr;
                const u32x2 v0 = *(const u32x2*)(VTp + ri * 40 + 4 * q), v1 = *(const u32x2*)(VTp + ri * 40 + 16 + 4 * q);
                const f32x4 s0 = *(const f32x4*)(SAF + ri * 36 + 4 * q), s1 = *(const f32x4*)(SAF + ri * 36 + 16 + 4 * q);
                const u32x4 vtp = {v0.x, v0.y, v1.x, v1.y}, sap = {pk2(s0.x, s0.y), pk2(s0.z, s0.w), pk2(s1.x, s1.y), pk2(s1.z, s1.w)};
                const bf16x8 z0 = *(const bf16x8*)(S0B + ri * 72 + 8 * q), z1 = *(const bf16x8*)(S0B + ri * 72 + 32 + 8 * q);
                f32x4 y = __builtin_amdgcn_mfma_f32_16x16x32_bf16(__builtin_bit_cast(bf16x8, vtp), __builtin_bit_cast(bf16x8, gkp), z4, 0, 0, 0);
                y = __builtin_amdgcn_mfma_f32_16x16x32_bf16(__builtin_bit_cast(bf16x8, sap), __builtin_bit_cast(bf16x8, gbp), y, 0, 0, 0);
                y = __builtin_amdgcn_mfma_f32_16x16x32_bf16(z0, r0, y, 0, 0, 0); y = __builtin_amdgcn_mfma_f32_16x16x32_bf16(z1, r1, y, 0, 0, 0);
                *(u32x2*)(yrow + 16 * nt) = (u32x2){pk2(y[0], y[1]), pk2(y[2], y[3])}; }
        };
        f32x4 ST[4][2];
#pragma unroll
        for (int u = 0; u < 4; ++u) { ST[u][0] = (f32x4){0.f, 0.f, 0.f, 0.f}; ST[u][1] = (f32x4){0.f, 0.f, 0.f, 0.f}; }
        __syncthreads();
        if (w == 3) {
#pragma unroll 1
            for (int cc = 0; cc < 2; ++cc) { int tidp = tid0; asm volatile("" : "+v"(tidp)); RawL rl; ld_issue(cc, tidp & 63, rl); ld_commit(cc, tidp & 63, rl); } }
        __syncthreads();
        if (w >= 4) prep(0, tid0 & 63, w - 4);
        __syncthreads();
        if (w == 3) {
            for (int c = 0; c < NCH; c += 2) {
                int tid = tid0; asm volatile("" : "+v"(tid));
                const int lane = tid & 63, wit = item + 256 * (c >> 1); const bool hw = (c >> 1) < 48;
                float wv[64];
                { RawL ra; ld_issue(c + 2 < NCH ? c + 2 : NCH - 1, lane, ra); if (hw) wt_issue(wit, lane, wv); ld_commit(c + 2, lane, ra); }
                __syncthreads();
                { RawL rb; ld_issue(c + 3 < NCH ? c + 3 : NCH - 1, lane, rb); if (hw) wt_finish(wit, lane, wv); ld_commit(c + 3, lane, rb); }
                __syncthreads();
            }
        } else
        for (int c = 0; c < NCH; ++c) {
            int tid = tid0; asm volatile("" : "+v"(tid));
            const int lane = tid & 63;
            if (w == 0) {
                const float* PCV = (const float*)(lds + (c & 1) * A_BYTES);
                const bf16_t* RBp = (const bf16_t*)(lds + OFF_B + (c % 3) * B_BYTES); const bf16_t* KBp = RBp + CH * 72; const bf16_t* BBp = KBp + CH * 72; const bf16_t* VTp = BBp + CH * 72; const bf16_t* KKp = (const bf16_t*)(lds + OFF_E + (c & 1) * E_BYTES); const bf16_t* KTp = KKp + CH * 72; const bf16_t* BTp = KTp + 64 * 40;
                float* SAF = (float*)(lds + OFF_C + (c & 1) * C_BYTES); bf16_t* S0B = (bf16_t*)(lds + OFF_C + (c & 1) * C_BYTES + 32 * 144);
                const int fr = lane & 15, q = lane >> 4;
                const f32x4 z4 = {0.f, 0.f, 0.f, 0.f};
                auto mf = [](bf16x8 a_, bf16x8 b_, f32x4 c_) -> f32x4 { return __builtin_amdgcn_mfma_f32_16x16x32_bf16(a_, b_, c_, 0, 0, 0); };
                auto opA = [](f32x4 x) -> bf16x8 { const u32x4 v = {pk2(x[0], x[1]), pk2(x[2], x[3]), 0u, 0u}; return __builtin_bit_cast(bf16x8, v); };
                auto opN = [](f32x4 x) -> bf16x8 { const u32x4 v = {pk2(-x[0], -x[1]), pk2(-x[2], -x[3]), 0u, 0u}; return __builtin_bit_cast(bf16x8, v); };
                typedef short bf16x4_ __attribute__((ext_vector_type(4)));
                auto m16 = [](bf16x4_ a_, bf16x4_ b_, f32x4 c_) -> f32x4 { return __builtin_amdgcn_mfma_f32_16x16x16bf16_1k(a_, b_, c_, 0, 0, 0); };
                auto o4 = [](f32x4 x) -> bf16x4_ { const u32x2 v = {pk2(x[0], x[1]), pk2(x[2], x[3])}; return __builtin_bit_cast(bf16x4_, v); };
                auto o4n = [](f32x4 x) -> bf16x4_ { const u32x2 v = {pk2(-x[0], -x[1]), pk2(-x[2], -x[3])}; return __builtin_bit_cast(bf16x4_, v); };
                auto op2 = [](f32x4 lo, f32x4 hi) -> bf16x8 { const u32x4 v = {pk2(lo[0], lo[1]), pk2(lo[2], lo[3]), pk2(hi[0], hi[1]), pk2(hi[2], hi[3])}; return __builtin_bit_cast(bf16x8, v); };
                auto op2n = [](f32x4 lo, f32x4 hi) -> bf16x8 { const u32x4 v = {pk2(-lo[0], -lo[1]), pk2(-lo[2], -lo[3]), pk2(-hi[0], -hi[1]), pk2(-hi[2], -hi[3])}; return __builtin_bit_cast(bf16x8, v); };
                auto rf = [&](const bf16_t* X, int stride, int r0, int k0) -> bf16x8 { return *(const bf16x8*)(X + (r0 + fr) * stride + k0 + 8 * q); };
                auto pf = [&](const bf16_t* X, int stride, int r0, int k0) -> bf16x8 { const u32x2 a_ = *(const u32x2*)(X + (r0 + fr) * stride + k0 + 4 * q), b_ = *(const u32x2*)(X + (r0 + fr) * stride + k0 + 16 + 4 * q);
                    const u32x4 v = {a_.x, a_.y, b_.x, b_.y}; return __builtin_bit_cast(bf16x8, v); };
                bf16x8 kkf[2][2], bbf[2][2], kf[2][2];
#pragma unroll
                for (int a_ = 0; a_ < 2; ++a_)
#pragma unroll
                    for (int ks = 0; ks < 2; ++ks) { kkf[a_][ks] = rf(KKp, 72, 16 * a_, 32 * ks); bbf[a_][ks] = rf(BBp, 72, 16 * a_, 32 * ks); kf[a_][ks] = rf(KBp, 72, 16 * a_, 32 * ks); }
                auto gram = [&](const bf16x8 (&P)[2], const bf16x8 (&Q)[2]) -> f32x4 { return mf(P[1], Q[1], mf(P[0], Q[0], z4)); };
                bool lo_[4], up_[4], dg_[4];
#pragma unroll
                for (int r = 0; r < 4; ++r) { lo_[r] = fr < 4 * q + r; up_[r] = 4 * q + r < fr; dg_[r] = 4 * q + r == fr; }
                f32x4 TT[2];
#pragma unroll
                for (int bl = 0; bl < 2; ++bl) {
                    f32x4 N = gram(kkf[bl], bbf[bl]), NT = gram(bbf[bl], kkf[bl]), PT;
#pragma unroll
                    for (int r = 0; r < 4; ++r) { N[r] = lo_[r] ? -N[r] : 0.f; NT[r] = up_[r] ? -NT[r] : 0.f; PT[r] = NT[r] + (dg_[r] ? 1.f : 0.f); }
                    const f32x4 N2 = m16(o4(NT), o4(N), z4), N2T = m16(o4(N), o4(NT), z4); PT = m16(o4(N2), o4(PT), PT);
                    const f32x4 N4 = m16(o4(N2T), o4(N2), z4), N4T = m16(o4(N2), o4(N2T), z4); PT = m16(o4(N4), o4(PT), PT);
                    const f32x4 N8 = m16(o4(N4T), o4(N4), z4); PT = m16(o4(N8), o4(PT), PT);
                    TT[bl] = PT; }
                const f32x4 L21T = gram(bbf[0], kkf[1]);
                f32x4 AkT00 = gram(kf[0], kkf[0]), AkT10 = gram(kf[0], kkf[1]), AkT11 = gram(kf[1], kkf[1]);
#pragma unroll
                for (int r = 0; r < 4; ++r) { AkT00[r] = up_[r] ? AkT00[r] : 0.f; AkT11[r] = up_[r] ? AkT11[r] : 0.f; }
                f32x4 RH[2][2];
                { const bf16x8 a0op = opA(AkT00), a1op = op2(AkT10, AkT11);
#pragma unroll
                  for (int cI = 0; cI < 2; ++cI) { const bf16x8 vp_ = pf(VTp, 40, 16 * cI, 0); RH[0][cI] = mf(a0op, vp_, z4); RH[1][cI] = mf(a1op, vp_, z4); } }
                bf16x8 sop[2][2];
#pragma unroll
                for (int ks = 0; ks < 2; ++ks)
#pragma unroll
                    for (int cI = 0; cI < 2; ++cI) { sop[ks][cI] = op2(ST[2 * ks][cI], ST[2 * ks + 1][cI]); const u32x4 sv = __builtin_bit_cast(u32x4, sop[ks][cI]);
                        *(u32x2*)(S0B + (16 * cI + fr) * 72 + 32 * ks + 4 * q) = (u32x2){sv.x, sv.y}; *(u32x2*)(S0B + (16 * cI + fr) * 72 + 32 * ks + 16 + 4 * q) = (u32x2){sv.z, sv.w}; }
#pragma unroll
                for (int a_ = 0; a_ < 2; ++a_)
#pragma unroll
                    for (int ks = 0; ks < 2; ++ks) { const bf16x8 kp_ = pf(KKp, 72, 16 * a_, 32 * ks); RH[a_][0] = mf(kp_, sop[ks][0], RH[a_][0]); RH[a_][1] = mf(kp_, sop[ks][1], RH[a_][1]); }
                bf16x8 nsa[2];
                { const bf16x4_ t0op = o4(TT[0]), t1op = o4(TT[1]), l21n = o4n(L21T);
#pragma unroll
                  for (int cI = 0; cI < 2; ++cI) { const f32x4 sa0 = m16(t0op, o4(RH[0][cI]), z4); const f32x4 r2 = m16(l21n, o4(sa0), RH[1][cI]); const f32x4 sa1 = m16(t1op, o4(r2), z4);
                      *(f32x4*)(SAF + (16 * cI + fr) * 36 + 4 * q) = sa0; *(f32x4*)(SAF + (16 * cI + fr) * 36 + 16 + 4 * q) = sa1; nsa[cI] = op2n(sa0, sa1); } }
                { const bf16x8 vr0 = rf(VTp, 40, 0, 0), vr1 = rf(VTp, 40, 16, 0);
#pragma unroll
                  for (int u = 0; u < 4; ++u) { const bf16x8 kt_ = rf(KTp, 40, 16 * u, 0), bt_ = pf(BTp, 40, 16 * u, 0); const f32x4 pc = *(const f32x4*)(PCV + 16 * u + 4 * q);
                      ST[u][0] = mf(bt_, nsa[0], mf(kt_, vr0, ST[u][0])) * pc; ST[u][1] = mf(bt_, nsa[1], mf(kt_, vr1, ST[u][1])) * pc; } }
            } else if (w < 3) {
                if (c - 1 >= NCX) ycomp(c - 1, lane, w - 1);
            } else {
                if (c + 1 < NCH) prep(c + 1, lane, w - 4);
            }
            __syncthreads();
        }
        if (w == 1 || w == 2) ycomp(NCH - 1, tid0 & 63, w - 1);
    }
}
__device__ __forceinline__ void phase_rwkv_final(const bf16_t* __restrict__ RW, const bf16_t* __restrict__ Y0, const bf16_t* __restrict__ Y1, const float* __restrict__ a0, const bf16_t* __restrict__ A2T,
                                                 const bf16_t* __restrict__ G2T, const float* __restrict__ k_a, const float* __restrict__ r_k, const float* __restrict__ lnx_g, const float* __restrict__ lnx_b, bf16_t* __restrict__ O, unsigned char* lds, int bid, int nb) {
    const int tid = otid(), lane = tid & 63, h = __builtin_amdgcn_readfirstlane(tid >> 6), fr = lane & 15, fq = lane >> 4;
    bf16_t* const IM = (bf16_t*)(lds + h * 11520);
    const int lr = lane >> 3, lc = lane & 7;
    for (int tile = bid; tile < NLAT / 64; tile += nb) {
#pragma unroll 1
        for (int mt = 0; mt < 4; ++mt) {
            const size_t rowb = (size_t)tile * 64 + 16 * mt;
            asm volatile("s_waitcnt lgkmcnt(0)" ::: "memory");
#pragma unroll
            for (int g = 0; g < 2; ++g) { const size_t row = rowb + 8 * g + lr; const bf16_t* p0 = RW + row * RW_COLS + h * 64 + 8 * lc; const int lo = (8 * g + lr) * 72 + 8 * lc;
                const u32x4 vr = *(const u32x4*)(p0), vk = *(const u32x4*)(p0 + 512), vv = *(const u32x4*)(p0 + 1024), v0 = *(const u32x4*)(Y0 + row * RWD + h * 64 + 8 * lc), v1 = *(const u32x4*)(Y1 + row * RWD + h * 64 + 8 * lc);
                *(u32x4*)(IM + lo) = vr; *(u32x4*)(IM + 1152 + lo) = vk; *(u32x4*)(IM + 2304 + lo) = vv; *(u32x4*)(IM + 3456 + lo) = v0; *(u32x4*)(IM + 4608 + lo) = v1; }
            const bf16_t* pa = RW + (rowb + fr) * RW_COLS;
            bf16x8 fa[2], fg[4];
#pragma unroll
            for (int ks = 0; ks < 2; ++ks) fa[ks] = *(const bf16x8*)(pa + 1600 + ks * 32 + fq * 8);
#pragma unroll
            for (int ks = 0; ks < 4; ++ks) fg[ks] = *(const bf16x8*)(pa + 1664 + ks * 32 + fq * 8);
            asm volatile("s_waitcnt vmcnt(0) lgkmcnt(0)" ::: "memory");
            float bsum = 0.f, ysum = 0.f, ysq = 0.f; f32x4 yv[4];
#pragma unroll
            for (int nt = 0; nt < 4; ++nt) {
                const int c0 = h * 64 + 16 * nt + 4 * fq, lo = fr * 72 + 16 * nt + 4 * fq; f32x4 aa0 = {0.f, 0.f, 0.f, 0.f}, aa1 = {0.f, 0.f, 0.f, 0.f};
#pragma unroll
                for (int ks = 0; ks < 2; ++ks) { const bf16x8 b0 = *(const bf16x8*)(A2T + ((size_t)(h * 64 + 16 * nt + fr)) * 64 + ks * 32 + fq * 8), b1 = *(const bf16x8*)(A2T + ((size_t)(512 + h * 64 + 16 * nt + fr)) * 64 + ks * 32 + fq * 8);
                    aa0 = __builtin_amdgcn_mfma_f32_16x16x32_bf16(b0, fa[ks], aa0, 0, 0, 0); aa1 = __builtin_amdgcn_mfma_f32_16x16x32_bf16(b1, fa[ks], aa1, 0, 0, 0); }
                const f32x4 r = ld_bf16x4(IM + lo), k = ld_bf16x4(IM + 1152 + lo); yv[nt] = ld_bf16x4(IM + 3456 + lo) + ld_bf16x4(IM + 4608 + lo);
                const f32x4 a00 = *(const f32x4*)(a0 + c0), a01 = *(const f32x4*)(a0 + 512 + c0), ka = *(const f32x4*)(k_a + c0), rk = *(const f32x4*)(r_k + c0);
#pragma unroll
                for (int j = 0; j < 4; ++j) { const float av0 = fsigmoid(aa0[j] + a00[j]), av1 = fsigmoid(aa1[j] + a01[j]); const float ksum = k[j] * (2.f + (av0 + av1 - 2.f) * ka[j]); bsum += r[j] * ksum * rk[j]; ysum += yv[nt][j]; ysq += yv[nt][j] * yv[nt][j]; }
                asm volatile("" ::: "memory");
            }
            bsum += __shfl_xor(bsum, 16); bsum += __shfl_xor(bsum, 32); ysum += __shfl_xor(ysum, 16); ysum += __shfl_xor(ysum, 32); ysq += __shfl_xor(ysq, 16); ysq += __shfl_xor(ysq, 32);
            const float mean = ysum * (1.f / 64.f); const float var = fmaxf(ysq * (1.f / 64.f) - mean * mean, 0.f); const float rstd = rsqrtf(var + LNX_EPS);
#pragma unroll
            for (int nt = 0; nt < 4; ++nt) {
                const int c0 = h * 64 + 16 * nt + 4 * fq, lo = fr * 72 + 16 * nt + 4 * fq; f32x4 gg = {0.f, 0.f, 0.f, 0.f};
#pragma unroll
                for (int ks = 0; ks < 4; ++ks) { const bf16x8 bg = *(const bf16x8*)(G2T + ((size_t)(h * 64 + 16 * nt + fr)) * 128 + ks * 32 + fq * 8); gg = __builtin_amdgcn_mfma_f32_16x16x32_bf16(bg, fg[ks], gg, 0, 0, 0); }
                const f32x4 v = ld_bf16x4(IM + 2304 + lo); const f32x4 lg = *(const f32x4*)(lnx_g + c0), lb = *(const f32x4*)(lnx_b + c0); f32x4 o;
#pragma unroll
                for (int j = 0; j < 4; ++j) o[j] = ((yv[nt][j] - mean) * rstd * lg[j] + lb[j] + bsum * v[j]) * gg[j];
                st_bf16x4(IM + lo, o);
                asm volatile("" ::: "memory");
            }
            asm volatile("s_waitcnt lgkmcnt(0)" ::: "memory");
#pragma unroll
            for (int g = 0; g < 2; ++g) { const size_t row = rowb + 8 * g + lr; *(u32x4*)(O + row * RWD + h * 64 + 8 * lc) = *(const u32x4*)(IM + (8 * g + lr) * 72 + 8 * lc); }
        }
    }
}
__device__ __forceinline__ void phase_lru_final(const bf16_t* __restrict__ H0, const bf16_t* __restrict__ H1, const bf16_t* __restrict__ GB, bf16_t* __restrict__ HL, int bid, int nb) {
    const size_t n8 = (size_t)NLAT * LWD / 8, stride = (size_t)nb * 512;
    for (size_t i = (size_t)bid * 512 + otid(); i < n8; i += 4 * stride) { u32x4 a[4], c[4], g[4];
#pragma unroll
        for (int q = 0; q < 4; ++q) { const size_t k = i + q * stride; if (k < n8) { a[q] = ((const u32x4*)H0)[k]; c[q] = ((const u32x4*)H1)[k]; g[q] = ((const u32x4*)GB)[k]; } }
#pragma unroll
        for (int q = 0; q < 4; ++q) { const size_t k = i + q * stride; if (k < n8) { float fa[8], fc[8], fg[8]; unpack8(a[q], fa); unpack8(c[q], fc); unpack8(g[q], fg); u32x4 o;
            o.x = pk2((fa[0] + fc[0]) * fg[0], (fa[1] + fc[1]) * fg[1]); o.y = pk2((fa[2] + fc[2]) * fg[2], (fa[3] + fc[3]) * fg[3]); o.z = pk2((fa[4] + fc[4]) * fg[4], (fa[5] + fc[5]) * fg[5]); o.w = pk2((fa[6] + fc[6]) * fg[6], (fa[7] + fc[7]) * fg[7]);
            ((u32x4*)HL)[k] = o; } }
    }
}
template <int CTRL> __device__ __forceinline__ float dpp_max(float x) { return fmaxf(x, __builtin_bit_cast(float, __builtin_amdgcn_update_dpp(0, __builtin_bit_cast(int, x), CTRL, 0xF, 0xF, true))); }
__device__ __forceinline__ float max16(float x) { x = dpp_max<0xB1>(x); x = dpp_max<0x4E>(x); x = dpp_max<0x141>(x); x = dpp_max<0x140>(x); return x; }
__device__ __forceinline__ void phase_router(const float* __restrict__ XMID, const float* __restrict__ g2n, const float* __restrict__ MOD, const float* __restrict__ router, float* __restrict__ AFF, const float* __restrict__ SSQ, bf16_t* __restrict__ H2, int bid, int nb) {
    const int tid = otid(), lane = tid & 63, w = tid >> 6, e = lane & 15, q = lane >> 4;
    for (int tile = bid * 8 + w; tile < NLAT / 16; tile += nb * 8) {
        const int row0 = tile * 16, b = row0 / T;
        float rstd; { const f32x4* sp_ = (const f32x4*)(SSQ + (size_t)(row0 + e) * 16); const f32x4 s0 = sp_[0], s1 = sp_[1], s2 = sp_[2], s3 = sp_[3];
            const float ssq = (((s0.x + s0.y) + (s0.z + s0.w)) + ((s1.x + s1.y) + (s1.z + s1.w))) + (((s2.x + s2.y) + (s2.z + s2.w)) + ((s3.x + s3.y) + (s3.z + s3.w))); rstd = rsqrtf(ssq * (1.f / D) + RMS_EPS); }
        const float* xr = XMID + (size_t)(row0 + e) * D + 4 * q; const float* gp = g2n + 4 * q; const float* scp = MOD + (size_t)b * 6144 + 4096 + 4 * q; const float* shp = MOD + (size_t)b * 6144 + 3072 + 4 * q; const float* rp = router + (4 * q) * 16 + e;
        bf16_t* hp = H2 + (size_t)(row0 + e) * D + 4 * q;
        f32x4 acc = {0.f, 0.f, 0.f, 0.f};
#pragma unroll 1
        for (int kc = 0; kc < D; kc += 256) {
            f32x4 xq[16];
#pragma unroll
            for (int u = 0; u < 16; ++u) xq[u] = *(const f32x4*)(xr + kc + 16 * u);
#pragma unroll
            for (int u = 0; u < 16; ++u) { const int kb = kc + 16 * u;
                const f32x4 gv = *(const f32x4*)(gp + kb), sv = *(const f32x4*)(scp + kb), hv = *(const f32x4*)(shp + kb);
                const f32x4 av = (xq[u] * rstd * gv) * (sv + 1.f) + hv;
                u32x2 o; o.x = pk2(av.x, av.y); o.y = pk2(av.z, av.w); *(u32x2*)(hp + kb) = o;
#pragma unroll
                for (int c = 0; c < 4; ++c) acc = __builtin_amdgcn_mfma_f32_16x16x4f32(av[c], rp[(kb + c) * 16], acc, 0, 0, 0); }
        }
#pragma unroll
        for (int r = 0; r < 4; ++r) { const int tok = 4 * q + r; const float lg = acc[r];
            const float mx = max16(lg); const float ex = __expf(lg - mx); const float sm = red16(ex);
            AFF[((size_t)b * NE + e) * T + (row0 & (T - 1)) + tok] = ex / sm; }
    }
}
__device__ __forceinline__ void phase_topk(const float* __restrict__ AFF, int* __restrict__ IDX, float* __restrict__ GATE, int* __restrict__ SLOT, unsigned char* lds, int bid, int nb) {
    unsigned* hist = (unsigned*)lds;
    unsigned* sel = (unsigned*)(lds + 1024);
    unsigned* wsum = (unsigned*)(lds + 1040);
    const int tid = otid(), lane = tid & 63, w = tid >> 6;
    for (int be = bid; be < NB * NE; be += nb) {
        const int b = be >> 4, e = be & 15;
        unsigned key[8];
        { const u32x4* src = (const u32x4*)(AFF + (size_t)be * T + tid * 8); const u32x4 v0 = src[0], v1 = src[1]; key[0] = v0.x; key[1] = v0.y; key[2] = v0.z; key[3] = v0.w; key[4] = v1.x; key[5] = v1.y; key[6] = v1.z; key[7] = v1.w; }
        unsigned prefix = 0u, kk = CAP;
#pragma unroll 1
        for (int pass = 0; pass < 4; ++pass) {
            const int shift = 24 - 8 * pass; const unsigned himask = pass == 0 ? 0u : (0xffffffffu << (shift + 8));
            __syncthreads();
            if (tid < 256) hist[tid] = 0u;
            __syncthreads();
#pragma unroll
            for (int q = 0; q < 8; ++q) if ((key[q] & himask) == prefix) atomicAdd(&hist[(key[q] >> shift) & 255u], 1u);
            __syncthreads();
            if (w == 0) {
                unsigned c[4]; unsigned tot = 0u;
#pragma unroll
                for (int j = 0; j < 4; ++j) { c[j] = hist[255 - 4 * lane - j]; tot += c[j]; }
                unsigned inc = tot;
#pragma unroll
                for (int o = 1; o < 64; o <<= 1) { const unsigned t = __shfl_up(inc, o); if (lane >= o) inc += t; }
                unsigned before = inc - tot;
#pragma unroll
                for (int j = 0; j < 4; ++j) { if (before < kk && kk <= before + c[j]) { sel[0] = (unsigned)(255 - 4 * lane - j); sel[1] = kk - before; } before += c[j]; }
            }
            __syncthreads();
            prefix |= sel[0] << shift; kk = sel[1];
        }
        unsigned ngt = 0u, neq = 0u;
#pragma unroll
        for (int q = 0; q < 8; ++q) { ngt += key[q] > prefix ? 1u : 0u; neq += key[q] == prefix ? 1u : 0u; }
        unsigned pk = (ngt << 16) | neq, inc = pk;
#pragma unroll
        for (int o = 1; o < 64; o <<= 1) { const unsigned t = __shfl_up(inc, o); if (lane >= o) inc += t; }
        __syncthreads();
        if (lane == 63) wsum[w] = inc;
        __syncthreads();
        unsigned base = 0u;
#pragma unroll
        for (int ww = 0; ww < 8; ++ww) if (ww < w) base += wsum[ww];
        unsigned ex = base + inc - pk; unsigned gt_before = ex >> 16, eq_before = ex & 0xffffu;
#pragma unroll
        for (int q = 0; q < 8; ++q) { const int i = tid * 8 + q; const bool isgt = key[q] > prefix, iseq = key[q] == prefix; const bool take = isgt || (iseq && eq_before < kk);
            const unsigned slot = gt_before + (eq_before < kk ? eq_before : kk);
            if (take) { IDX[(size_t)be * CAP + slot] = i; GATE[(size_t)be * CAP + slot] = __builtin_bit_cast(float, key[q]); }
            SLOT[((size_t)b * T + i) * NE + e] = take ? (int)slot : -1;
            gt_before += isgt ? 1u : 0u; eq_before += iseq ? 1u : 0u; }
    }
}
__device__ __forceinline__ void phase_final(const float* __restrict__ XMID, const bf16_t* __restrict__ YE, const int* __restrict__ SLOT, const float* __restrict__ MOD, const float* __restrict__ fg, float* __restrict__ out, int bid, int nb) {
    const int tid = otid(), lane = tid & 63, p = lane & 15, gq = bid * 32 + (tid >> 4), NGQ = nb * 32;
    for (int r = gq; r < NLAT; r += NGQ) {
        const int b = r / T; const float* mr = MOD + (size_t)b * 6144 + 5120;
        const int4 s0 = *(const int4*)(SLOT + (size_t)r * NE), s1 = *(const int4*)(SLOT + (size_t)r * NE + 4), s2 = *(const int4*)(SLOT + (size_t)r * NE + 8), s3 = *(const int4*)(SLOT + (size_t)r * NE + 12);
        const int sl[16] = {s0.x, s0.y, s0.z, s0.w, s1.x, s1.y, s1.z, s1.w, s2.x, s2.y, s2.z, s2.w, s3.x, s3.y, s3.z, s3.w};
        f32x4 acc[16];
#pragma unroll
        for (int j = 0; j < 16; ++j) acc[j] = (f32x4){0.f, 0.f, 0.f, 0.f};
#pragma unroll
        for (int e = 0; e < NE; ++e) if (sl[e] >= 0) { const u32x4* yr = (const u32x4*)(YE + ((size_t)(b * NE + e) * CAP + sl[e]) * D) + p;
#pragma unroll
            for (int j = 0; j < 8; ++j) { const u32x4 v = yr[16 * j];
                acc[2 * j] += (f32x4){__builtin_bit_cast(float, v.x << 16), __builtin_bit_cast(float, v.x & 0xffff0000u), __builtin_bit_cast(float, v.y << 16), __builtin_bit_cast(float, v.y & 0xffff0000u)};
                acc[2 * j + 1] += (f32x4){__builtin_bit_cast(float, v.z << 16), __builtin_bit_cast(float, v.z & 0xffff0000u), __builtin_bit_cast(float, v.w << 16), __builtin_bit_cast(float, v.w & 0xffff0000u)}; } }
        float s = 0.f;
#pragma unroll
        for (int j = 0; j < 16; ++j) { const int f4 = 2 * (p + 16 * (j >> 1)) + (j & 1);
            acc[j] = ((const f32x4*)(XMID + (size_t)r * D))[f4] + ((const f32x4*)mr)[f4] * acc[j]; s += (acc[j].x * acc[j].x + acc[j].y * acc[j].y) + (acc[j].z * acc[j].z + acc[j].w * acc[j].w); }
        const float rstd = rsqrtf(red16(s) * (1.f / D) + RMS_EPS);
#pragma unroll
        for (int j = 0; j < 16; ++j) { const int f4 = 2 * (p + 16 * (j >> 1)) + (j & 1); ((f32x4*)(out + (size_t)r * D))[f4] = acc[j] * rstd * ((const f32x4*)fg)[f4]; }
    }
}

constexpr int RING_BYTES = 131072, LDS_BYTES = 163840, MISC_OFF = LDS_BYTES - 256;
constexpr int CW_BAR = 4096;
constexpr size_t CTL_ZERO_BYTES = 65536;
__global__ __launch_bounds__(512, 2) void mega(Args a) {
    extern __shared__ __attribute__((aligned(16))) unsigned char lds[];
    const int bid = blockIdx.x, nb = gridDim.x, tid = threadIdx.x;
    unsigned char* ws = a.ws;
    const float* x = a.in[0]; const float* c = a.in[1]; const float* ctx = a.in[2]; const float* c_ctx = a.in[3]; const float* w_mod = a.in[4]; const float* b_mod = a.in[5];
    const float* norm1_g = a.in[6]; const float* norm2_g = a.in[7]; const float* w_in = a.in[8]; const float* mu = a.in[9]; const float* rw0 = a.in[10]; const float* rw2 = a.in[11];
    const float* ra0 = a.in[12]; const float* ra2 = a.in[13]; const float* rg2 = a.in[14]; const float* rkk = a.in[15]; const float* rka = a.in[16]; const float* rrk = a.in[17];
    const float* lnx_g = a.in[18]; const float* lnx_b = a.in[19]; const float* w_pr = a.in[20]; const float* conv_w = a.in[21]; const float* conv_b = a.in[22]; const float* lwa = a.in[23];
    const float* lba = a.in[24]; const float* lwx = a.in[25]; const float* lbx = a.in[26]; const float* llam = a.in[27]; const float* w_pl = a.in[28]; const float* w_out = a.in[29];
    const float* router = a.in[30]; const float* mw1 = a.in[31]; const float* mw3 = a.in[32]; const float* mw2 = a.in[33]; const float* final_g = a.in[34];
    float* MOD = (float*)(ws + WS_MOD); bf16_t* WIN = (bf16_t*)(ws + WS_WIN); bf16_t* WPR = (bf16_t*)(ws + WS_WPR); bf16_t* WPL = (bf16_t*)(ws + WS_WPL); bf16_t* WOUT = (bf16_t*)(ws + WS_WOUT);
    bf16_t* GT = (bf16_t*)(ws + WS_GT); float* XMID = (float*)(ws + WS_XMID); bf16_t* U = (bf16_t*)(ws + WS_U); float* Y = (float*)(ws + WS_Y); bf16_t* RW = (bf16_t*)(ws + WS_RW);
    bf16_t* MG = (bf16_t*)(ws + WS_MERGED); bf16_t* XB = (bf16_t*)(ws + WS_XB); bf16_t* GB = (bf16_t*)(ws + WS_GB); float* H = (float*)(ws + WS_H); bf16_t* O = (bf16_t*)(ws + WS_O); bf16_t* HL = (bf16_t*)(ws + WS_HL);
    bf16_t* W2 = (bf16_t*)a.out; bf16_t* W13 = (bf16_t*)((unsigned char*)a.out + 32 * MiB);
     bf16_t* H2 = (bf16_t*)(ws + WS_H2); bf16_t* HID = (bf16_t*)(ws + WS_HID); bf16_t* YE = (bf16_t*)(ws + WS_YE); bf16_t* XS = (bf16_t*)(ws + WS_XS);
    bf16_t* W2T = (bf16_t*)(ws + WS_W2T); bf16_t* A2T = (bf16_t*)(ws + WS_A2T); bf16_t* WAT = (bf16_t*)(ws + WS_WAT); bf16_t* WXT = (bf16_t*)(ws + WS_WXT); bf16_t* G2T = (bf16_t*)(ws + WS_G2T); bf16_t* H0 = (bf16_t*)(ws + WS_H); bf16_t* H1 = (bf16_t*)(ws + WS_H + 32 * MiB); bf16_t* Y0 = (bf16_t*)(ws + WS_Y); bf16_t* Y1 = (bf16_t*)(ws + WS_Y + 32 * MiB);
    float* AFF = (float*)(ws + TAB_AFF); int* IDX = (int*)(ws + TAB_IDX); float* GATE = (float*)(ws + TAB_GATE); int* SLOT = (int*)(ws + TAB_SLOT); float* KN = (float*)(ws + TAB_RSTD); bf16_t* SIDE = (bf16_t*)(ws + TAB_SIDE); float* SSQ = (float*)(ws + TAB_SSQ);

    for (int u = tid; u < (LDS_BYTES - MISC_OFF) / 4; u += 512) ((LAS unsigned*)(lds + MISC_OFF))[u] = 0u;
    __syncthreads();
    const XcdBarrier bar = xcd_barrier_post((unsigned*)(ws + WS_CTL) + CW_BAR, (volatile LAS unsigned*)(lds + MISC_OFF) + 8);
    PG8_LAS unsigned char* ring = (PG8_LAS unsigned char*)lds;

#define PH(k) for (int rep_ = 0; rep_ < (PROBE == (k) ? 3 : 1); ++rep_)
    PH(0) {
    phase_modvec(c, c_ctx, w_mod, b_mod, MOD, lds, bid, nb);
    phase_wconv(w_in, WIN, 1024, IN_COLS, 4, 0, 1, 0, 0, lds, bid, nb);
    phase_wconv(w_pr, WPR, 512, 1024, 4, 0, 1, 0, 0, lds, bid, nb);
    phase_wconv(w_pl, WPL, 512, 1024, 4, 0, 1, 0, 0, lds, bid, nb);
    phase_wconv(w_out, WOUT, 1024, 1024, 4, 0, 1, 0, 0, lds, bid, nb);
    phase_wconv(rw2, W2T, 64, 512, 4, 0, 2, (size_t)64 * 512, (size_t)512 * 64, lds, bid, nb);
    phase_wconv(ra2, A2T, 64, 512, 4, 0, 2, (size_t)64 * 512, (size_t)512 * 64, lds, bid, nb);
    phase_wconv(lwa, WAT, 64, 64, 4, 0, 16, (size_t)64 * 64, (size_t)64 * 64, lds, bid, nb);
    phase_wconv(lwx, WXT, 64, 64, 4, 0, 16, (size_t)64 * 64, (size_t)64 * 64, lds, bid, nb);
    phase_wconv(rg2, G2T, 128, 512, 4, 0, 1, 0, 0, lds, bid, nb);
    xcd_barrier(bar); }
    PH(1) { phase_normmod(x, ctx, norm1_g, MOD, U, bid, nb); xcd_barrier(bar); }
    PH(2) { SWin S{U, WIN, nb, bid}; EWin E{RW, XB, GB, GT}; pg8::gemm_phase<EWin, SWin, true>(ring, 1024, S, E); xcd_barrier(bar); }
    PH(4) { phase_lru_seq(XB, H0, H1, conv_w, conv_b, WAT, lba, WXT, lbx, llam, lds, bid, nb); phase_mixA(RW, SIDE, bid, nb); xcd_barrier(bar); }
    PH(16) { phase_mixB(RW, SIDE, mu, rkk, KN, bid, nb); xcd_barrier(bar); }
    PH(3) { phase_rwkv_seq4(RW, KN, Y0, Y1, rw0, W2T, ra0, A2T, rkk, rka, mw1, mw3, mw2, W13, W2, lds, bid, nb); xcd_barrier(bar); }
    PH(5) { phase_rwkv_final(RW, Y0, Y1, ra0, A2T, G2T, rka, rrk, lnx_g, lnx_b, O, lds, bid, nb); if (PROBE == 5) xcd_barrier(bar); }
    PH(14) { phase_lru_final(H0, H1, GB, HL, bid, nb); xcd_barrier(bar); }
    PH(6) { SProj S{O, HL, WPR, WPL, nb, bid}; EProj E{GT, MG}; pg8::gemm_phase<EProj, SProj, true>(ring, 512, S, E); xcd_barrier(bar); }
    PH(7) { SWout S{MG, WOUT, nb, bid}; EWout E{x, MOD, XMID, SSQ}; pg8::gemm_phase<EWout, SWout, true>(ring, 1024, S, E); xcd_barrier(bar); }
    PH(8) {
    if (PROBE == 8) xcd_barrier(bar); }
    PH(15) { phase_router(XMID, norm2_g, MOD, router, AFF, SSQ, H2, bid, nb); xcd_barrier(bar); }
    PH(9) { phase_topk(AFF, IDX, GATE, SLOT, lds, bid, nb); xcd_barrier(bar); }
    PH(11) { SMoe1 S{H2, W13, IDX, nb, bid}; EMoe1 E{HID}; pg8::gemm_phase<EMoe1, SMoe1, true>(ring, 1024, S, E); xcd_barrier(bar); }
    PH(12) { SMoe2 S{HID, W2, nb, bid}; EMoe2 E{GATE, YE}; pg8::gemm_phase<EMoe2, SMoe2, true>(ring, 1024, S, E); xcd_barrier(bar); }
    PH(13) { phase_final(XMID, YE, SLOT, MOD, final_g, a.out, bid, nb); if (PROBE == 13) xcd_barrier(bar); }
#undef PH
}

extern "C" void kernel_launch(void* const* d_in, const int* in_sizes, int n_in, void* d_out, int out_size, void* d_ws, size_t ws_size, hipStream_t stream) {
    static int grid = 0;
    if (grid == 0) {
        if (n_in != 35 || ws_size < WS_END || out_size != NLAT * D) { fprintf(stderr, "kernel_launch: unexpected problem (n_in %d, ws %zu, out %d)\n", n_in, ws_size, out_size); grid = -1; return; }
        int dev = 0, cus = 0;
        if (hipGetDevice(&dev) != hipSuccess || hipDeviceGetAttribute(&cus, hipDeviceAttributeMultiprocessorCount, dev) != hipSuccess || cus <= 0) { fprintf(stderr, "kernel_launch: device query failed\n"); grid = -1; return; }
        if (hipFuncSetAttribute((const void*)mega, hipFuncAttributeMaxDynamicSharedMemorySize, LDS_BYTES) != hipSuccess) { fprintf(stderr, "kernel_launch: hipFuncSetAttribute failed\n"); grid = -1; return; }
        int per_cu = 0;
        if (hipOccupancyMaxActiveBlocksPerMultiprocessor(&per_cu, (const void*)mega, 512, LDS_BYTES) != hipSuccess || per_cu < 1) fprintf(stderr, "kernel_launch: occupancy query reports %d blocks per CU\n", per_cu);
        (void)hipGetLastError();
        grid = cus;
    }
    if (grid < 0) return;
    (void)hipMemsetAsync((char*)d_ws + WS_CTL, 0, CTL_ZERO_BYTES, stream);
    Args a{};
    for (int i = 0; i < 35; ++i) a.in[i] = (const float*)d_in[i];
    a.out = (float*)d_out; a.ws = (unsigned char*)d_ws;
    hipLaunchKernelGGL(mega, dim3(grid), dim3(512), LDS_BYTES, stream, a);
}
```

```cpp
#include <hip/hip_runtime.h>
#include <cstdio>
#include <cstdint>

typedef unsigned short bf16_t;
typedef short bf16x8 __attribute__((ext_vector_type(8)));
typedef float f32x4 __attribute__((ext_vector_type(4)));
typedef unsigned u32x4 __attribute__((ext_vector_type(4)));
typedef unsigned u32x2 __attribute__((ext_vector_type(2)));
typedef float f32x2_ __attribute__((ext_vector_type(2)));

constexpr int D = 1024, NB = 8, T = 4096, TC = 256, GW = 64;
constexpr int NLAT = NB * T, NCTX = NB * TC, NTOK = NLAT + NCTX;
constexpr int RH = 8, RN = 64, RWD = 512, RWR = 64, RAR = 64, RGR = 128;
constexpr int RW_COLS = 3 * RWD + RWR + RAR + RGR;
constexpr int LWD = 512;
constexpr int IN_COLS = RW_COLS + 2 * LWD + 2 * D;
constexpr int NE = 16, CAP = 512, DE = 1024;
constexpr float RMS_EPS = 1e-6f, LNX_EPS = 64e-5f;
constexpr int NSLOT = NB * NE * CAP;

constexpr size_t MiB = 1u << 20;
constexpr size_t WS_CTL = 0;
constexpr size_t WS_MOD = 1 * MiB;
constexpr size_t WS_WIN = 2 * MiB;
constexpr size_t WS_WPR = 12 * MiB;
constexpr size_t WS_WPL = 13 * MiB;
constexpr size_t WS_WOUT = 14 * MiB;
constexpr size_t WS_GT = 16 * MiB;
constexpr size_t WS_XMID = 16 * MiB;
constexpr size_t WS_U = 144 * MiB;
constexpr size_t WS_Y = 144 * MiB;
constexpr size_t WS_RW = 212 * MiB;
constexpr size_t WS_MERGED = 212 * MiB;
constexpr size_t WS_XB = 331 * MiB;
constexpr size_t WS_GB = 365 * MiB;
constexpr size_t WS_H = 397 * MiB;
constexpr size_t WS_O = 461 * MiB;
constexpr size_t WS_TAB = 496 * MiB;
constexpr size_t WS_W2 = 144 * MiB;
constexpr size_t WS_W13 = 176 * MiB;
constexpr size_t WS_XS = 240 * MiB;
constexpr size_t WS_H2 = 240 * MiB;
constexpr size_t WS_HID = 368 * MiB;
constexpr size_t WS_YE = 176 * MiB;
constexpr size_t WS_END = 512 * MiB;
constexpr size_t TAB_AFF = WS_TAB;
constexpr size_t TAB_IDX = WS_TAB + 2 * MiB;
constexpr size_t TAB_GATE = WS_TAB + 3 * MiB;
constexpr size_t TAB_SLOT = WS_TAB + 4 * MiB;
constexpr size_t TAB_RSTD = WS_TAB + 6 * MiB;
constexpr size_t TAB_SIDE = WS_TAB + 8 * MiB;
constexpr size_t TAB_SSQ = WS_TAB + 8 * MiB;

__device__ __forceinline__ unsigned f2bf(float f) { return (unsigned)__builtin_bit_cast(unsigned short, (__bf16)f); }
typedef float f32x2_t_ __attribute__((ext_vector_type(2))); typedef __bf16 bf16x2_t_ __attribute__((ext_vector_type(2)));
__device__ __forceinline__ unsigned pk2(float lo, float hi) { const f32x2_t_ v = {lo, hi}; const bf16x2_t_ b = __builtin_convertvector(v, bf16x2_t_); return __builtin_bit_cast(unsigned, b); }
__device__ __forceinline__ float bf2f(bf16_t b) { return __builtin_bit_cast(float, ((unsigned)b) << 16); }
__device__ __forceinline__ float softplusf_(float x) { return fmaxf(x, 0.f) + log1pf(__expf(-fabsf(x))); }
__device__ __forceinline__ float siluf_(float x) { return x / (1.f + __expf(-x)); }
__device__ __forceinline__ float fsigmoid(float x) { return __builtin_amdgcn_rcpf(1.f + __builtin_amdgcn_exp2f(-1.4426950408889634f * x)); }
__device__ __forceinline__ float fgelu_tanh(float x) { return x * fsigmoid(1.5957691216057308f * (x + 0.044715f * x * x * x)); }
__device__ __forceinline__ float fsilu(float x) { return x * fsigmoid(x); }
__device__ __forceinline__ float wave_sum(float v) {
#pragma unroll
    for (int o = 1; o < 64; o <<= 1) v += __shfl_xor(v, o);
    return v;
}
constexpr size_t WS_W2T = WS_MOD + 256 * 1024, WS_A2T = WS_MOD + 384 * 1024, WS_WAT = WS_MOD + 512 * 1024, WS_WXT = WS_MOD + 640 * 1024, WS_G2T = WS_MOD + 768 * 1024;
constexpr size_t WS_HL = WS_XB;


__device__ __forceinline__ void st_bf16x4(bf16_t* p, f32x4 v) { u32x2 w; w.x = pk2(v.x, v.y); w.y = pk2(v.z, v.w); *(u32x2*)p = w; }
__device__ __forceinline__ f32x4 ld_bf16x4(const bf16_t* p) { const u32x2 w = *(const u32x2*)p; return (f32x4){__builtin_bit_cast(float, w.x << 16), __builtin_bit_cast(float, w.x & 0xffff0000u), __builtin_bit_cast(float, w.y << 16), __builtin_bit_cast(float, w.y & 0xffff0000u)}; }
namespace pg8 {
#define PG8_LAS __attribute__((address_space(3)))
constexpr int BM = 256, BK = 64, HALF = 128, HTB = HALF * BK * 2, STAGE_BYTES = 8 * HTB, NXCD = 8, WGM = 8;
__host__ __device__ __forceinline__ int lds_byte(int r, int c) { const int st = (r >> 4) * 2 + (c >> 5), rr = r & 15, cc = c & 31, ob = rr * 64 + cc * 2; return st * 1024 + (ob ^ (((ob >> 9) & 1) << 5)); }
__host__ __device__ __forceinline__ void stage_rc(int b, int& R, int& C) { const int st = b / 1024, sb = b % 1024, swz = sb ^ (((sb >> 9) & 1) << 5); R = (st >> 1) * 16 + swz / 64; C = (st & 1) * 32 + (swz % 64) / 2; }
__host__ __device__ __forceinline__ int perm32(int rho) { const int n = rho >> 4, i = rho & 15; return 8 * (i >> 2) + 4 * n + (i & 3); }
struct Unit { int pm, pn, aux; };
__device__ __forceinline__ void grid_order(int L, int nM, int nN, int& pm, int& pn) {
    const int nwg = nM * nN; int wgid = L; { const int q = nwg / NXCD, r = nwg % NXCD, xcd = wgid % NXCD, off = wgid / NXCD; wgid = (xcd < r ? xcd * (q + 1) : r * (q + 1) + (xcd - r) * q) + off; }
    const int nig = WGM * nN, gid = wgid / nig, fm = gid * WGM, gsz = (nM - fm) < WGM ? (nM - fm) : WGM;
    pm = fm + ((wgid % nig) % gsz); pn = (wgid % nig) / gsz;
}

template <class Epi, class Sched, bool ALIGN_EPI = true>
__device__ __forceinline__ void gemm_phase(PG8_LAS unsigned char* lds, const int K, const Sched& S, const Epi& E) {
    int tid = threadIdx.x; asm volatile("" : "+v"(tid));
    const int wid = __builtin_amdgcn_readfirstlane(tid >> 6), lane = tid & 63, wr = wid >> 2, wc = wid & 3, fr = lane & 15, fq = lane >> 4;
    const int nt = K / BK;
    unsigned voffB[2]; int RA[2]; unsigned CA[2];
#pragma unroll
    for (int i = 0; i < 2; ++i) { int R, C; stage_rc(tid * 16 + i * 8192, R, C); const int Rb = Epi::PERM ? ((R & ~31) + perm32(R & 31)) : R;
        RA[i] = R; CA[i] = (unsigned)C * 2u; voffB[i] = (unsigned)(Rb * K + C) * 2u; }
    unsigned vc[2][2], vn[2][2];
#define PG8_AOFF(dst, u) do { _Pragma("unroll") for (int _h = 0; _h < 2; ++_h) _Pragma("unroll") for (int _i = 0; _i < 2; ++_i) dst[_h][_i] = S.a_rowoff(u, _h * HALF + RA[_i], K) + CA[_i]; } while (0)
#define PG8_SEL(h) { last ? vn[h][0] : vc[h][0], last ? vn[h][1] : vc[h][1] }
    const size_t kstep = (size_t)(BK * 2);
    const size_t hstep = (size_t)HALF * K * 2;
    const unsigned ldsw = (unsigned)wid * 1024u;
    const int aoff = lds_byte(wr * 64 + fr, fq * 8), boff = lds_byte(wc * 32 + fr, fq * 8);
#define PG8_SA(b, h) (((b) * 2 + (h)) * HTB)
#define PG8_SB(b, h) ((4 + (b) * 2 + (h)) * HTB)
#define PG8_STAGE(bufoff, gbase, voff) do { _Pragma("unroll") for (int _i = 0; _i < 2; ++_i) \
        __builtin_amdgcn_global_load_lds((const unsigned*)((const char*)(gbase) + (voff)[_i]), (PG8_LAS unsigned*)(lds + (bufoff) + ldsw + _i * 8192), 16, 0, 0); } while (0)
#define PG8_LDA(dst, b, h) do { _Pragma("unroll") for (int m = 0; m < 4; ++m) _Pragma("unroll") for (int k = 0; k < 2; ++k) dst[m][k] = *(const PG8_LAS bf16x8*)(lds + PG8_SA(b, h) + aoff + m * 2048 + k * 1024); } while (0)
#define PG8_LDB(dst, b, h) do { _Pragma("unroll") for (int n = 0; n < 2; ++n) _Pragma("unroll") for (int k = 0; k < 2; ++k) dst[n][k] = *(const PG8_LAS bf16x8*)(lds + PG8_SB(b, h) + boff + n * 2048 + k * 1024); } while (0)
#define PG8_MMA(ai, bj, At, Bt) do { __builtin_amdgcn_s_setprio(1); _Pragma("unroll") for (int m = 0; m < 4; ++m) _Pragma("unroll") for (int n = 0; n < 2; ++n) _Pragma("unroll") for (int k = 0; k < 2; ++k) \
        acc[ai][bj][m][n] = __builtin_amdgcn_mfma_f32_16x16x32_bf16(Bt[n][k], At[m][k], acc[ai][bj][m][n], 0, 0, 0); __builtin_amdgcn_s_setprio(0); } while (0)
#define PG8_WAIT_V(n) asm volatile("s_waitcnt vmcnt(" #n ")" ::: "memory")
#define PG8_WAIT_L(n) asm volatile("s_waitcnt lgkmcnt(" #n ")" ::: "memory")
#define PG8_BAR __builtin_amdgcn_s_barrier()
#define PG8_SCHED __builtin_amdgcn_sched_barrier(0)
    Unit cur, nxt; int ui = 0;
    if (!S.next(0, cur)) return;
    f32x4 acc[2][2][4][2];
#pragma unroll
    for (int a = 0; a < 2; ++a)
#pragma unroll
        for (int b = 0; b < 2; ++b)
#pragma unroll
            for (int m = 0; m < 4; ++m)
#pragma unroll
                for (int n = 0; n < 2; ++n) acc[a][b][m][n] = (f32x4){0.f, 0.f, 0.f, 0.f};
    bf16x8 At[4][2], B0[2][2], B1[2][2];
    const char* cA = S.a_base(cur); const char* cB = S.b_base(cur);
    PG8_AOFF(vc, cur);
    PG8_STAGE(PG8_SB(0, 0), cB, voffB); PG8_STAGE(PG8_SB(0, 1), cB + hstep, voffB); PG8_STAGE(PG8_SA(0, 0), cA, vc[0]); PG8_STAGE(PG8_SA(0, 1), cA, vc[1]);
    if (wr == 1) PG8_BAR;
    PG8_WAIT_V(2); PG8_BAR;
    PG8_STAGE(PG8_SB(1, 0), cB + kstep, voffB); PG8_STAGE(PG8_SA(1, 0), cA + kstep, vc[0]); PG8_STAGE(PG8_SB(1, 1), cB + hstep + kstep, voffB);
    PG8_WAIT_V(6); PG8_BAR;
    for (;;) {
        const bool has_next = S.next(ui + 1, nxt);
        const char* nA = has_next ? S.a_base(nxt) : cA; const char* nB = has_next ? S.b_base(nxt) : cB;
        if (has_next) PG8_AOFF(vn, nxt); else { vn[0][0] = vc[0][0]; vn[0][1] = vc[0][1]; vn[1][0] = vc[1][0]; vn[1][1] = vc[1][1]; }
        for (int t = 0; t < nt; t += 2) {
            const bool last = (t == nt - 2);
            const char* a1 = cA + (size_t)(t + 1) * kstep;
            const char* a2 = last ? nA : cA + (size_t)(t + 2) * kstep; const char* b2 = last ? nB : cB + (size_t)(t + 2) * kstep;
            const char* a3 = a2 + kstep; const char* b3 = b2 + kstep;
            PG8_LDB(B0, 0, 0); PG8_LDB(B1, 0, 1); PG8_SCHED; PG8_LDA(At, 0, 0); PG8_STAGE(PG8_SA(1, 1), a1, vc[1]);
            PG8_WAIT_V(8); PG8_WAIT_L(0); PG8_BAR; PG8_MMA(0, 0, At, B0); PG8_MMA(0, 1, At, B1); PG8_BAR; PG8_SCHED;
            PG8_LDA(At, 0, 1); PG8_STAGE(PG8_SB(0, 0), b2, voffB); PG8_STAGE(PG8_SB(0, 1), b2 + hstep, voffB); { const unsigned vs[2] = PG8_SEL(0); PG8_STAGE(PG8_SA(0, 0), a2, vs); }
            PG8_WAIT_V(8); PG8_WAIT_L(0); PG8_BAR; PG8_MMA(1, 0, At, B0); PG8_MMA(1, 1, At, B1); PG8_BAR; PG8_SCHED;
            PG8_LDB(B0, 1, 0); PG8_LDB(B1, 1, 1); PG8_SCHED; PG8_LDA(At, 1, 0); { const unsigned vs[2] = PG8_SEL(1); PG8_STAGE(PG8_SA(0, 1), a2, vs); }
            PG8_WAIT_V(8); PG8_WAIT_L(0); PG8_BAR; PG8_MMA(0, 0, At, B0); PG8_MMA(0, 1, At, B1); PG8_BAR; PG8_SCHED;
            PG8_LDA(At, 1, 1); PG8_STAGE(PG8_SB(1, 0), b3, voffB); PG8_STAGE(PG8_SB(1, 1), b3 + hstep, voffB); { const unsigned vs[2] = PG8_SEL(0); PG8_STAGE(PG8_SA(1, 0), a3, vs); }
            PG8_WAIT_V(8); PG8_WAIT_L(0); PG8_BAR; PG8_MMA(1, 0, At, B0); PG8_MMA(1, 1, At, B1); PG8_BAR; PG8_SCHED;
        }
        if constexpr (ALIGN_EPI) { if (wr == 0) PG8_BAR; }
        E(acc, cur, wr, wc, fr, fq);
        if (!has_next) break;
#pragma unroll
        for (int a = 0; a < 2; ++a)
#pragma unroll
            for (int b = 0; b < 2; ++b)
#pragma unroll
                for (int m = 0; m < 4; ++m)
#pragma unroll
                    for (int n = 0; n < 2; ++n) acc[a][b][m][n] = (f32x4){0.f, 0.f, 0.f, 0.f};
        cur = nxt; cA = nA; cB = nB; ++ui; vc[0][0] = vn[0][0]; vc[0][1] = vn[0][1]; vc[1][0] = vn[1][0]; vc[1][1] = vn[1][1];
        if constexpr (ALIGN_EPI) { if (wr == 1) PG8_BAR; }
    }
    PG8_WAIT_V(0);
    if constexpr (!ALIGN_EPI) { if (wr == 0) PG8_BAR; }
    PG8_BAR;
#undef PG8_AOFF
#undef PG8_SEL
#undef PG8_SA
#undef PG8_SB
#undef PG8_STAGE
#undef PG8_LDA
#undef PG8_LDB
#undef PG8_MMA
#undef PG8_WAIT_V
#undef PG8_WAIT_L
#undef PG8_BAR
#undef PG8_SCHED
}
}

struct SWin {
    const bf16_t* U; const bf16_t* W; int G, c;
    __device__ __forceinline__ bool next(int i, pg8::Unit& u) const { const int L = i * G + c; if (L < 128 * 19) { pg8::grid_order(L, 128, 19, u.pm, u.pn); u.aux = 0; return true; }
        const int r = L - 128 * 19; if (r >= 72) return false; u.pm = 128 + (r & 7); u.pn = r >> 3; u.aux = 0; return true; }
    __device__ __forceinline__ const char* a_base(const pg8::Unit& u) const { return (const char*)(U + (size_t)u.pm * 256 * D); }
    __device__ __forceinline__ unsigned a_rowoff(const pg8::Unit&, int r, int K) const { return (unsigned)(r * K) * 2u; }
    __device__ __forceinline__ const char* b_base(const pg8::Unit& u) const { return (const char*)(W + (size_t)u.pn * 256 * D); }
};
struct EWin {
    static constexpr bool PERM = true;
    bf16_t* RW; bf16_t* XB; bf16_t* GB; bf16_t* GT;
    __device__ __forceinline__ void operator()(const f32x4 (&acc)[2][2][4][2], const pg8::Unit& u, int wr, int wc, int fr, int fq) const {
        const int row0 = u.pm * 256 + wr * 64 + fr, colt = u.pn * 256, cl = wc * 32 + 8 * fq;
        bf16_t* base; int ldc, act;
        if (colt < 1792) { base = RW + colt; ldc = RW_COLS; act = 0; } else if (colt < 2304) { base = XB + (colt - 1792); ldc = LWD; act = 0; }
        else if (colt < 2816) { base = GB + (colt - 2304); ldc = LWD; act = 1; } else { base = GT + (colt - 2816); ldc = 2048; act = 2; }
#pragma unroll
        for (int ai = 0; ai < 2; ++ai)
#pragma unroll
            for (int m = 0; m < 4; ++m) { bf16_t* rowp = base + (size_t)(row0 + ai * 128 + m * 16) * ldc + cl;
#pragma unroll
                for (int bj = 0; bj < 2; ++bj) { f32x4 v0 = acc[ai][bj][m][0], v1 = acc[ai][bj][m][1];
                    if (act == 1) {
#pragma unroll
                        for (int j = 0; j < 4; ++j) { v0[j] = fgelu_tanh(v0[j]); v1[j] = fgelu_tanh(v1[j]); } }
                    else if (act == 2) {
#pragma unroll
                        for (int j = 0; j < 4; ++j) { v0[j] = fsigmoid(v0[j]); v1[j] = fsigmoid(v1[j]); } }
                    u32x4 w; w.x = pk2(v0[0], v0[1]); w.y = pk2(v0[2], v0[3]); w.z = pk2(v1[0], v1[1]); w.w = pk2(v1[2], v1[3]);
                    *(u32x4*)(rowp + bj * 128) = w; } }
    }
};
struct SProj {
    const bf16_t* O; const bf16_t* HL; const bf16_t* Wr; const bf16_t* Wl; int G, c;
    __device__ __forceinline__ bool next(int i, pg8::Unit& u) const { const int L = (i >> 1) * G + c; if (L >= 128 * 4) return false; pg8::grid_order(L, 128, 4, u.pm, u.pn); u.aux = i & 1; return true; }
    __device__ __forceinline__ const char* a_base(const pg8::Unit& u) const { return (const char*)((u.aux ? HL : O) + (size_t)u.pm * 256 * 512); }
    __device__ __forceinline__ unsigned a_rowoff(const pg8::Unit&, int r, int K) const { return (unsigned)(r * K) * 2u; }
    __device__ __forceinline__ const char* b_base(const pg8::Unit& u) const { return (const char*)((u.aux ? Wl : Wr) + (size_t)u.pn * 256 * 512); }
};
struct EProj {
    static constexpr bool PERM = true;
    const bf16_t* GT; bf16_t* MG;
    __device__ __forceinline__ void operator()(const f32x4 (&acc)[2][2][4][2], const pg8::Unit& u, int wr, int wc, int fr, int fq) const {
        const int row0 = u.pm * 256 + wr * 64 + fr, col0 = u.pn * 256 + wc * 32 + 8 * fq;
#pragma unroll
        for (int ai = 0; ai < 2; ++ai)
#pragma unroll
            for (int m = 0; m < 4; ++m) { const size_t r = (size_t)(row0 + ai * 128 + m * 16);
#pragma unroll
                for (int bj = 0; bj < 2; ++bj) { const int cc = col0 + bj * 128; const bf16_t* gp = GT + r * 2048 + (u.aux ? 1024 : 0) + cc; bf16_t* op = MG + r * D + cc;
                    const f32x4 g0 = ld_bf16x4(gp), g1 = ld_bf16x4(gp + 4); f32x4 v0 = g0 * acc[ai][bj][m][0], v1 = g1 * acc[ai][bj][m][1];
                    if (u.aux) { v0 += ld_bf16x4(op); v1 += ld_bf16x4(op + 4); }
                    u32x4 w; w.x = pk2(v0[0], v0[1]); w.y = pk2(v0[2], v0[3]); w.z = pk2(v1[0], v1[1]); w.w = pk2(v1[2], v1[3]);
                    *(u32x4*)op = w; } }
    }
};
struct SWout {
    const bf16_t* MG; const bf16_t* W; int G, c;
    __device__ __forceinline__ bool next(int i, pg8::Unit& u) const { const int L = i * G + c; if (L >= 128 * 4) return false; pg8::grid_order(L, 128, 4, u.pm, u.pn); u.aux = 0; return true; }
    __device__ __forceinline__ const char* a_base(const pg8::Unit& u) const { return (const char*)(MG + (size_t)u.pm * 256 * D); }
    __device__ __forceinline__ unsigned a_rowoff(const pg8::Unit&, int r, int K) const { return (unsigned)(r * K) * 2u; }
    __device__ __forceinline__ const char* b_base(const pg8::Unit& u) const { return (const char*)(W + (size_t)u.pn * 256 * D); }
};
struct EWout {
    static constexpr bool PERM = false;
    const float* x; const float* MOD; float* XMID; float* SSQ;
    __device__ __forceinline__ void operator()(const f32x4 (&acc)[2][2][4][2], const pg8::Unit& u, int wr, int wc, int fr, int fq) const {
        const int row0 = u.pm * 256 + wr * 64 + fr, col0 = u.pn * 256 + wc * 32 + 4 * fq; const float* gt1 = MOD + (size_t)(u.pm >> 4) * 6144 + 2048;
        f32x4 gv[2][2];
#pragma unroll
        for (int bj = 0; bj < 2; ++bj)
#pragma unroll
            for (int n = 0; n < 2; ++n) gv[bj][n] = *(const f32x4*)(gt1 + col0 + bj * 128 + n * 16);
#pragma unroll
        for (int ai = 0; ai < 2; ++ai)
#pragma unroll
            for (int m = 0; m < 4; ++m) { const size_t row = (size_t)(row0 + ai * 128 + m * 16), off = row * D + col0; float ss = 0.f;
#pragma unroll
                for (int bj = 0; bj < 2; ++bj)
#pragma unroll
                    for (int n = 0; n < 2; ++n) { const f32x4 v = *(const f32x4*)(x + off + bj * 128 + n * 16) + gv[bj][n] * acc[ai][bj][m][n]; *(f32x4*)(XMID + off + bj * 128 + n * 16) = v; ss += (v.x * v.x + v.y * v.y) + (v.z * v.z + v.w * v.w); }
                ss += __shfl_xor(ss, 16); ss += __shfl_xor(ss, 32);
                if (fq == 0) SSQ[row * 16 + u.pn * 4 + wc] = ss; }
    }
};
struct SMoe1 {
    const bf16_t* H2; const bf16_t* W13; const int* IDX; int G, c;
    __device__ __forceinline__ bool next(int i, pg8::Unit& u) const { const int L = i * G + c; if (L >= 256 * 8) return false; pg8::grid_order(L, 256, 8, u.pm, u.pn); u.aux = (u.pm >> 1) & 15; return true; }
    __device__ __forceinline__ const char* a_base(const pg8::Unit&) const { return (const char*)H2; }
    __device__ __forceinline__ unsigned a_rowoff(const pg8::Unit& u, int r, int K) const { return (unsigned)((u.pm >> 5) * T + IDX[u.pm * 256 + r]) * (unsigned)(K * 2); }
    __device__ __forceinline__ const char* b_base(const pg8::Unit& u) const { return (const char*)(W13 + ((size_t)u.aux * 2048 + (size_t)u.pn * 256) * D); }
};
struct EMoe1 {
    static constexpr bool PERM = true;
    bf16_t* HID;
    __device__ __forceinline__ void operator()(const f32x4 (&acc)[2][2][4][2], const pg8::Unit& u, int wr, int wc, int fr, int fq) const {
        const int row0 = u.pm * 256 + wr * 64 + fr, col0 = (u.pn * 256 + wc * 32 + 8 * fq) >> 1;
#pragma unroll
        for (int ai = 0; ai < 2; ++ai)
#pragma unroll
            for (int m = 0; m < 4; ++m) { bf16_t* rowp = HID + (size_t)(row0 + ai * 128 + m * 16) * DE + col0;
#pragma unroll
                for (int bj = 0; bj < 2; ++bj) { const f32x4 a = acc[ai][bj][m][0], b = acc[ai][bj][m][1]; u32x2 w;
                    w.x = pk2(fsilu(a[0]) * b[0], fsilu(a[1]) * b[1]); w.y = pk2(fsilu(a[2]) * b[2], fsilu(a[3]) * b[3]);
                    *(u32x2*)(rowp + bj * 64) = w; } }
    }
};
struct SMoe2 {
    const bf16_t* HID; const bf16_t* W2; int G, c;
    __device__ __forceinline__ bool next(int i, pg8::Unit& u) const { const int L = i * G + c; if (L >= 256 * 4) return false; pg8::grid_order(L, 256, 4, u.pm, u.pn); u.aux = (u.pm >> 1) & 15; return true; }
    __device__ __forceinline__ const char* a_base(const pg8::Unit& u) const { return (const char*)(HID + (size_t)u.pm * 256 * DE); }
    __device__ __forceinline__ unsigned a_rowoff(const pg8::Unit&, int r, int K) const { return (unsigned)(r * K) * 2u; }
    __device__ __forceinline__ const char* b_base(const pg8::Unit& u) const { return (const char*)(W2 + ((size_t)u.aux * D + (size_t)u.pn * 256) * DE); }
};
struct EMoe2 {
    static constexpr bool PERM = true;
    const float* GATE; bf16_t* YE;
    __device__ __forceinline__ void operator()(const f32x4 (&acc)[2][2][4][2], const pg8::Unit& u, int wr, int wc, int fr, int fq) const {
        const int row0 = u.pm * 256 + wr * 64 + fr, col0 = u.pn * 256 + wc * 32 + 8 * fq;
#pragma unroll
        for (int ai = 0; ai < 2; ++ai)
#pragma unroll
            for (int m = 0; m < 4; ++m) { const int r = row0 + ai * 128 + m * 16; const float gt = GATE[r]; bf16_t* rowp = YE + (size_t)r * D + col0;
#pragma unroll
                for (int bj = 0; bj < 2; ++bj) { const f32x4 v0 = acc[ai][bj][m][0] * gt, v1 = acc[ai][bj][m][1] * gt;
                    u32x4 w; w.x = pk2(v0[0], v0[1]); w.y = pk2(v0[2], v0[3]); w.z = pk2(v1[0], v1[1]); w.w = pk2(v1[2], v1[3]);
                    *(u32x4*)(rowp + bj * 128) = w; } }
    }
};
#ifndef PROBE
#define PROBE (-1)
#endif
#define LAS __attribute__((address_space(3)))
__device__ __forceinline__ int otid() { int t = threadIdx.x; asm volatile("" : "+v"(t)); return t; }
#define XB_TMO      128
#define XB_XCNT(j)  (256  + 64 * (j))
#define XB_XSUB(j)  (1280 + 64 * (j))
#define XB_XGEN(j)  (2304 + 64 * (j))
#define XB_TOP      3328
#define XB_TOPGEN   3392
#define XCD_BAR_WORDS 3456
#define XB_SPIN_CAP (1u << 22)
__device__ __forceinline__ unsigned xb_ld(unsigned* p)              { return __hip_atomic_load(p, __ATOMIC_RELAXED, __HIP_MEMORY_SCOPE_AGENT); }
__device__ __forceinline__ unsigned xb_add(unsigned* p, unsigned v) { return __hip_atomic_fetch_add(p, v, __ATOMIC_RELAXED, __HIP_MEMORY_SCOPE_AGENT); }
__device__ __forceinline__ unsigned xb_xcc_id() { return (unsigned)__builtin_amdgcn_s_getreg((3 << 11) | 20) & 0xFu; }
#define XB_SPIN(cond, bar) do { unsigned _sp = 0; while (cond) { __builtin_amdgcn_s_sleep(1); \
    if ((++_sp & 255u) == 0u) { if (xb_ld(&(bar)[XB_TMO])) break; if (_sp > XB_SPIN_CAP) { atomicAdd(&(bar)[XB_TMO], 1u); break; } } } } while (0)
struct XcdBarrier { unsigned* bar; unsigned x; volatile LAS unsigned* st; };
__device__ __forceinline__ XcdBarrier xcd_barrier_post(unsigned* bar, volatile LAS unsigned* st) {
    XcdBarrier b; b.bar = bar; b.x = xb_xcc_id(); b.st = st;
    if (threadIdx.x == 0) (void)xb_add(&bar[XB_XCNT(b.x)], 1u);
    return b;
}
__device__ __forceinline__ void xcd_barrier_complete(unsigned* bar, unsigned x, unsigned& nloc, unsigned& nx) {
    const unsigned G = gridDim.x * gridDim.y * gridDim.z;
    unsigned sum, cnt, mine, sp = 0u;
    for (;;) {
        sum = 0u; cnt = 0u; mine = 0u;
#pragma unroll
        for (unsigned j = 0; j < 16; ++j) { const unsigned c = xb_ld(&bar[XB_XCNT(j)]); sum += c; cnt += (c > 0u) ? 1u : 0u; mine = (j == x) ? c : mine; }
        if (sum == G) break;
        __builtin_amdgcn_s_sleep(1);
        if ((++sp & 255u) == 0u) { if (xb_ld(&bar[XB_TMO])) break; if (sp > XB_SPIN_CAP) { atomicAdd(&bar[XB_TMO], 1u); break; } }
    }
    nloc = mine > 0u ? mine : 1u; nx = cnt > 0u ? cnt : 1u;
}
__device__ __forceinline__ void xcd_barrier(const XcdBarrier& b) {
    asm volatile("s_waitcnt vmcnt(0)" ::: "memory");
    __syncthreads();
    if (threadIdx.x == 0) {
        unsigned* bar = b.bar;
        __builtin_amdgcn_s_waitcnt(0);
        unsigned nloc = b.st[0], nx = b.st[1];
        if (nloc == 0u) { xcd_barrier_complete(bar, b.x, nloc, nx); b.st[0] = nloc; b.st[1] = nx; }
        const unsigned old = xb_add(&bar[XB_XSUB(b.x)], 1u);
        const unsigned gen = old / nloc;
        if (old + 1u == (gen + 1u) * nloc) {
            __builtin_amdgcn_fence(__ATOMIC_RELEASE, "agent");
            asm volatile("s_waitcnt vmcnt(0)" ::: "memory");
            const unsigned og = xb_add(&bar[XB_TOP], 1u);
            const unsigned tg = og / nx;
            if (og + 1u == (tg + 1u) * nx) xb_add(&bar[XB_TOPGEN], 1u);
            else XB_SPIN(xb_ld(&bar[XB_TOPGEN]) == tg, bar);
            __builtin_amdgcn_fence(__ATOMIC_ACQUIRE, "agent");
            xb_add(&bar[XB_XGEN(b.x)], 1u);
            asm volatile("s_waitcnt vmcnt(0)" ::: "memory");
        } else {
            XB_SPIN(xb_ld(&bar[XB_XGEN(b.x)]) == gen, bar);
            __builtin_amdgcn_fence(__ATOMIC_ACQUIRE, "agent");
            asm volatile("s_waitcnt vmcnt(0)" ::: "memory");
        }
    }
    __syncthreads();
}

struct Args { const float* in[35]; float* out; unsigned char* ws; };

__device__ __forceinline__ void phase_modvec(const float* __restrict__ c, const float* __restrict__ c_ctx, const float* __restrict__ w_mod, const float* __restrict__ b_mod, float* __restrict__ MOD, unsigned char* lds, int bid, int nb) {
    float (*sv)[1024] = (float (*)[1024])lds; float (*red)[9][32] = (float (*)[9][32])(lds + 9 * 1024 * 4);
    const int tid = otid(), lane = tid & 63, w = tid >> 6;
    if (bid >= 192) return;
    for (int i = tid; i < 9 * 1024; i += 512) { const int r = i >> 10, k = i & 1023; const float v = r < 8 ? c[r * 1024 + k] : c_ctx[k]; sv[r][k] = siluf_(v); }
    __syncthreads();
    for (int item = bid; item < 192; item += nb) {
        const int col = item * 32 + (lane & 31), kg = w * 2 + (lane >> 5);
        float acc[9];
#pragma unroll
        for (int r = 0; r < 9; ++r) acc[r] = 0.f;
#pragma unroll 8
        for (int kk = 0; kk < 64; ++kk) { const int k = kg * 64 + kk; const float wv = w_mod[(size_t)k * 6144 + col];
#pragma unroll
            for (int r = 0; r < 9; ++r) acc[r] += sv[r][k] * wv; }
#pragma unroll
        for (int r = 0; r < 9; ++r) red[kg][r][lane & 31] = acc[r];
        __syncthreads();
        if (tid < 288) { const int r = tid >> 5, cc = tid & 31; float s = b_mod[item * 32 + cc];
#pragma unroll
            for (int g = 0; g < 16; ++g) s += red[g][r][cc];
            MOD[r * 6144 + item * 32 + cc] = s; }
        __syncthreads();
    }
}
__device__ __forceinline__ void phase_wconv(const float* __restrict__ src0, bf16_t* __restrict__ dst0, int K, int N, int rmul, int radd, int nbatch, size_t sstride, size_t dstride, unsigned char* lds, int bid, int nb) {
    const int tid = otid(), lane = tid & 63, wv = tid >> 6, gw = bid * 8 + wv, NGW = nb * 8, nkt = K / 64, nnt = N / 64, per = nkt * nnt;
    u32x4* wl = (u32x4*)(lds + wv * 9216);
    for (int it = gw; it < per * nbatch; it += NGW) {
        const int bt = it / per, r = it % per; const float* src = src0 + (size_t)bt * sstride; bf16_t* dst = dst0 + (size_t)bt * dstride;
        const int k0 = (r / nnt) * 64, n0 = (r % nnt) * 64;
        const float* sp = src + (size_t)k0 * N + n0 + lane; float v[64];
#pragma unroll
        for (int i = 0; i < 64; ++i) v[i] = sp[(size_t)i * N];
#pragma unroll
        for (int c = 0; c < 8; ++c) { u32x4 o; o.x = pk2(v[8 * c], v[8 * c + 1]); o.y = pk2(v[8 * c + 2], v[8 * c + 3]); o.z = pk2(v[8 * c + 4], v[8 * c + 5]); o.w = pk2(v[8 * c + 6], v[8 * c + 7]); wl[lane * 9 + c] = o; }
        asm volatile("s_waitcnt lgkmcnt(0)" ::: "memory");
#pragma unroll
        for (int j = 0; j < 8; ++j) { const int n = (lane >> 3) + 8 * j, c = lane & 7; const u32x4 o = wl[n * 9 + c];
            const int nn = n0 + n, row = (nn >> 2) * rmul + (nn & 3) + radd; *(u32x4*)(dst + (size_t)row * K + k0 + 8 * c) = o; }
        asm volatile("s_waitcnt lgkmcnt(0)" ::: "memory");
    }
}
__device__ __forceinline__ void phase_normmod(const float* __restrict__ x, const float* __restrict__ ctx, const float* __restrict__ g1, const float* __restrict__ MOD, bf16_t* __restrict__ U, int bid, int nb) {
    const int tid = otid(), lane = tid & 63, gw = bid * 8 + (tid >> 6), NGW = nb * 8;
    for (int r0 = gw * 4; r0 < NTOK; r0 += NGW * 4) {
        const float* src = r0 < NLAT ? x + (size_t)r0 * D : ctx + (size_t)(r0 - NLAT) * D;
        f32x4 v[4][4]; float ss[4];
#pragma unroll
        for (int q = 0; q < 4; ++q) { ss[q] = 0.f;
#pragma unroll
            for (int j = 0; j < 4; ++j) { v[q][j] = ((const f32x4*)(src + (size_t)q * D))[lane + 64 * j]; } }
#pragma unroll
        for (int q = 0; q < 4; ++q) {
#pragma unroll
            for (int j = 0; j < 4; ++j) ss[q] += (v[q][j].x * v[q][j].x + v[q][j].y * v[q][j].y) + (v[q][j].z * v[q][j].z + v[q][j].w * v[q][j].w);
            const int r = r0 + q; const float* mr = MOD + (size_t)(r < NLAT ? r / T : 8) * 6144;
            const float rstd = rsqrtf(wave_sum(ss[q]) * (1.f / D) + RMS_EPS);
#pragma unroll
            for (int j = 0; j < 4; ++j) { const f32x4 g = ((const f32x4*)g1)[lane + 64 * j], sh = ((const f32x4*)mr)[lane + 64 * j], sc = ((const f32x4*)(mr + 1024))[lane + 64 * j];
                const f32x4 o = (v[q][j] * rstd * g) * (sc + 1.f) + sh; u32x2 w; w.x = pk2(o.x, o.y); w.y = pk2(o.z, o.w);
                ((u32x2*)(U + (size_t)r * D))[lane + 64 * j] = w; } }
    }
}
template <int CTRL> __device__ __forceinline__ float dpp_mov(float x) { return __builtin_bit_cast(float, __builtin_amdgcn_update_dpp(0, __builtin_bit_cast(int, x), CTRL, 0xF, 0xF, true)); }
__device__ __forceinline__ float red16(float x) { x += dpp_mov<0xB1>(x); x += dpp_mov<0x4E>(x); x += dpp_mov<0x141>(x); x += dpp_mov<0x140>(x); return x; }
__device__ __forceinline__ float fmul_s(float a, float b) { float r; asm("v_mul_f32_e32 %0, %1, %2" : "=v"(r) : "v"(a), "v"(b)); return r; }
__device__ __forceinline__ float ffma_s(float a, float b, float c) { float r; asm("v_fma_f32 %0, %1, %2, %3" : "=v"(r) : "v"(a), "v"(b), "v"(c)); return r; }
__device__ __forceinline__ float fnma_s(float a, float b, float c) { float r; asm("v_fma_f32 %0, -%1, %2, %3" : "=v"(r) : "v"(a), "v"(b), "v"(c)); return r; }
__device__ __forceinline__ float ftanh(float x) { return 2.f * fsigmoid(2.f * x) - 1.f; }
__device__ __forceinline__ void unpack8(const u32x4 v, float (&f)[8]) {
    f[0] = __builtin_bit_cast(float, v.x << 16); f[1] = __builtin_bit_cast(float, v.x & 0xffff0000u); f[2] = __builtin_bit_cast(float, v.y << 16); f[3] = __builtin_bit_cast(float, v.y & 0xffff0000u);
    f[4] = __builtin_bit_cast(float, v.z << 16); f[5] = __builtin_bit_cast(float, v.z & 0xffff0000u); f[6] = __builtin_bit_cast(float, v.w << 16); f[7] = __builtin_bit_cast(float, v.w & 0xffff0000u); }
__device__ __forceinline__ void phase_lru_seq(const bf16_t* __restrict__ XB, bf16_t* __restrict__ H0, bf16_t* __restrict__ H1, const float* __restrict__ conv_w, const float* __restrict__ conv_b, const bf16_t* __restrict__ WAT,
                                              const float* __restrict__ ba, const bf16_t* __restrict__ WXT, const float* __restrict__ bx, const float* __restrict__ lam, unsigned char* lds, int bid, int nb) {
    const int tid = otid(), lane = tid & 63, w = __builtin_amdgcn_readfirstlane(tid >> 6), fr = lane & 15, fq = lane >> 4;
    bf16_t* RAW = (bf16_t*)(lds + w * 18944);
    bf16_t* XC = (bf16_t*)(lds + w * 18944 + 9728);
    float* CW = (float*)(lds + 151552);
    float* TOT = (float*)(lds + 152832);
    for (int item = bid; item < 256; item += nb) {
        const int b = item >> 5, g = (item >> 2) & 7, d = (item >> 1) & 1, half = item & 1;
        bf16_t* Hd = d ? H1 : H0;
        __syncthreads();
        float cwr[5][8];
#pragma unroll
        for (int k = 0; k < 5; ++k)
#pragma unroll
            for (int e = 0; e < 8; ++e) cwr[k][e] = k < 4 ? conv_w[(d * 4 + k) * 512 + g * 64 + 8 * (lane & 7) + e] : conv_b[d * 512 + g * 64 + 8 * (lane & 7) + e];
        bf16x8 waf[2][2], wxf[2][2]; float bav[2], bxv[2], spv[2], hcar[2];
#pragma unroll
        for (int mt = 0; mt < 2; ++mt) { const int co = half * 32 + 16 * mt + fr, cg = d * 512 + g * 64 + co; bav[mt] = ba[cg]; bxv[mt] = bx[cg]; spv[mt] = softplusf_(-lam[cg]); hcar[mt] = 0.f;
#pragma unroll
            for (int ks = 0; ks < 2; ++ks) { const size_t off = (((size_t)d * 8 + g) * 64 + co) * 64 + ks * 32 + fq * 8; waf[mt][ks] = *(const bf16x8*)(WAT + off); wxf[mt][ks] = *(const bf16x8*)(WXT + off); } }
        __syncthreads();
        for (int sc = 0; sc < 9; ++sc) {
            const int ch = sc * 8 + w; const bool active = ch < 68; const bool isctx = ch < 4; const int len = isctx ? TC : T; const int s0 = isctx ? ch * 64 : (ch - 4) * 64;
            float Atot[2] = {1.f, 1.f}, Btot[2] = {0.f, 0.f}, Aex[2] = {1.f, 1.f}, Bex[2] = {0.f, 0.f};
            float av[2][16], bv[2][16];
            if (active) {
                auto rowof = [&](int sseg) -> size_t { const int i = d ? len - 1 - sseg : sseg; return isctx ? (size_t)NLAT + (size_t)b * TC + i : (size_t)b * T + (size_t)((i & 63) * 64 + (i >> 6)); };
                { const int lr = lane >> 3, lc = lane & 7; const u32x4 z = {0u, 0u, 0u, 0u};
#pragma unroll
                  for (int g8 = 0; g8 < 9; ++g8) { const int rr = 8 * g8 + lr; if (rr < 67) { const int sh = s0 - 3 + rr; *(u32x4*)(RAW + rr * 72 + 8 * lc) = sh >= 0 ? *(const u32x4*)(XB + rowof(sh) * LWD + g * 64 + 8 * lc) : z; } } }
                { const int j8 = lane & 7, p0 = 8 * (lane >> 3); float win[4][8];
#pragma unroll
                  for (int q = 0; q < 3; ++q) unpack8(*(const u32x4*)(RAW + (p0 + q) * 72 + 8 * j8), win[q]);
#pragma unroll
                  for (int q = 0; q < 8; ++q) { const int s = p0 + q, rho = 16 * ((s >> 2) & 3) + 4 * (s >> 4) + (s & 3); unpack8(*(const u32x4*)(RAW + (s + 3) * 72 + 8 * j8), win[(q + 3) & 3]);
                      float o[8];
#pragma unroll
                      for (int e = 0; e < 8; ++e) o[e] = cwr[4][e] + cwr[0][e] * win[q & 3][e] + cwr[1][e] * win[(q + 1) & 3][e] + cwr[2][e] * win[(q + 2) & 3][e] + cwr[3][e] * win[(q + 3) & 3][e];
                      u32x4 pk; pk.x = pk2(o[0], o[1]); pk.y = pk2(o[2], o[3]); pk.z = pk2(o[4], o[5]); pk.w = pk2(o[6], o[7]); *(u32x4*)(XC + rho * 72 + 8 * j8) = pk; } }
                f32x4 pa[2][4], px[2][4];
#pragma unroll
                for (int mt = 0; mt < 2; ++mt)
#pragma unroll
                    for (int nt = 0; nt < 4; ++nt) { pa[mt][nt] = (f32x4){0.f, 0.f, 0.f, 0.f}; px[mt][nt] = (f32x4){0.f, 0.f, 0.f, 0.f}; }
#pragma unroll
                for (int nt = 0; nt < 4; ++nt)
#pragma unroll
                    for (int ks = 0; ks < 2; ++ks) { const bf16x8 xf = *(const bf16x8*)(XC + (16 * nt + fr) * 72 + ks * 32 + fq * 8);
#pragma unroll
                        for (int mt = 0; mt < 2; ++mt) { pa[mt][nt] = __builtin_amdgcn_mfma_f32_16x16x32_bf16(xf, waf[mt][ks], pa[mt][nt], 0, 0, 0); px[mt][nt] = __builtin_amdgcn_mfma_f32_16x16x32_bf16(xf, wxf[mt][ks], px[mt][nt], 0, 0, 0); } }
#pragma unroll
                for (int mt = 0; mt < 2; ++mt) { float A = 1.f, B = 0.f;
#pragma unroll
                    for (int nt = 0; nt < 4; ++nt)
#pragma unroll
                        for (int j = 0; j < 4; ++j) { const float xc = bf2f(XC[(16 * nt + 4 * fq + j) * 72 + half * 32 + 16 * mt + fr]);
                            const float rg = fsigmoid(pa[mt][nt][j] + bav[mt]), ig = fsigmoid(px[mt][nt][j] + bxv[mt]); const float a = __expf(-8.f * rg * spv[mt]); const float bt = sqrtf((1.f - a) * (1.f + a)) * (ig * xc);
                            av[mt][nt * 4 + j] = a; bv[mt][nt * 4 + j] = bt; B = a * B + bt; A = A * a; }
                    { const float Al = __shfl_up(A, 16), Bl = __shfl_up(B, 16); if (fq >= 1) { B = A * Bl + B; A = A * Al; } }
                    { const float Al = __shfl_up(A, 32), Bl = __shfl_up(B, 32); if (fq >= 2) { B = A * Bl + B; A = A * Al; } }
                    { const float Al = __shfl_up(A, 16), Bl = __shfl_up(B, 16); Aex[mt] = fq >= 1 ? Al : 1.f; Bex[mt] = fq >= 1 ? Bl : 0.f; }
                    Atot[mt] = __shfl(A, 48 + fr); Btot[mt] = __shfl(B, 48 + fr); }
            }
            if (fq == 3) {
#pragma unroll
                for (int mt = 0; mt < 2; ++mt) { TOT[(w * 32 + 16 * mt + fr) * 2] = Atot[mt]; TOT[(w * 32 + 16 * mt + fr) * 2 + 1] = Btot[mt]; } }
            __syncthreads();
            float hin[2];
#pragma unroll
            for (int mt = 0; mt < 2; ++mt) { float h = hcar[mt]; hin[mt] = h;
#pragma unroll
                for (int ww = 0; ww < 8; ++ww) { const float At = TOT[(ww * 32 + 16 * mt + fr) * 2], Bt = TOT[(ww * 32 + 16 * mt + fr) * 2 + 1]; h = At * h + Bt; if (ww + 1 == w) hin[mt] = h; }
                hcar[mt] = h; }
            if (active && !isctx) {
                bf16_t* OUT = RAW;
#pragma unroll
                for (int mt = 0; mt < 2; ++mt) { float h = Aex[mt] * hin[mt] + Bex[mt];
#pragma unroll
                    for (int q = 0; q < 16; ++q) { h = av[mt][q] * h + bv[mt][q]; OUT[(16 * fq + q) * 40 + 16 * mt + fr] = (bf16_t)f2bf(h); } }
#pragma unroll
                for (int j = 0; j < 4; ++j) { const int ps = 16 * j + (lane >> 2), lc = lane & 3; const int sseg = s0 + ps; const int i = d ? len - 1 - sseg : sseg; const size_t row = (size_t)b * T + (size_t)((i & 63) * 64 + (i >> 6));
                    *(u32x4*)(Hd + row * LWD + g * 64 + half * 32 + 8 * lc) = *(const u32x4*)(OUT + ps * 40 + 8 * lc); }
            }
            __syncthreads();
        }
    }
}

constexpr int NSTRIP = NTOK / 32, NCHUNK = RW_COLS / 8;
__device__ __forceinline__ void phase_mixA(const bf16_t* __restrict__ RW, bf16_t* __restrict__ SIDE, int bid, int nb) {
    const int tid = otid(), lane = tid & 63, gw = bid * 8 + (tid >> 6), NGW = nb * 8;
    for (int it = gw; it < NSTRIP * 2; it += NGW) { const int sidx = it >> 1, wh = it & 1; const u32x4* src = (const u32x4*)(RW + (size_t)(sidx * 32 + wh * 31) * RW_COLS); u32x4* dst = (u32x4*)(SIDE + (size_t)it * RW_COLS);
        for (int ch = lane; ch < NCHUNK; ch += 64) dst[ch] = src[ch]; }
}
__device__ __forceinline__ void phase_mixB(bf16_t* __restrict__ RW, const bf16_t* __restrict__ SIDE, const float* __restrict__ mu, const float* __restrict__ k_k, float* __restrict__ KN, int bid, int nb) {
    const int tid = otid();
    for (int it = bid * 512 + tid; it < NSTRIP * NCHUNK; it += nb * 512) {
        const int sidx = it / NCHUNK, ch = it - sidx * NCHUNK, r0 = sidx * 32;
        const bool first = r0 < NLAT ? (r0 & (T - 1)) == 0 : ((r0 - NLAT) & (TC - 1)) == 0, last = r0 < NLAT ? ((r0 + 32) & (T - 1)) == 0 : ((r0 + 32 - NLAT) & (TC - 1)) == 0;
        const int act = (ch >= 192 && ch < 200) ? 1 : (ch >= 208 ? 2 : 0);
        const f32x4 mu0 = *(const f32x4*)(mu + 8 * ch), mu1 = *(const f32x4*)(mu + 8 * ch + 4); const float mm[8] = {mu0.x, mu0.y, mu0.z, mu0.w, mu1.x, mu1.y, mu1.z, mu1.w};
        const bool isk = ch >= 64 && ch < 128; const int kc = isk ? 8 * (ch - 64) : 0; const f32x4 kk0 = *(const f32x4*)(k_k + kc), kk1 = *(const f32x4*)(k_k + kc + 4); const float kkc[8] = {kk0.x, kk0.y, kk0.z, kk0.w, kk1.x, kk1.y, kk1.z, kk1.w};
        const u32x4 z = {0u, 0u, 0u, 0u};
        u32x4* col = (u32x4*)(RW + (size_t)r0 * RW_COLS + 8 * ch);
        u32x4 prev = first ? z : *(const u32x4*)(SIDE + ((size_t)(sidx - 1) * 2 + 1) * RW_COLS + 8 * ch);
        const u32x4 after = last ? z : *(const u32x4*)(SIDE + ((size_t)(sidx + 1) * 2) * RW_COLS + 8 * ch);
#pragma unroll 1
        for (int sb = 0; sb < 4; ++sb) { u32x4 rw[9];
#pragma unroll
            for (int j = 0; j < 8; ++j) rw[j] = col[(size_t)(sb * 8 + j) * NCHUNK];
            rw[8] = sb < 3 ? col[(size_t)(sb * 8 + 8) * NCHUNK] : after;
#pragma unroll
            for (int j = 0; j < 8; ++j) { float p_[8], m_[8], n_[8]; unpack8(rw[j], p_); unpack8(j == 0 ? prev : rw[j - 1], m_); unpack8(rw[j + 1], n_); float o[8];
#pragma unroll
                for (int e = 0; e < 8; ++e) { float v = p_[e] + mm[e] * (0.5f * (m_[e] + n_[e]) - p_[e]); o[e] = act == 1 ? ftanh(v) : act == 2 ? fsigmoid(v) : v; }
                u32x4 pk; pk.x = pk2(o[0], o[1]); pk.y = pk2(o[2], o[3]); pk.z = pk2(o[4], o[5]); pk.w = pk2(o[6], o[7]); col[(size_t)(sb * 8 + j) * NCHUNK] = pk;
                float ss = 0.f;
#pragma unroll
                for (int e = 0; e < 8; ++e) { const float kv = o[e] * kkc[e]; ss += kv * kv; }
                ss += __shfl_xor(ss, 1); ss += __shfl_xor(ss, 2); ss += __shfl_xor(ss, 4);
                if (isk && (ch & 7) == 0) KN[(size_t)(r0 + sb * 8 + j) * 8 + ((ch - 64) >> 3)] = 1.f / fmaxf(sqrtf(ss), 1e-12f); }
            prev = rw[7]; }
    }
}
__device__ __forceinline__ void phase_rwkv_seq2(const bf16_t* __restrict__ RW, const float* __restrict__ KN, bf16_t* __restrict__ Y0, bf16_t* __restrict__ Y1, const float* __restrict__ w0, const bf16_t* __restrict__ W2T,
                                                const float* __restrict__ a0, const bf16_t* __restrict__ A2T, const float* __restrict__ k_k, const float* __restrict__ k_a, unsigned char* lds, int bid, int nb) {
    const int tid0 = otid(), w = __builtin_amdgcn_readfirstlane(tid0 >> 6);
    constexpr int BUFB = 65536 + 8192 + 4096 + 256;
    for (int item = bid; item < 256; item += nb) {
        const int chain = item >> 1, vh = item & 1, b = chain >> 4, h = (chain >> 1) & 7, d = chain & 1;
        bf16_t* Yd = d ? Y1 : Y0;
        auto tok_row = [&](int cc, int j) -> size_t { const bool ic = cc < 4; const int ln = ic ? TC : T; const int ss = (ic ? cc * 64 : (cc - 4) * 64) + j, t = d == 0 ? ss : ln - 1 - ss; return (ic ? (size_t)NLAT + (size_t)b * TC : (size_t)b * T) + t; };
        auto prep = [&](int cc, int lane, int pw) {
            unsigned char* B_ = lds + (cc & 1) * BUFB; float* VEC = (float*)B_; float* VV = (float*)(B_ + 65536); float* PCV = (float*)(B_ + 65536 + 8192 + 4096);
            const int fr = lane & 15, fq = lane >> 4, i0 = 16 * pw + 4 * fq;
            { const int ptid = pw * 64 + lane, tk = ptid >> 2, part = ptid & 3; float v8[8]; unpack8(*(const u32x4*)(RW + tok_row(cc, tk) * RW_COLS + 1024 + h * 64 + vh * 32 + 8 * part), v8);
              *(f32x4*)(VV + tk * 32 + 8 * part) = (f32x4){v8[0], v8[1], v8[2], v8[3]}; *(f32x4*)(VV + tk * 32 + 8 * part + 4) = (f32x4){v8[4], v8[5], v8[6], v8[7]}; }
            bf16x8 bw[2], ba[2];
#pragma unroll
            for (int ks = 0; ks < 2; ++ks) { const size_t off = ((size_t)d * 512 + h * 64 + 16 * pw + fr) * 64 + ks * 32 + fq * 8; bw[ks] = *(const bf16x8*)(W2T + off); ba[ks] = *(const bf16x8*)(A2T + off); }
            const f32x4 w0c = *(const f32x4*)(w0 + d * 512 + h * 64 + i0), a0c = *(const f32x4*)(a0 + d * 512 + h * 64 + i0), kkc = *(const f32x4*)(k_k + h * 64 + i0), kac = *(const f32x4*)(k_a + h * 64 + i0);
            f32x4 run = {0.f, 0.f, 0.f, 0.f};
#pragma unroll 1
            for (int mt = 0; mt < 4; ++mt) {
                const int tk = 16 * mt + fr; const size_t row = tok_row(cc, tk); const bf16_t* p0 = RW + row * RW_COLS;
                f32x4 aw = {0.f, 0.f, 0.f, 0.f}, aa = {0.f, 0.f, 0.f, 0.f};
#pragma unroll
                for (int ks = 0; ks < 2; ++ks) { const bf16x8 fw = *(const bf16x8*)(p0 + 1536 + ks * 32 + fq * 8), fa = *(const bf16x8*)(p0 + 1600 + ks * 32 + fq * 8);
                    aw = __builtin_amdgcn_mfma_f32_16x16x32_bf16(bw[ks], fw, aw, 0, 0, 0); aa = __builtin_amdgcn_mfma_f32_16x16x32_bf16(ba[ks], fa, aa, 0, 0, 0); }
                const f32x4 r4 = ld_bf16x4(p0 + h * 64 + i0), k4 = ld_bf16x4(p0 + 512 + h * 64 + i0); const float inv = KN[row * 8 + h];
                f32x4 kkt, bt, kt, rt, tot;
#pragma unroll
                for (int r = 0; r < 4; ++r) { const float L = -0.6065306597126334f * fsigmoid(aw[r] + w0c[r]); float cs = L;
                    cs += dpp_mov<0x111>(cs); cs += dpp_mov<0x112>(cs); cs += dpp_mov<0x114>(cs); cs += dpp_mov<0x118>(cs);
                    tot[r] = __shfl(cs, (lane & 48) + 15);
                    const float cum = cs + run[r]; const float e1 = __expf(cum), ei = __builtin_amdgcn_rcpf(e1), e0 = __expf(cum - L);
                    const float a = fsigmoid(aa[r] + a0c[r]); const float kkn = k4[r] * kkc[r] * inv;
                    kkt[r] = kkn * e0; bt[r] = kkn * a * ei; kt[r] = k4[r] * (1.f + (a - 1.f) * kac[r]) * ei; rt[r] = r4[r] * e1; }
                run += tot;
                *(f32x4*)(VEC + (tk * 4 + 0) * 64 + i0) = kkt; *(f32x4*)(VEC + (tk * 4 + 1) * 64 + i0) = bt; *(f32x4*)(VEC + (tk * 4 + 2) * 64 + i0) = kt; *(f32x4*)(VEC + (tk * 4 + 3) * 64 + i0) = rt;
            }
            if (fr == 0) *(f32x4*)(PCV + i0) = (f32x4){__expf(run.x), __expf(run.y), __expf(run.z), __expf(run.w)};
        };
        auto yout = [&](int cc, int lane, int pw) { if (cc < 4) return; const bf16_t* YB = (const bf16_t*)(lds + (cc & 1) * BUFB + 65536 + 8192);
            const int ptid = pw * 64 + lane, tk = ptid >> 2, part = ptid & 3;
            *(u32x4*)(Yd + tok_row(cc, tk) * RWD + h * 64 + vh * 32 + 8 * part) = *(const u32x4*)(YB + tk * 32 + 8 * part); };
        f32x4 S = {0.f, 0.f, 0.f, 0.f}, S2 = {0.f, 0.f, 0.f, 0.f};
        __syncthreads();
        if (w >= 4) prep(0, tid0 & 63, w - 4);
        __syncthreads();
        for (int c = 0; c < 68; ++c) {
            int tid = tid0; asm volatile("" : "+v"(tid));
            const int lane = tid & 63;
            if (w < 4) {
                unsigned char* B_ = lds + (c & 1) * BUFB; const float* VEC = (const float*)B_; const float* VV = (const float*)(B_ + 65536); unsigned* YBw = (unsigned*)(B_ + 65536 + 8192); const float* PCV = (const float*)(B_ + 65536 + 8192 + 4096);
                const int sp = lane & 15, fq = lane >> 4, rA = w * 8 + fq * 2;
                const float* vp = VEC + 4 * sp; f32x4 kkv_ = *(const f32x4*)(vp), bv_ = *(const f32x4*)(vp + 64), kdv = *(const f32x4*)(vp + 128), rv = *(const f32x4*)(vp + 192); f32x2_ vv2 = *(const f32x2_*)(VV + rA);
                float a0_ = S.x, a1_ = S.y, a2_ = S.z, a3_ = S.w, b0_ = S2.x, b1_ = S2.y, b2_ = S2.z, b3_ = S2.w;
                f32x4 rpv = {0.f, 0.f, 0.f, 0.f};
                const bool o1 = sp & 1, o2 = sp & 2;
                auto yred = [&](const float (&yA)[4], const float (&yB)[4], int trow) {
                    float a_ = o1 ? yA[1] : yA[0], b_ = o1 ? yA[0] : yA[1], c_ = o1 ? yA[3] : yA[2], d_ = o1 ? yA[2] : yA[3];
                    float g_ = o1 ? yB[1] : yB[0], h_ = o1 ? yB[0] : yB[1], i_ = o1 ? yB[3] : yB[2], j_ = o1 ? yB[2] : yB[3];
                    a_ += dpp_mov<0xB1>(b_); g_ += dpp_mov<0xB1>(h_); c_ += dpp_mov<0xB1>(d_); i_ += dpp_mov<0xB1>(j_);
                    float e_ = o2 ? c_ : a_, f_ = o2 ? a_ : c_, k_ = o2 ? i_ : g_, l_ = o2 ? g_ : i_; e_ += dpp_mov<0x4E>(f_); k_ += dpp_mov<0x4E>(l_);
                    e_ += dpp_mov<0x124>(e_); k_ += dpp_mov<0x124>(k_); e_ += dpp_mov<0x128>(e_); k_ += dpp_mov<0x128>(k_);
                    const int tr = trow + sp; if (sp < 4 && tr >= 0) YBw[tr * 16 + (rA >> 1)] = pk2(e_, k_); };
#pragma unroll 1
                for (int t4 = 0; t4 < 64; t4 += 4) { float yA[4], yB[4];
#pragma unroll
                  for (int u = 0; u < 4; ++u) { const int t = t4 + u;
                    const int tn = t < 63 ? t + 1 : 63; const float* vn = VEC + tn * 256 + 4 * sp;
                    const f32x4 kkn_ = *(const f32x4*)(vn), bn = *(const f32x4*)(vn + 64), kdn = *(const f32x4*)(vn + 128), rn = *(const f32x4*)(vn + 192); const f32x2_ vvn = *(const f32x2_*)(VV + tn * 32 + rA);
                    asm volatile("" ::: "memory");
                    const float vva = vv2.x, vvb = vv2.y; float sa, sb, ya, yb;
                    asm volatile("v_mul_f32_e32 %0, %4, %12\n\tv_mul_f32_e32 %1, %8, %12\n\tv_fmac_f32_e32 %0, %5, %13\n\tv_fmac_f32_e32 %1, %9, %13\n\tv_fmac_f32_e32 %0, %6, %14\n\tv_fmac_f32_e32 %1, %10, %14\n\tv_fmac_f32_e32 %0, %7, %15\n\tv_fmac_f32_e32 %1, %11, %15\n\t"
                                 "v_mul_f32_e32 %2, %4, %16\n\tv_add_f32_dpp %0, %0, %0 quad_perm:[1,0,3,2] row_mask:0xf bank_mask:0xf bound_ctrl:1\n\tv_mul_f32_e32 %3, %8, %16\n\tv_add_f32_dpp %1, %1, %1 quad_perm:[1,0,3,2] row_mask:0xf bank_mask:0xf bound_ctrl:1\n\t"
                                 "v_fmac_f32_e32 %2, %5, %17\n\tv_add_f32_dpp %0, %0, %0 quad_perm:[2,3,0,1] row_mask:0xf bank_mask:0xf bound_ctrl:1\n\tv_fmac_f32_e32 %3, %9, %17\n\tv_add_f32_dpp %1, %1, %1 quad_perm:[2,3,0,1] row_mask:0xf bank_mask:0xf bound_ctrl:1\n\t"
                                 "v_fmac_f32_e32 %2, %6, %18\n\tv_add_f32_dpp %0, %0, %0 row_half_mirror row_mask:0xf bank_mask:0xf bound_ctrl:1\n\tv_fmac_f32_e32 %3, %10, %18\n\tv_add_f32_dpp %1, %1, %1 row_half_mirror row_mask:0xf bank_mask:0xf bound_ctrl:1\n\t"
                                 "v_fmac_f32_e32 %2, %7, %19\n\tv_add_f32_dpp %0, %0, %0 row_mirror row_mask:0xf bank_mask:0xf bound_ctrl:1\n\tv_fmac_f32_e32 %3, %11, %19\n\tv_add_f32_dpp %1, %1, %1 row_mirror row_mask:0xf bank_mask:0xf bound_ctrl:1\n\ts_nop 1"
                                 : "=&v"(sa), "=&v"(sb), "=&v"(ya), "=&v"(yb)
                                 : "v"(a0_), "v"(a1_), "v"(a2_), "v"(a3_), "v"(b0_), "v"(b1_), "v"(b2_), "v"(b3_), "v"(kkv_.x), "v"(kkv_.y), "v"(kkv_.z), "v"(kkv_.w), "v"(rpv.x), "v"(rpv.y), "v"(rpv.z), "v"(rpv.w));
                    yA[u] = ya; yB[u] = yb;
                    a0_ = fnma_s(bv_.x, sa, a0_); b0_ = fnma_s(bv_.x, sb, b0_); a1_ = fnma_s(bv_.y, sa, a1_); b1_ = fnma_s(bv_.y, sb, b1_); a2_ = fnma_s(bv_.z, sa, a2_); b2_ = fnma_s(bv_.z, sb, b2_); a3_ = fnma_s(bv_.w, sa, a3_); b3_ = fnma_s(bv_.w, sb, b3_);
                    a0_ = ffma_s(kdv.x, vva, a0_); b0_ = ffma_s(kdv.x, vvb, b0_); a1_ = ffma_s(kdv.y, vva, a1_); b1_ = ffma_s(kdv.y, vvb, b1_); a2_ = ffma_s(kdv.z, vva, a2_); b2_ = ffma_s(kdv.z, vvb, b2_); a3_ = ffma_s(kdv.w, vva, a3_); b3_ = ffma_s(kdv.w, vvb, b3_);
                    rpv = rv; kkv_ = kkn_; bv_ = bn; kdv = kdn; rv = rn; vv2 = vvn; }
                  yred(yA, yB, t4 - 1); }
                {
                  float ya = fmul_s(a0_, rpv.x), yb = fmul_s(b0_, rpv.x); ya = ffma_s(a1_, rpv.y, ya); yb = ffma_s(b1_, rpv.y, yb); ya = ffma_s(a2_, rpv.z, ya); yb = ffma_s(b2_, rpv.z, yb); ya = ffma_s(a3_, rpv.w, ya); yb = ffma_s(b3_, rpv.w, yb);
                  ya = red16(ya); yb = red16(yb); if (sp == 0) YBw[63 * 16 + (rA >> 1)] = pk2(ya, yb); }
                const f32x4 pc = *(const f32x4*)(PCV + 4 * sp); S = (f32x4){a0_ * pc.x, a1_ * pc.y, a2_ * pc.z, a3_ * pc.w}; S2 = (f32x4){b0_ * pc.x, b1_ * pc.y, b2_ * pc.z, b3_ * pc.w};
            } else {
                if (c >= 1) yout(c - 1, lane, w - 4);
                if (c + 1 < 68) prep(c + 1, lane, w - 4);
            }
            __syncthreads();
        }
        if (w >= 4) yout(67, tid0 & 63, w - 4);
    }
}
__device__ __forceinline__ void phase_rwkv_seq3(const bf16_t* __restrict__ RW, const float* __restrict__ KN, bf16_t* __restrict__ Y0, bf16_t* __restrict__ Y1, const float* __restrict__ w0, const bf16_t* __restrict__ W2T,
                                                const float* __restrict__ a0, const bf16_t* __restrict__ A2T, const float* __restrict__ k_k, const float* __restrict__ k_a, unsigned char* lds, int bid, int nb) {
    const int tid0 = otid(), w = __builtin_amdgcn_readfirstlane(tid0 >> 6);
    constexpr int CH = 32, NCH = (TC + T) / CH, NCX = TC / CH;
    constexpr int VSTR = 196;
    constexpr int A_BYTES = CH * VSTR * 4 + CH * 32 * 4 + 256;
    constexpr int B_BYTES = 3 * CH * 144 + 32 * 80;
    constexpr int C_BYTES = 32 * 144 + 32 * 144;
    constexpr int OFF_B = 2 * A_BYTES, OFF_C = OFF_B + 3 * B_BYTES;
    static_assert(OFF_C + 2 * C_BYTES <= 163584, "LDS");
    for (int item = bid; item < 256; item += nb) {
        const int chain = item >> 1, vh = item & 1, b = chain >> 4, h = (chain >> 1) & 7, d = chain & 1;
        bf16_t* Yd = d ? Y1 : Y0;
        auto tok_row = [&](int cc, int j) -> size_t { const bool ic = cc < NCX; const int ln = ic ? TC : T; const int ss = (ic ? cc : cc - NCX) * CH + j, t = d == 0 ? ss : ln - 1 - ss; return (ic ? (size_t)NLAT + (size_t)b * TC : (size_t)b * T) + t; };
        struct Raw { bf16x8 fw[2][2], fa[2][2], bw[2], ba[2]; u32x2 r4[2], k4[2], v; float inv[2]; f32x4 w0c, a0c, kkc, kac; };
        auto prep_load = [&](int cc, int lane, int pw, Raw& R) {
            const int fr = lane & 15, fq = lane >> 4, i0 = 16 * pw + 4 * fq;
            { const int ptid = pw * 64 + lane, tk = ptid >> 3, part = ptid & 7; R.v = *(const u32x2*)(RW + tok_row(cc, tk) * RW_COLS + 1024 + h * 64 + vh * 32 + 4 * part); }
#pragma unroll
            for (int mt = 0; mt < 2; ++mt) { const size_t row = tok_row(cc, 16 * mt + fr); const bf16_t* p0 = RW + row * RW_COLS;
#pragma unroll
                for (int ks = 0; ks < 2; ++ks) { R.fw[mt][ks] = *(const bf16x8*)(p0 + 1536 + ks * 32 + fq * 8); R.fa[mt][ks] = *(const bf16x8*)(p0 + 1600 + ks * 32 + fq * 8); }
                R.r4[mt] = *(const u32x2*)(p0 + h * 64 + i0); R.k4[mt] = *(const u32x2*)(p0 + 512 + h * 64 + i0); R.inv[mt] = KN[row * 8 + h]; }
#pragma unroll
            for (int ks = 0; ks < 2; ++ks) { const size_t off = ((size_t)d * 512 + h * 64 + 16 * pw + fr) * 64 + ks * 32 + fq * 8; R.bw[ks] = *(const bf16x8*)(W2T + off); R.ba[ks] = *(const bf16x8*)(A2T + off); }
            R.w0c = *(const f32x4*)(w0 + d * 512 + h * 64 + i0); R.a0c = *(const f32x4*)(a0 + d * 512 + h * 64 + i0); R.kkc = *(const f32x4*)(k_k + h * 64 + i0); R.kac = *(const f32x4*)(k_a + h * 64 + i0);
            asm volatile("" ::: "memory");
        };
        auto prep = [&](int cc, int lane, int pw, const Raw& R) {
            unsigned char* A_ = lds + (cc & 1) * A_BYTES; float* VEC = (float*)A_; float* VV = (float*)(A_ + CH * VSTR * 4); float* PCV = (float*)(A_ + CH * VSTR * 4 + CH * 32 * 4);
            bf16_t* RBp = (bf16_t*)(lds + OFF_B + (cc % 3) * B_BYTES); bf16_t* KBp = RBp + CH * 72; bf16_t* BBp = KBp + CH * 72; bf16_t* VTp = BBp + CH * 72;
            const int fr = lane & 15, fq = lane >> 4, i0 = 16 * pw + 4 * fq;
            { const int ptid = pw * 64 + lane, tk = ptid >> 3, part = ptid & 7; const u32x2 raw = R.v;
              *(f32x4*)(VV + tk * 32 + 4 * part) = (f32x4){__builtin_bit_cast(float, raw.x << 16), __builtin_bit_cast(float, raw.x & 0xffff0000u), __builtin_bit_cast(float, raw.y << 16), __builtin_bit_cast(float, raw.y & 0xffff0000u)};
              bf16_t* vt = VTp + (4 * part) * 40 + tk; vt[0] = (bf16_t)raw.x; vt[40] = (bf16_t)(raw.x >> 16); vt[80] = (bf16_t)raw.y; vt[120] = (bf16_t)(raw.y >> 16); }
            const f32x4 w0c = R.w0c, a0c = R.a0c, kkc = R.kkc, kac = R.kac;
            f32x4 run = {0.f, 0.f, 0.f, 0.f};
#pragma unroll
            for (int mt = 0; mt < 2; ++mt) {
                const int tk = 16 * mt + fr;
                f32x4 aw = {0.f, 0.f, 0.f, 0.f}, aa = {0.f, 0.f, 0.f, 0.f};
#pragma unroll
                for (int ks = 0; ks < 2; ++ks) { aw = __builtin_amdgcn_mfma_f32_16x16x32_bf16(R.bw[ks], R.fw[mt][ks], aw, 0, 0, 0); aa = __builtin_amdgcn_mfma_f32_16x16x32_bf16(R.ba[ks], R.fa[mt][ks], aa, 0, 0, 0); }
                const u32x2 rr = R.r4[mt], kr = R.k4[mt];
                const f32x4 r4 = {__builtin_bit_cast(float, rr.x << 16), __builtin_bit_cast(float, rr.x & 0xffff0000u), __builtin_bit_cast(float, rr.y << 16), __builtin_bit_cast(float, rr.y & 0xffff0000u)};
                const f32x4 k4 = {__builtin_bit_cast(float, kr.x << 16), __builtin_bit_cast(float, kr.x & 0xffff0000u), __builtin_bit_cast(float, kr.y << 16), __builtin_bit_cast(float, kr.y & 0xffff0000u)};
                const float inv = R.inv[mt];
                f32x4 kkt, bt, kt, rt, tot;
#pragma unroll
                for (int r = 0; r < 4; ++r) { const float L = -0.6065306597126334f * fsigmoid(aw[r] + w0c[r]); float cs = L;
                    cs += dpp_mov<0x111>(cs); cs += dpp_mov<0x112>(cs); cs += dpp_mov<0x114>(cs); cs += dpp_mov<0x118>(cs);
                    tot[r] = __shfl(cs, (lane & 48) + 15);
                    const float cum = cs + run[r]; const float e1 = __expf(cum), ei = __builtin_amdgcn_rcpf(e1), e0 = __expf(cum - L);
                    const float a = fsigmoid(aa[r] + a0c[r]); const float kkn = k4[r] * kkc[r] * inv;
                    kkt[r] = kkn * e0; bt[r] = kkn * a * ei; kt[r] = k4[r] * (1.f + (a - 1.f) * kac[r]) * ei; rt[r] = r4[r] * e1; }
                run += tot;
                float* vp = VEC + tk * VSTR + i0; *(f32x4*)(vp) = kkt; *(f32x4*)(vp + 64) = bt; *(f32x4*)(vp + 128) = kt;
                *(u32x2*)(RBp + tk * 72 + i0) = (u32x2){pk2(rt.x, rt.y), pk2(rt.z, rt.w)}; *(u32x2*)(KBp + tk * 72 + i0) = (u32x2){pk2(kt.x, kt.y), pk2(kt.z, kt.w)}; *(u32x2*)(BBp + tk * 72 + i0) = (u32x2){pk2(bt.x, bt.y), pk2(bt.z, bt.w)};
            }
            if (fr == 0) *(f32x4*)(PCV + i0) = (f32x4){__expf(run.x), __expf(run.y), __expf(run.z), __expf(run.w)};
        };
        auto ycomp = [&](int cc, int lane, int pw) {
            if (cc < NCX) return;
            const bf16_t* RBp = (const bf16_t*)(lds + OFF_B + (cc % 3) * B_BYTES); const bf16_t* KBp = RBp + CH * 72; const bf16_t* BBp = KBp + CH * 72; const bf16_t* VTp = BBp + CH * 72;
            const float* SAF = (const float*)(lds + OFF_C + (cc & 1) * C_BYTES); const bf16_t* S0B = (const bf16_t*)(lds + OFF_C + (cc & 1) * C_BYTES + 32 * 144);
            const int fr = lane & 15, q = lane >> 4, mt = pw >> 1, nt = pw & 1;
            const bf16x8 r0 = *(const bf16x8*)(RBp + (16 * mt + fr) * 72 + 8 * q), r1 = *(const bf16x8*)(RBp + (16 * mt + fr) * 72 + 32 + 8 * q);
            const f32x4 z4 = {0.f, 0.f, 0.f, 0.f};
            f32x4 gk0, gb0, gk1 = z4, gb1 = z4;
            { const bf16x8 k0 = *(const bf16x8*)(KBp + fr * 72 + 8 * q), k1 = *(const bf16x8*)(KBp + fr * 72 + 32 + 8 * q), b0 = *(const bf16x8*)(BBp + fr * 72 + 8 * q), b1 = *(const bf16x8*)(BBp + fr * 72 + 32 + 8 * q);
              gk0 = __builtin_amdgcn_mfma_f32_16x16x32_bf16(k0, r0, z4, 0, 0, 0); gk0 = __builtin_amdgcn_mfma_f32_16x16x32_bf16(k1, r1, gk0, 0, 0, 0);
              gb0 = __builtin_amdgcn_mfma_f32_16x16x32_bf16(b0, r0, z4, 0, 0, 0); gb0 = __builtin_amdgcn_mfma_f32_16x16x32_bf16(b1, r1, gb0, 0, 0, 0); }
            if (mt == 1) {
              const bf16x8 k0 = *(const bf16x8*)(KBp + (16 + fr) * 72 + 8 * q), k1 = *(const bf16x8*)(KBp + (16 + fr) * 72 + 32 + 8 * q), b0 = *(const bf16x8*)(BBp + (16 + fr) * 72 + 8 * q), b1 = *(const bf16x8*)(BBp + (16 + fr) * 72 + 32 + 8 * q);
              gk1 = __builtin_amdgcn_mfma_f32_16x16x32_bf16(k0, r0, z4, 0, 0, 0); gk1 = __builtin_amdgcn_mfma_f32_16x16x32_bf16(k1, r1, gk1, 0, 0, 0);
              gb1 = __builtin_amdgcn_mfma_f32_16x16x32_bf16(b0, r0, z4, 0, 0, 0); gb1 = __builtin_amdgcn_mfma_f32_16x16x32_bf16(b1, r1, gb1, 0, 0, 0);
#pragma unroll
              for (int r = 0; r < 4; ++r) { const bool keep = 4 * q + r <= fr; gk1[r] = keep ? gk1[r] : 0.f; gb1[r] = keep ? gb1[r] : 0.f; }
            } else {
#pragma unroll
              for (int r = 0; r < 4; ++r) { const bool keep = 4 * q + r <= fr; gk0[r] = keep ? gk0[r] : 0.f; gb0[r] = keep ? gb0[r] : 0.f; }
            }
            const u32x4 gkp = {pk2(gk0[0], gk0[1]), pk2(gk0[2], gk0[3]), pk2(gk1[0], gk1[1]), pk2(gk1[2], gk1[3])};
            const u32x4 gbp = {pk2(-gb0[0], -gb0[1]), pk2(-gb0[2], -gb0[3]), pk2(-gb1[0], -gb1[1]), pk2(-gb1[2], -gb1[3])};
            const int ri = 16 * nt + fr;
            const u32x2 v0 = *(const u32x2*)(VTp + ri * 40 + 4 * q), v1 = *(const u32x2*)(VTp + ri * 40 + 16 + 4 * q);
            const f32x4 s0 = *(const f32x4*)(SAF + ri * 36 + 4 * q), s1 = *(const f32x4*)(SAF + ri * 36 + 16 + 4 * q);
            const u32x4 vtp = {v0.x, v0.y, v1.x, v1.y}, sap = {pk2(s0.x, s0.y), pk2(s0.z, s0.w), pk2(s1.x, s1.y), pk2(s1.z, s1.w)};
            const bf16x8 z0 = *(const bf16x8*)(S0B + ri * 72 + 8 * q), z1 = *(const bf16x8*)(S0B + ri * 72 + 32 + 8 * q);
            f32x4 y = __builtin_amdgcn_mfma_f32_16x16x32_bf16(__builtin_bit_cast(bf16x8, vtp), __builtin_bit_cast(bf16x8, gkp), z4, 0, 0, 0);
            y = __builtin_amdgcn_mfma_f32_16x16x32_bf16(__builtin_bit_cast(bf16x8, sap), __builtin_bit_cast(bf16x8, gbp), y, 0, 0, 0);
            y = __builtin_amdgcn_mfma_f32_16x16x32_bf16(z0, r0, y, 0, 0, 0); y = __builtin_amdgcn_mfma_f32_16x16x32_bf16(z1, r1, y, 0, 0, 0);
            *(u32x2*)(Yd + tok_row(cc, 16 * mt + fr) * RWD + h * 64 + vh * 32 + 16 * nt + 4 * q) = (u32x2){pk2(y[0], y[1]), pk2(y[2], y[3])};
        };
        f32x4 S = {0.f, 0.f, 0.f, 0.f}, S2 = {0.f, 0.f, 0.f, 0.f};
        __syncthreads();
        if (w >= 4) { Raw raw; prep_load(0, tid0 & 63, w - 4, raw); prep(0, tid0 & 63, w - 4, raw); }
        __syncthreads();
        for (int c = 0; c < NCH; ++c) {
            int tid = tid0; asm volatile("" : "+v"(tid));
            const int lane = tid & 63;
            if (w < 4) {
                const unsigned char* A_ = lds + (c & 1) * A_BYTES; const float* VEC = (const float*)A_; const float* VV = (const float*)(A_ + CH * VSTR * 4); const float* PCV = (const float*)(A_ + CH * VSTR * 4 + CH * 32 * 4);
                float* SAF = (float*)(lds + OFF_C + (c & 1) * C_BYTES); bf16_t* S0B = (bf16_t*)(lds + OFF_C + (c & 1) * C_BYTES + 32 * 144);
                const int sp = lane & 15, fq = lane >> 4, rA = w * 8 + fq * 2;
                *(u32x2*)(S0B + rA * 72 + 4 * sp) = (u32x2){pk2(S.x, S.y), pk2(S.z, S.w)}; *(u32x2*)(S0B + (rA + 1) * 72 + 4 * sp) = (u32x2){pk2(S2.x, S2.y), pk2(S2.z, S2.w)};
                unsigned saw = (unsigned)(size_t)(LAS float*)(SAF + rA * 36); asm volatile("" : "+v"(saw));
                const unsigned long long m_sp0 = __ballot(sp == 0);
                const float* vp = VEC + 4 * sp; f32x4 kkv_ = *(const f32x4*)(vp), bv_ = *(const f32x4*)(vp + 64), kdv = *(const f32x4*)(vp + 128); f32x2_ vv2 = *(const f32x2_*)(VV + rA);
                float a0_ = S.x, a1_ = S.y, a2_ = S.z, a3_ = S.w, b0_ = S2.x, b1_ = S2.y, b2_ = S2.z, b3_ = S2.w;
#pragma unroll 1
                for (int t4 = 0; t4 < CH; t4 += 4) {
#pragma unroll
                  for (int u = 0; u < 4; ++u) { const int t = t4 + u;
                    const int tn = t < CH - 1 ? t + 1 : CH - 1; const float* vn = VEC + tn * VSTR + 4 * sp;
                    const f32x4 kkn_ = *(const f32x4*)(vn), bn = *(const f32x4*)(vn + 64), kdn = *(const f32x4*)(vn + 128); const f32x2_ vvn = *(const f32x2_*)(VV + tn * 32 + rA);
                    asm volatile("" ::: "memory");
                    const float vva = vv2.x, vvb = vv2.y; float sa, sb;
                    asm volatile("v_mul_f32_e32 %8, %0, %10\n\tv_mul_f32_e32 %9, %4, %10\n\tv_fmac_f32_e32 %8, %1, %11\n\tv_fmac_f32_e32 %9, %5, %11\n\tv_fmac_f32_e32 %8, %2, %12\n\tv_fmac_f32_e32 %9, %6, %12\n\tv_fmac_f32_e32 %8, %3, %13\n\tv_fmac_f32_e32 %9, %7, %13\n\t"
                                 "v_fmac_f32_e32 %0, %14, %18\n\tv_add_f32_dpp %8, %8, %8 quad_perm:[1,0,3,2] row_mask:0xf bank_mask:0xf bound_ctrl:1\n\tv_fmac_f32_e32 %4, %14, %19\n\tv_add_f32_dpp %9, %9, %9 quad_perm:[1,0,3,2] row_mask:0xf bank_mask:0xf bound_ctrl:1\n\t"
                                 "v_fmac_f32_e32 %1, %15, %18\n\tv_add_f32_dpp %8, %8, %8 quad_perm:[2,3,0,1] row_mask:0xf bank_mask:0xf bound_ctrl:1\n\tv_fmac_f32_e32 %5, %15, %19\n\tv_add_f32_dpp %9, %9, %9 quad_perm:[2,3,0,1] row_mask:0xf bank_mask:0xf bound_ctrl:1\n\t"
                                 "v_fmac_f32_e32 %2, %16, %18\n\tv_add_f32_dpp %8, %8, %8 row_half_mirror row_mask:0xf bank_mask:0xf bound_ctrl:1\n\tv_fmac_f32_e32 %6, %16, %19\n\tv_add_f32_dpp %9, %9, %9 row_half_mirror row_mask:0xf bank_mask:0xf bound_ctrl:1\n\t"
                                 "v_fmac_f32_e32 %3, %17, %18\n\tv_add_f32_dpp %8, %8, %8 row_mirror row_mask:0xf bank_mask:0xf bound_ctrl:1\n\tv_fmac_f32_e32 %7, %17, %19\n\tv_add_f32_dpp %9, %9, %9 row_mirror row_mask:0xf bank_mask:0xf bound_ctrl:1"
                                 : "+v"(a0_), "+v"(a1_), "+v"(a2_), "+v"(a3_), "+v"(b0_), "+v"(b1_), "+v"(b2_), "+v"(b3_), "=&v"(sa), "=&v"(sb)
                                 : "v"(kkv_.x), "v"(kkv_.y), "v"(kkv_.z), "v"(kkv_.w), "v"(kdv.x), "v"(kdv.y), "v"(kdv.z), "v"(kdv.w), "v"(vva), "v"(vvb));
                    asm volatile("s_mov_b64 exec, %3\n\tds_write2_b32 %0, %1, %2 offset0:%4 offset1:%5\n\ts_mov_b64 exec, -1" :: "v"(saw + 4 * t4), "v"(sa), "v"(sb), "s"(m_sp0), "n"(u), "n"(36 + u) : "memory");
                    a0_ = fnma_s(bv_.x, sa, a0_); b0_ = fnma_s(bv_.x, sb, b0_); a1_ = fnma_s(bv_.y, sa, a1_); b1_ = fnma_s(bv_.y, sb, b1_); a2_ = fnma_s(bv_.z, sa, a2_); b2_ = fnma_s(bv_.z, sb, b2_); a3_ = fnma_s(bv_.w, sa, a3_); b3_ = fnma_s(bv_.w, sb, b3_);
                    kkv_ = kkn_; bv_ = bn; kdv = kdn; vv2 = vvn; }
                }
                const f32x4 pc = *(const f32x4*)(PCV + 4 * sp); S = (f32x4){a0_ * pc.x, a1_ * pc.y, a2_ * pc.z, a3_ * pc.w}; S2 = (f32x4){b0_ * pc.x, b1_ * pc.y, b2_ * pc.z, b3_ * pc.w};
            } else {
                Raw raw; prep_load(c + 1 < NCH ? c + 1 : NCH - 1, lane, w - 4, raw);
                if (c >= 1) ycomp(c - 1, lane, w - 4);
                if (c + 1 < NCH) prep(c + 1, lane, w - 4, raw);
            }
            __syncthreads();
        }
        if (w >= 4) ycomp(NCH - 1, tid0 & 63, w - 4);
    }
}
__device__ __forceinline__ void phase_rwkv_full(const bf16_t* __restrict__ RW, const float* __restrict__ KN, bf16_t* __restrict__ Y0, bf16_t* __restrict__ Y1, const float* __restrict__ w0, const bf16_t* __restrict__ W2T,
                                                const float* __restrict__ a0, const bf16_t* __restrict__ A2T, const float* __restrict__ k_k, const float* __restrict__ k_a,
                                                const float* __restrict__ mw1, const float* __restrict__ mw3, const float* __restrict__ mw2, bf16_t* __restrict__ W13, bf16_t* __restrict__ W2, unsigned char* lds, int bid, int nb) {
    const int tid0 = otid(), w = __builtin_amdgcn_readfirstlane(tid0 >> 6);
    constexpr int CH = 32, NCH = (TC + T) / CH, NCX = TC / CH;
    constexpr int A_BYTES = 256;
    constexpr int B_BYTES = 3 * CH * 144 + 64 * 80;
    constexpr int E_BYTES = CH * 144 + 2 * 64 * 80;
    constexpr int C_BYTES = 64 * 80 + 64 * 144;
    constexpr int D_BYTES = 5 * CH * 144 + 128;
    constexpr int OFF_B = 2 * A_BYTES, OFF_C = OFF_B + 3 * B_BYTES, OFF_D = OFF_C + 2 * C_BYTES, OFF_E = OFF_D + 2 * D_BYTES;
    static_assert(OFF_E + 2 * E_BYTES <= 163584, "LDS");
    for (int item = bid; item < 128; item += nb) {
        const int chain = item, b = chain >> 4, h = (chain >> 1) & 7, d = chain & 1;
        bf16_t* Yd = d ? Y1 : Y0;
        auto tok_row = [&](int cc, int j) -> size_t { const bool ic = cc < NCX; const int ln = ic ? TC : T; const int ss = (ic ? cc : cc - NCX) * CH + j, t = d == 0 ? ss : ln - 1 - ss; return (ic ? (size_t)NLAT + (size_t)b * TC : (size_t)b * T) + t; };
        auto tok_ri = [&](int cc, int j) -> unsigned { const bool ic = cc < NCX; const int ln = ic ? TC : T; const int ss = (ic ? cc : cc - NCX) * CH + j, t = d == 0 ? ss : ln - 1 - ss; return (unsigned)((ic ? NLAT + b * TC : b * T) + t); };
        struct RawL { u32x4 p[20]; float kn; };
        auto ld_issue = [&](int cc, int lane, RawL& R) {
            const char* RWb = (const char*)RW;
#pragma unroll
            for (int it = 0; it < 8; ++it) { const int tok = it * 4 + (lane >> 4), p = lane & 15; R.p[it] = *(const u32x4*)(RWb + (tok_ri(cc, tok) * (unsigned)(RW_COLS * 2) + (unsigned)(3072 + 16 * p))); }
#pragma unroll
            for (int it = 0; it < 4; ++it) { const int tok = it * 8 + (lane >> 3), p = lane & 7; const unsigned o_ = tok_ri(cc, tok) * (unsigned)(RW_COLS * 2) + (unsigned)(h * 128 + 16 * p); R.p[8 + it] = *(const u32x4*)(RWb + o_); R.p[12 + it] = *(const u32x4*)(RWb + (o_ + 1024u)); }
#pragma unroll
            for (int it = 0; it < 4; ++it) { const int tok = it * 8 + (lane >> 3), p = lane & 7; R.p[16 + it] = *(const u32x4*)(RWb + (tok_ri(cc, tok) * (unsigned)(RW_COLS * 2) + (unsigned)(2048 + h * 128 + 16 * p))); }
            R.kn = *(const float*)((const char*)KN + (tok_ri(cc, lane & 31) * 32u + (unsigned)(h * 4)));
            asm volatile("" ::: "memory");
        };
        auto ld_commit = [&](int cc, int lane, const RawL& R) {
            bf16_t* WD = (bf16_t*)(lds + OFF_D + (cc & 1) * D_BYTES); bf16_t* RI = WD + 2 * CH * 72; bf16_t* KI = RI + CH * 72; bf16_t* VI = KI + CH * 72; float* KNs = (float*)(VI + CH * 72);
#pragma unroll
            for (int it = 0; it < 8; ++it) { const int tok = it * 4 + (lane >> 4), p = lane & 15; *(u32x4*)(WD + (p >> 3) * (CH * 72) + tok * 72 + 8 * (p & 7)) = R.p[it]; }
#pragma unroll
            for (int it = 0; it < 4; ++it) { const int tok = it * 8 + (lane >> 3), p = lane & 7; *(u32x4*)(RI + tok * 72 + 8 * p) = R.p[8 + it]; *(u32x4*)(KI + tok * 72 + 8 * p) = R.p[12 + it]; }
#pragma unroll
            for (int it = 0; it < 4; ++it) { const int tok = it * 8 + (lane >> 3), p = lane & 7; *(u32x4*)(VI + tok * 72 + 8 * p) = R.p[16 + it]; }
            if (lane < 32) KNs[lane] = R.kn;
        };
        auto wt_src = [&](int it, int& k0, int& n0, int& rmul, int& radd, bf16_t*& dst) -> const float* {
            const int m = it >> 12, r = it & 4095, e = r >> 8, tt = r & 255; k0 = (tt >> 4) * 64; n0 = (tt & 15) * 64;
            const float* src = (m == 0 ? mw1 : m == 1 ? mw3 : mw2) + (size_t)e * 1024 * 1024; rmul = m == 2 ? 4 : 8; radd = m == 1 ? 4 : 0; dst = m == 2 ? W2 + (size_t)e * 1024 * 1024 : W13 + (size_t)e * 2048 * 1024;
            return src + (size_t)k0 * 1024 + n0; };
        auto wt_issue = [&](int it, int lane, float (&v)[64]) { int k0, n0, rmul, radd; bf16_t* dst; const float* sp = wt_src(it, k0, n0, rmul, radd, dst); const unsigned lo = (unsigned)lane * 4u;
            const unsigned long long pb = (unsigned long long)sp; const __attribute__((address_space(1))) char* sb = (const __attribute__((address_space(1))) char*)(((unsigned long long)(unsigned)__builtin_amdgcn_readfirstlane((int)(pb >> 32)) << 32) | (unsigned)__builtin_amdgcn_readfirstlane((int)pb));
#pragma unroll
            for (int i = 0; i < 64; ++i) v[i] = *(const __attribute__((address_space(1))) float*)(sb + ((unsigned)(i * 4096) + lo));
            asm volatile("" ::: "memory"); };
        auto wt_finish = [&](int it, int lane, const float (&v)[64]) { int k0, n0, rmul, radd; bf16_t* dst; (void)wt_src(it, k0, n0, rmul, radd, dst);
            const int nn = n0 + lane, row = (nn >> 2) * rmul + (nn & 3) + radd; bf16_t* dp = dst + (size_t)row * 1024 + k0;
#pragma unroll
            for (int c = 0; c < 8; ++c) { u32x4 o; o.x = pk2(v[8 * c], v[8 * c + 1]); o.y = pk2(v[8 * c + 2], v[8 * c + 3]); o.z = pk2(v[8 * c + 4], v[8 * c + 5]); o.w = pk2(v[8 * c + 6], v[8 * c + 7]); *(u32x4*)(dp + 8 * c) = o; } };
        struct PCst { bf16x8 bw[2], ba[2]; f32x4 w0c, a0c, kkc, kac; };
        PCst PC_;
        if (w >= 4) { const int lane = tid0 & 63, pw = w - 4, fr = lane & 15, fq = lane >> 4, i0 = 16 * pw + 4 * fq;
#pragma unroll
            for (int ks = 0; ks < 2; ++ks) { const size_t off = ((size_t)d * 512 + h * 64 + 16 * pw + fr) * 64 + ks * 32 + fq * 8; PC_.bw[ks] = *(const bf16x8*)(W2T + off); PC_.ba[ks] = *(const bf16x8*)(A2T + off); }
            PC_.w0c = *(const f32x4*)(w0 + d * 512 + h * 64 + i0); PC_.a0c = *(const f32x4*)(a0 + d * 512 + h * 64 + i0); PC_.kkc = *(const f32x4*)(k_k + h * 64 + i0); PC_.kac = *(const f32x4*)(k_a + h * 64 + i0); }
        auto prep = [&](int cc, int lane, int pw) {
            float* PCV = (float*)(lds + (cc & 1) * A_BYTES);
            const bf16_t* WD = (const bf16_t*)(lds + OFF_D + (cc & 1) * D_BYTES); const bf16_t* AD = WD + CH * 72; const bf16_t* RI = AD + CH * 72; const bf16_t* KI = RI + CH * 72; const bf16_t* VI = KI + CH * 72; const float* KNs = (const float*)(VI + CH * 72);
            bf16_t* RBp = (bf16_t*)(lds + OFF_B + (cc % 3) * B_BYTES); bf16_t* KBp = RBp + CH * 72; bf16_t* BBp = KBp + CH * 72; bf16_t* VTp = BBp + CH * 72; bf16_t* KKp = (bf16_t*)(lds + OFF_E + (cc & 1) * E_BYTES); bf16_t* KTp = KKp + CH * 72; bf16_t* BTp = KTp + 64 * 40;
            const int fr = lane & 15, fq = lane >> 4, i0 = 16 * pw + 4 * fq;
            { const int ptid = pw * 64 + lane, tk = ptid >> 3, part = ptid & 7; const u32x4 raw = *(const u32x4*)(VI + tk * 72 + 8 * part);
              bf16_t* vt = VTp + (8 * part) * 40 + tk; vt[0] = (bf16_t)raw.x; vt[40] = (bf16_t)(raw.x >> 16); vt[80] = (bf16_t)raw.y; vt[120] = (bf16_t)(raw.y >> 16); vt[160] = (bf16_t)raw.z; vt[200] = (bf16_t)(raw.z >> 16); vt[240] = (bf16_t)raw.w; vt[280] = (bf16_t)(raw.w >> 16); }
            const f32x4 w0c = PC_.w0c, a0c = PC_.a0c, kkc = PC_.kkc, kac = PC_.kac;
            f32x4 run = {0.f, 0.f, 0.f, 0.f};
#pragma unroll
            for (int mt = 0; mt < 2; ++mt) {
                const int tk = 16 * mt + fr;
                f32x4 aw = {0.f, 0.f, 0.f, 0.f}, aa = {0.f, 0.f, 0.f, 0.f};
#pragma unroll
                for (int ks = 0; ks < 2; ++ks) { const bf16x8 fw = *(const bf16x8*)(WD + tk * 72 + ks * 32 + fq * 8), fa = *(const bf16x8*)(AD + tk * 72 + ks * 32 + fq * 8);
                    aw = __builtin_amdgcn_mfma_f32_16x16x32_bf16(PC_.bw[ks], fw, aw, 0, 0, 0); aa = __builtin_amdgcn_mfma_f32_16x16x32_bf16(PC_.ba[ks], fa, aa, 0, 0, 0); }
                const u32x2 rr = *(const u32x2*)(RI + tk * 72 + i0), kr = *(const u32x2*)(KI + tk * 72 + i0);
                const f32x4 r4 = {__builtin_bit_cast(float, rr.x << 16), __builtin_bit_cast(float, rr.x & 0xffff0000u), __builtin_bit_cast(float, rr.y << 16), __builtin_bit_cast(float, rr.y & 0xffff0000u)};
                const f32x4 k4 = {__builtin_bit_cast(float, kr.x << 16), __builtin_bit_cast(float, kr.x & 0xffff0000u), __builtin_bit_cast(float, kr.y << 16), __builtin_bit_cast(float, kr.y & 0xffff0000u)};
                const float inv = KNs[tk];
                f32x4 kkt, bt, kt, rt, tot;
#pragma unroll
                for (int r = 0; r < 4; ++r) { const float L = -0.6065306597126334f * fsigmoid(aw[r] + w0c[r]); float cs = L;
                    cs += dpp_mov<0x111>(cs); cs += dpp_mov<0x112>(cs); cs += dpp_mov<0x114>(cs); cs += dpp_mov<0x118>(cs);
                    tot[r] = __shfl(cs, (lane & 48) + 15);
                    const float cum = cs + run[r]; const float e1 = __expf(cum), ei = __builtin_amdgcn_rcpf(e1), e0 = __expf(cum - L);
                    const float a = fsigmoid(aa[r] + a0c[r]); const float kkn = k4[r] * kkc[r] * inv;
                    kkt[r] = kkn * e0; bt[r] = kkn * a * ei; kt[r] = k4[r] * (1.f + (a - 1.f) * kac[r]) * ei; rt[r] = r4[r] * e1; }
                run += tot;
                const u32x2 kp = {pk2(kt.x, kt.y), pk2(kt.z, kt.w)}, bp = {pk2(bt.x, bt.y), pk2(bt.z, bt.w)};
                *(u32x2*)(RBp + tk * 72 + i0) = (u32x2){pk2(rt.x, rt.y), pk2(rt.z, rt.w)}; *(u32x2*)(KBp + tk * 72 + i0) = kp; *(u32x2*)(BBp + tk * 72 + i0) = bp; *(u32x2*)(KKp + tk * 72 + i0) = (u32x2){pk2(kkt.x, kkt.y), pk2(kkt.z, kkt.w)};
                bf16_t* ktc = KTp + i0 * 40 + tk; ktc[0] = (bf16_t)kp.x; ktc[40] = (bf16_t)(kp.x >> 16); ktc[80] = (bf16_t)kp.y; ktc[120] = (bf16_t)(kp.y >> 16);
                bf16_t* btc = BTp + i0 * 40 + tk; btc[0] = (bf16_t)bp.x; btc[40] = (bf16_t)(bp.x >> 16); btc[80] = (bf16_t)bp.y; btc[120] = (bf16_t)(bp.y >> 16);
            }
            if (fr == 0) *(f32x4*)(PCV + i0) = (f32x4){__expf(run.x), __expf(run.y), __expf(run.z), __expf(run.w)};
        };
        auto ycomp1 = [&](int cc, int lane, int mt) {
            const bf16_t* RBp = (const bf16_t*)(lds + OFF_B + (cc % 3) * B_BYTES); const bf16_t* KBp = RBp + CH * 72; const bf16_t* BBp = KBp + CH * 72; const bf16_t* VTp = BBp + CH * 72;
            const bf16_t* SAF = (const bf16_t*)(lds + OFF_C + (cc & 1) * C_BYTES); const bf16_t* S0B = (const bf16_t*)(lds + OFF_C + (cc & 1) * C_BYTES + 64 * 80);
            const int fr = lane & 15, q = lane >> 4;
            const bf16x8 r0 = *(const bf16x8*)(RBp + (16 * mt + fr) * 72 + 8 * q), r1 = *(const bf16x8*)(RBp + (16 * mt + fr) * 72 + 32 + 8 * q);
            const f32x4 z4 = {0.f, 0.f, 0.f, 0.f};
            f32x4 gk0, gb0, gk1 = z4, gb1 = z4;
            { const bf16x8 k0 = *(const bf16x8*)(KBp + fr * 72 + 8 * q), k1 = *(const bf16x8*)(KBp + fr * 72 + 32 + 8 * q), b0 = *(const bf16x8*)(BBp + fr * 72 + 8 * q), b1 = *(const bf16x8*)(BBp + fr * 72 + 32 + 8 * q);
              gk0 = __builtin_amdgcn_mfma_f32_16x16x32_bf16(k0, r0, z4, 0, 0, 0); gk0 = __builtin_amdgcn_mfma_f32_16x16x32_bf16(k1, r1, gk0, 0, 0, 0);
              gb0 = __builtin_amdgcn_mfma_f32_16x16x32_bf16(b0, r0, z4, 0, 0, 0); gb0 = __builtin_amdgcn_mfma_f32_16x16x32_bf16(b1, r1, gb0, 0, 0, 0); }
            if (mt == 1) {
              const bf16x8 k0 = *(const bf16x8*)(KBp + (16 + fr) * 72 + 8 * q), k1 = *(const bf16x8*)(KBp + (16 + fr) * 72 + 32 + 8 * q), b0 = *(const bf16x8*)(BBp + (16 + fr) * 72 + 8 * q), b1 = *(const bf16x8*)(BBp + (16 + fr) * 72 + 32 + 8 * q);
              gk1 = __builtin_amdgcn_mfma_f32_16x16x32_bf16(k0, r0, z4, 0, 0, 0); gk1 = __builtin_amdgcn_mfma_f32_16x16x32_bf16(k1, r1, gk1, 0, 0, 0);
              gb1 = __builtin_amdgcn_mfma_f32_16x16x32_bf16(b0, r0, z4, 0, 0, 0); gb1 = __builtin_amdgcn_mfma_f32_16x16x32_bf16(b1, r1, gb1, 0, 0, 0);
#pragma unroll
              for (int r = 0; r < 4; ++r) { const bool keep = 4 * q + r <= fr; gk1[r] = keep ? gk1[r] : 0.f; gb1[r] = keep ? gb1[r] : 0.f; }
            } else {
#pragma unroll
              for (int r = 0; r < 4; ++r) { const bool keep = 4 * q + r <= fr; gk0[r] = keep ? gk0[r] : 0.f; gb0[r] = keep ? gb0[r] : 0.f; }
            }
            const u32x4 gkp = {pk2(gk0[0], gk0[1]), pk2(gk0[2], gk0[3]), pk2(gk1[0], gk1[1]), pk2(gk1[2], gk1[3])};
            const u32x4 gbp = {pk2(-gb0[0], -gb0[1]), pk2(-gb0[2], -gb0[3]), pk2(-gb1[0], -gb1[1]), pk2(-gb1[2], -gb1[3])};
            bf16_t* yrow = Yd + tok_row(cc, 16 * mt + fr) * RWD + h * 64 + 4 * q;
#pragma unroll
            for (int nt = 0; nt < 4; ++nt) { const int ri = 16 * nt + fr;
                const u32x2 v0 = *(const u32x2*)(VTp + ri * 40 + 4 * q), v1 = *(const u32x2*)(VTp + ri * 40 + 16 + 4 * q);
                const u32x2 s0 = *(const u32x2*)(SAF + ri * 40 + 4 * q), s1 = *(const u32x2*)(SAF + ri * 40 + 16 + 4 * q);
                const u32x4 vtp = {v0.x, v0.y, v1.x, v1.y}, sap = {s0.x, s0.y, s1.x, s1.y};
                const bf16x8 z0 = *(const bf16x8*)(S0B + ri * 72 + 8 * q), z1 = *(const bf16x8*)(S0B + ri * 72 + 32 + 8 * q);
                f32x4 y = __builtin_amdgcn_mfma_f32_16x16x32_bf16(__builtin_bit_cast(bf16x8, vtp), __builtin_bit_cast(bf16x8, gkp), z4, 0, 0, 0);
                y = __builtin_amdgcn_mfma_f32_16x16x32_bf16(__builtin_bit_cast(bf16x8, sap), __builtin_bit_cast(bf16x8, gbp), y, 0, 0, 0);
                y = __builtin_amdgcn_mfma_f32_16x16x32_bf16(z0, r0, y, 0, 0, 0); y = __builtin_amdgcn_mfma_f32_16x16x32_bf16(z1, r1, y, 0, 0, 0);
                *(u32x2*)(yrow + 16 * nt) = (u32x2){pk2(y[0], y[1]), pk2(y[2], y[3])}; }
        };
        auto ycomp = [&](int cc, int lane) { ycomp1(cc, lane, 0); ycomp1(cc, lane, 1); };
        f32x4 ST[4][2];
#pragma unroll
        for (int u = 0; u < 4; ++u) { ST[u][0] = (f32x4){0.f, 0.f, 0.f, 0.f}; ST[u][1] = (f32x4){0.f, 0.f, 0.f, 0.f}; }
        __syncthreads();
        if (w == 3) {
#pragma unroll 1
            for (int cc = 0; cc < 2; ++cc) { int tidp = tid0; asm volatile("" : "+v"(tidp)); RawL rl; ld_issue(cc, tidp & 63, rl); ld_commit(cc, tidp & 63, rl); } }
        __syncthreads();
        if (w >= 4) prep(0, tid0 & 63, w - 4);
        __syncthreads();
        if (w == 3) {
            for (int c = 0; c < NCH; c += 2) {
                int tid = tid0; asm volatile("" : "+v"(tid));
                const int lane = tid & 63, wit = item + 128 * (c >> 1); const bool hw = true;
                float wv[64];
                { RawL ra; ld_issue(c + 2 < NCH ? c + 2 : NCH - 1, lane, ra); if (hw) wt_issue(wit, lane, wv); ld_commit(c + 2, lane, ra); }
                __syncthreads();
                { RawL rb; ld_issue(c + 3 < NCH ? c + 3 : NCH - 1, lane, rb); if (hw) wt_finish(wit, lane, wv); ld_commit(c + 3, lane, rb); }
                __syncthreads();
            }
        } else
        for (int c = 0; c < NCH; ++c) {
            int tid = tid0; asm volatile("" : "+v"(tid));
            const int lane = tid & 63;
            if (w < 2) {
                const int rb = w;
                const float* PCV = (const float*)(lds + (c & 1) * A_BYTES);
                const bf16_t* RBp = (const bf16_t*)(lds + OFF_B + (c % 3) * B_BYTES); const bf16_t* KBp = RBp + CH * 72; const bf16_t* BBp = KBp + CH * 72; const bf16_t* VTp = BBp + CH * 72; const bf16_t* KKp = (const bf16_t*)(lds + OFF_E + (c & 1) * E_BYTES); const bf16_t* KTp = KKp + CH * 72; const bf16_t* BTp = KTp + 64 * 40;
                bf16_t* SAF = (bf16_t*)(lds + OFF_C + (c & 1) * C_BYTES); bf16_t* S0B = (bf16_t*)(lds + OFF_C + (c & 1) * C_BYTES + 64 * 80);
                const int fr = lane & 15, q = lane >> 4;
                const f32x4 z4 = {0.f, 0.f, 0.f, 0.f};
                auto mf = [](bf16x8 a_, bf16x8 b_, f32x4 c_) -> f32x4 { return __builtin_amdgcn_mfma_f32_16x16x32_bf16(a_, b_, c_, 0, 0, 0); };
                auto opA = [](f32x4 x) -> bf16x8 { const u32x4 v = {pk2(x[0], x[1]), pk2(x[2], x[3]), 0u, 0u}; return __builtin_bit_cast(bf16x8, v); };
                auto opN = [](f32x4 x) -> bf16x8 { const u32x4 v = {pk2(-x[0], -x[1]), pk2(-x[2], -x[3]), 0u, 0u}; return __builtin_bit_cast(bf16x8, v); };
                typedef short bf16x4_ __attribute__((ext_vector_type(4)));
                auto m16 = [](bf16x4_ a_, bf16x4_ b_, f32x4 c_) -> f32x4 { return __builtin_amdgcn_mfma_f32_16x16x16bf16_1k(a_, b_, c_, 0, 0, 0); };
                auto o4 = [](f32x4 x) -> bf16x4_ { const u32x2 v = {pk2(x[0], x[1]), pk2(x[2], x[3])}; return __builtin_bit_cast(bf16x4_, v); };
                auto o4n = [](f32x4 x) -> bf16x4_ { const u32x2 v = {pk2(-x[0], -x[1]), pk2(-x[2], -x[3])}; return __builtin_bit_cast(bf16x4_, v); };
                auto op2 = [](f32x4 lo, f32x4 hi) -> bf16x8 { const u32x4 v = {pk2(lo[0], lo[1]), pk2(lo[2], lo[3]), pk2(hi[0], hi[1]), pk2(hi[2], hi[3])}; return __builtin_bit_cast(bf16x8, v); };
                auto op2n = [](f32x4 lo, f32x4 hi) -> bf16x8 { const u32x4 v = {pk2(-lo[0], -lo[1]), pk2(-lo[2], -lo[3]), pk2(-hi[0], -hi[1]), pk2(-hi[2], -hi[3])}; return __builtin_bit_cast(bf16x8, v); };
                auto rf = [&](const bf16_t* X, int stride, int r0, int k0) -> bf16x8 { return *(const bf16x8*)(X + (r0 + fr) * stride + k0 + 8 * q); };
                auto pf = [&](const bf16_t* X, int stride, int r0, int k0) -> bf16x8 { const u32x2 a_ = *(const u32x2*)(X + (r0 + fr) * stride + k0 + 4 * q), b_ = *(const u32x2*)(X + (r0 + fr) * stride + k0 + 16 + 4 * q);
                    const u32x4 v = {a_.x, a_.y, b_.x, b_.y}; return __builtin_bit_cast(bf16x8, v); };
                bf16x8 kkf[2][2], bbf[2][2], kf[2][2];
#pragma unroll
                for (int a_ = 0; a_ < 2; ++a_)
#pragma unroll
                    for (int ks = 0; ks < 2; ++ks) { kkf[a_][ks] = rf(KKp, 72, 16 * a_, 32 * ks); bbf[a_][ks] = rf(BBp, 72, 16 * a_, 32 * ks); kf[a_][ks] = rf(KBp, 72, 16 * a_, 32 * ks); }
                auto gram = [&](const bf16x8 (&P)[2], const bf16x8 (&Q)[2]) -> f32x4 { return mf(P[1], Q[1], mf(P[0], Q[0], z4)); };
                bool lo_[4], up_[4], dg_[4];
#pragma unroll
                for (int r = 0; r < 4; ++r) { lo_[r] = fr < 4 * q + r; up_[r] = 4 * q + r < fr; dg_[r] = 4 * q + r == fr; }
                f32x4 TT[2];
#pragma unroll
                for (int bl = 0; bl < 2; ++bl) {
                    f32x4 N = gram(kkf[bl], bbf[bl]), NT = gram(bbf[bl], kkf[bl]), PT;
#pragma unroll
                    for (int r = 0; r < 4; ++r) { N[r] = lo_[r] ? -N[r] : 0.f; NT[r] = up_[r] ? -NT[r] : 0.f; PT[r] = NT[r] + (dg_[r] ? 1.f : 0.f); }
                    const f32x4 N2 = m16(o4(NT), o4(N), z4), N2T = m16(o4(N), o4(NT), z4); PT = m16(o4(N2), o4(PT), PT);
                    const f32x4 N4 = m16(o4(N2T), o4(N2), z4), N4T = m16(o4(N2), o4(N2T), z4); PT = m16(o4(N4), o4(PT), PT);
                    const f32x4 N8 = m16(o4(N4T), o4(N4), z4); PT = m16(o4(N8), o4(PT), PT);
                    TT[bl] = PT; }
                const f32x4 L21T = gram(bbf[0], kkf[1]);
                f32x4 AkT00 = gram(kf[0], kkf[0]), AkT10 = gram(kf[0], kkf[1]), AkT11 = gram(kf[1], kkf[1]);
#pragma unroll
                for (int r = 0; r < 4; ++r) { AkT00[r] = up_[r] ? AkT00[r] : 0.f; AkT11[r] = up_[r] ? AkT11[r] : 0.f; }
                f32x4 RH[2][2];
                { const bf16x8 a0op = opA(AkT00), a1op = op2(AkT10, AkT11);
#pragma unroll
                  for (int cI = 0; cI < 2; ++cI) { const bf16x8 vp_ = pf(VTp, 40, 32 * rb + 16 * cI, 0); RH[0][cI] = mf(a0op, vp_, z4); RH[1][cI] = mf(a1op, vp_, z4); } }
                bf16x8 sop[2][2];
#pragma unroll
                for (int ks = 0; ks < 2; ++ks)
#pragma unroll
                    for (int cI = 0; cI < 2; ++cI) { sop[ks][cI] = op2(ST[2 * ks][cI], ST[2 * ks + 1][cI]); const u32x4 sv = __builtin_bit_cast(u32x4, sop[ks][cI]);
                        *(u32x2*)(S0B + (32 * rb + 16 * cI + fr) * 72 + 32 * ks + 4 * q) = (u32x2){sv.x, sv.y}; *(u32x2*)(S0B + (32 * rb + 16 * cI + fr) * 72 + 32 * ks + 16 + 4 * q) = (u32x2){sv.z, sv.w}; }
#pragma unroll
                for (int a_ = 0; a_ < 2; ++a_)
#pragma unroll
                    for (int ks = 0; ks < 2; ++ks) { const bf16x8 kp_ = pf(KKp, 72, 16 * a_, 32 * ks); RH[a_][0] = mf(kp_, sop[ks][0], RH[a_][0]); RH[a_][1] = mf(kp_, sop[ks][1], RH[a_][1]); }
                bf16x8 nsa[2];
                { const bf16x4_ t0op = o4(TT[0]), t1op = o4(TT[1]), l21n = o4n(L21T);
#pragma unroll
                  for (int cI = 0; cI < 2; ++cI) { const f32x4 sa0 = m16(t0op, o4(RH[0][cI]), z4); const f32x4 r2 = m16(l21n, o4(sa0), RH[1][cI]); const f32x4 sa1 = m16(t1op, o4(r2), z4);
                      *(u32x2*)(SAF + (32 * rb + 16 * cI + fr) * 40 + 4 * q) = (u32x2){pk2(sa0[0], sa0[1]), pk2(sa0[2], sa0[3])}; *(u32x2*)(SAF + (32 * rb + 16 * cI + fr) * 40 + 16 + 4 * q) = (u32x2){pk2(sa1[0], sa1[1]), pk2(sa1[2], sa1[3])}; nsa[cI] = op2n(sa0, sa1); } }
                { const bf16x8 vr0 = rf(VTp, 40, 32 * rb, 0), vr1 = rf(VTp, 40, 32 * rb + 16, 0);
#pragma unroll
                  for (int u = 0; u < 4; ++u) { const bf16x8 kt_ = rf(KTp, 40, 16 * u, 0), bt_ = pf(BTp, 40, 16 * u, 0); const f32x4 pc = *(const f32x4*)(PCV + 16 * u + 4 * q);
                      ST[u][0] = mf(bt_, nsa[0], mf(kt_, vr0, ST[u][0])) * pc; ST[u][1] = mf(bt_, nsa[1], mf(kt_, vr1, ST[u][1])) * pc; } }
            } else if (w == 2) {
                if (c - 1 >= NCX) ycomp(c - 1, lane);
            } else {
                if (c + 1 < NCH) prep(c + 1, lane, w - 4);
            }
            __syncthreads();
        }
        if (w == 2) ycomp(NCH - 1, tid0 & 63);
    }
}
__device__ __forceinline__ void phase_rwkv_final(const bf16_t* __restrict__ RW, const bf16_t* __restrict__ Y0, const bf16_t* __restrict__ Y1, const float* __restrict__ a0, const bf16_t* __restrict__ A2T,
                                                 const bf16_t* __restrict__ G2T, const float* __restrict__ k_a, const float* __restrict__ r_k, const float* __restrict__ lnx_g, const float* __restrict__ lnx_b, bf16_t* __restrict__ O, unsigned char* lds, int bid, int nb) {
    const int tid = otid(), lane = tid & 63, h = __builtin_amdgcn_readfirstlane(tid >> 6), fr = lane & 15, fq = lane >> 4;
    bf16_t* const IM = (bf16_t*)(lds + h * 11520);
    const int lr = lane >> 3, lc = lane & 7;
    for (int tile = bid; tile < NLAT / 64; tile += nb) {
#pragma unroll 1
        for (int mt = 0; mt < 4; ++mt) {
            const size_t rowb = (size_t)tile * 64 + 16 * mt;
            asm volatile("s_waitcnt lgkmcnt(0)" ::: "memory");
#pragma unroll
            for (int g = 0; g < 2; ++g) { const size_t row = rowb + 8 * g + lr; const bf16_t* p0 = RW + row * RW_COLS + h * 64 + 8 * lc; const int lo = (8 * g + lr) * 72 + 8 * lc;
                const u32x4 vr = *(const u32x4*)(p0), vk = *(const u32x4*)(p0 + 512), vv = *(const u32x4*)(p0 + 1024), v0 = *(const u32x4*)(Y0 + row * RWD + h * 64 + 8 * lc), v1 = *(const u32x4*)(Y1 + row * RWD + h * 64 + 8 * lc);
                *(u32x4*)(IM + lo) = vr; *(u32x4*)(IM + 1152 + lo) = vk; *(u32x4*)(IM + 2304 + lo) = vv; *(u32x4*)(IM + 3456 + lo) = v0; *(u32x4*)(IM + 4608 + lo) = v1; }
            const bf16_t* pa = RW + (rowb + fr) * RW_COLS;
            bf16x8 fa[2], fg[4];
#pragma unroll
            for (int ks = 0; ks < 2; ++ks) fa[ks] = *(const bf16x8*)(pa + 1600 + ks * 32 + fq * 8);
#pragma unroll
            for (int ks = 0; ks < 4; ++ks) fg[ks] = *(const bf16x8*)(pa + 1664 + ks * 32 + fq * 8);
            asm volatile("s_waitcnt vmcnt(0) lgkmcnt(0)" ::: "memory");
            float bsum = 0.f, ysum = 0.f, ysq = 0.f; f32x4 yv[4];
#pragma unroll
            for (int nt = 0; nt < 4; ++nt) {
                const int c0 = h * 64 + 16 * nt + 4 * fq, lo = fr * 72 + 16 * nt + 4 * fq; f32x4 aa0 = {0.f, 0.f, 0.f, 0.f}, aa1 = {0.f, 0.f, 0.f, 0.f};
#pragma unroll
                for (int ks = 0; ks < 2; ++ks) { const bf16x8 b0 = *(const bf16x8*)(A2T + ((size_t)(h * 64 + 16 * nt + fr)) * 64 + ks * 32 + fq * 8), b1 = *(const bf16x8*)(A2T + ((size_t)(512 + h * 64 + 16 * nt + fr)) * 64 + ks * 32 + fq * 8);
                    aa0 = __builtin_amdgcn_mfma_f32_16x16x32_bf16(b0, fa[ks], aa0, 0, 0, 0); aa1 = __builtin_amdgcn_mfma_f32_16x16x32_bf16(b1, fa[ks], aa1, 0, 0, 0); }
                const f32x4 r = ld_bf16x4(IM + lo), k = ld_bf16x4(IM + 1152 + lo); yv[nt] = ld_bf16x4(IM + 3456 + lo) + ld_bf16x4(IM + 4608 + lo);
                const f32x4 a00 = *(const f32x4*)(a0 + c0), a01 = *(const f32x4*)(a0 + 512 + c0), ka = *(const f32x4*)(k_a + c0), rk = *(const f32x4*)(r_k + c0);
#pragma unroll
                for (int j = 0; j < 4; ++j) { const float av0 = fsigmoid(aa0[j] + a00[j]), av1 = fsigmoid(aa1[j] + a01[j]); const float ksum = k[j] * (2.f + (av0 + av1 - 2.f) * ka[j]); bsum += r[j] * ksum * rk[j]; ysum += yv[nt][j]; ysq += yv[nt][j] * yv[nt][j]; }
                asm volatile("" ::: "memory");
            }
            bsum += __shfl_xor(bsum, 16); bsum += __shfl_xor(bsum, 32); ysum += __shfl_xor(ysum, 16); ysum += __shfl_xor(ysum, 32); ysq += __shfl_xor(ysq, 16); ysq += __shfl_xor(ysq, 32);
            const float mean = ysum * (1.f / 64.f); const float var = fmaxf(ysq * (1.f / 64.f) - mean * mean, 0.f); const float rstd = rsqrtf(var + LNX_EPS);
#pragma unroll
            for (int nt = 0; nt < 4; ++nt) {
                const int c0 = h * 64 + 16 * nt + 4 * fq, lo = fr * 72 + 16 * nt + 4 * fq; f32x4 gg = {0.f, 0.f, 0.f, 0.f};
#pragma unroll
                for (int ks = 0; ks < 4; ++ks) { const bf16x8 bg = *(const bf16x8*)(G2T + ((size_t)(h * 64 + 16 * nt + fr)) * 128 + ks * 32 + fq * 8); gg = __builtin_amdgcn_mfma_f32_16x16x32_bf16(bg, fg[ks], gg, 0, 0, 0); }
                const f32x4 v = ld_bf16x4(IM + 2304 + lo); const f32x4 lg = *(const f32x4*)(lnx_g + c0), lb = *(const f32x4*)(lnx_b + c0); f32x4 o;
#pragma unroll
                for (int j = 0; j < 4; ++j) o[j] = ((yv[nt][j] - mean) * rstd * lg[j] + lb[j] + bsum * v[j]) * gg[j];
                st_bf16x4(IM + lo, o);
                asm volatile("" ::: "memory");
            }
            asm volatile("s_waitcnt lgkmcnt(0)" ::: "memory");
#pragma unroll
            for (int g = 0; g < 2; ++g) { const size_t row = rowb + 8 * g + lr; *(u32x4*)(O + row * RWD + h * 64 + 8 * lc) = *(const u32x4*)(IM + (8 * g + lr) * 72 + 8 * lc); }
        }
    }
}
__device__ __forceinline__ void phase_lru_final(const bf16_t* __restrict__ H0, const bf16_t* __restrict__ H1, const bf16_t* __restrict__ GB, bf16_t* __restrict__ HL, int bid, int nb) {
    const size_t n8 = (size_t)NLAT * LWD / 8, stride = (size_t)nb * 512;
    for (size_t i = (size_t)bid * 512 + otid(); i < n8; i += 4 * stride) { u32x4 a[4], c[4], g[4];
#pragma unroll
        for (int q = 0; q < 4; ++q) { const size_t k = i + q * stride; if (k < n8) { a[q] = ((const u32x4*)H0)[k]; c[q] = ((const u32x4*)H1)[k]; g[q] = ((const u32x4*)GB)[k]; } }
#pragma unroll
        for (int q = 0; q < 4; ++q) { const size_t k = i + q * stride; if (k < n8) { float fa[8], fc[8], fg[8]; unpack8(a[q], fa); unpack8(c[q], fc); unpack8(g[q], fg); u32x4 o;
            o.x = pk2((fa[0] + fc[0]) * fg[0], (fa[1] + fc[1]) * fg[1]); o.y = pk2((fa[2] + fc[2]) * fg[2], (fa[3] + fc[3]) * fg[3]); o.z = pk2((fa[4] + fc[4]) * fg[4], (fa[5] + fc[5]) * fg[5]); o.w = pk2((fa[6] + fc[6]) * fg[6], (fa[7] + fc[7]) * fg[7]);
            ((u32x4*)HL)[k] = o; } }
    }
}
template <int CTRL> __device__ __forceinline__ float dpp_max(float x) { return fmaxf(x, __builtin_bit_cast(float, __builtin_amdgcn_update_dpp(0, __builtin_bit_cast(int, x), CTRL, 0xF, 0xF, true))); }
__device__ __forceinline__ float max16(float x) { x = dpp_max<0xB1>(x); x = dpp_max<0x4E>(x); x = dpp_max<0x141>(x); x = dpp_max<0x140>(x); return x; }
__device__ __forceinline__ void phase_router(const float* __restrict__ XMID, const float* __restrict__ g2n, const float* __restrict__ MOD, const float* __restrict__ router, float* __restrict__ AFF, const float* __restrict__ SSQ, bf16_t* __restrict__ H2, int bid, int nb) {
    const int tid = otid(), lane = tid & 63, w = tid >> 6, e = lane & 15, q = lane >> 4;
    for (int tile = bid * 8 + w; tile < NLAT / 16; tile += nb * 8) {
        const int row0 = tile * 16, b = row0 / T;
        float rstd; { const f32x4* sp_ = (const f32x4*)(SSQ + (size_t)(row0 + e) * 16); const f32x4 s0 = sp_[0], s1 = sp_[1], s2 = sp_[2], s3 = sp_[3];
            const float ssq = (((s0.x + s0.y) + (s0.z + s0.w)) + ((s1.x + s1.y) + (s1.z + s1.w))) + (((s2.x + s2.y) + (s2.z + s2.w)) + ((s3.x + s3.y) + (s3.z + s3.w))); rstd = rsqrtf(ssq * (1.f / D) + RMS_EPS); }
        const float* xr = XMID + (size_t)(row0 + e) * D + 4 * q; const float* gp = g2n + 4 * q; const float* scp = MOD + (size_t)b * 6144 + 4096 + 4 * q; const float* shp = MOD + (size_t)b * 6144 + 3072 + 4 * q; const float* rp = router + (4 * q) * 16 + e;
        bf16_t* hp = H2 + (size_t)(row0 + e) * D + 4 * q;
        f32x4 acc = {0.f, 0.f, 0.f, 0.f};
#pragma unroll 1
        for (int kc = 0; kc < D; kc += 256) {
            f32x4 xq[16];
#pragma unroll
            for (int u = 0; u < 16; ++u) xq[u] = *(const f32x4*)(xr + kc + 16 * u);
#pragma unroll
            for (int u = 0; u < 16; ++u) { const int kb = kc + 16 * u;
                const f32x4 gv = *(const f32x4*)(gp + kb), sv = *(const f32x4*)(scp + kb), hv = *(const f32x4*)(shp + kb);
                const f32x4 av = (xq[u] * rstd * gv) * (sv + 1.f) + hv;
                u32x2 o; o.x = pk2(av.x, av.y); o.y = pk2(av.z, av.w); *(u32x2*)(hp + kb) = o;
#pragma unroll
                for (int c = 0; c < 4; ++c) acc = __builtin_amdgcn_mfma_f32_16x16x4f32(av[c], rp[(kb + c) * 16], acc, 0, 0, 0); }
        }
#pragma unroll
        for (int r = 0; r < 4; ++r) { const int tok = 4 * q + r; const float lg = acc[r];
            const float mx = max16(lg); const float ex = __expf(lg - mx); const float sm = red16(ex);
            AFF[((size_t)b * NE + e) * T + (row0 & (T - 1)) + tok] = ex / sm; }
    }
}
__device__ __forceinline__ void phase_topk(const float* __restrict__ AFF, int* __restrict__ IDX, float* __restrict__ GATE, int* __restrict__ SLOT, unsigned char* lds, int bid, int nb) {
    unsigned* hist = (unsigned*)lds;
    unsigned* sel = (unsigned*)(lds + 1024);
    unsigned* wsum = (unsigned*)(lds + 1040);
    const int tid = otid(), lane = tid & 63, w = tid >> 6;
    for (int be = bid; be < NB * NE; be += nb) {
        const int b = be >> 4, e = be & 15;
        unsigned key[8];
        { const u32x4* src = (const u32x4*)(AFF + (size_t)be * T + tid * 8); const u32x4 v0 = src[0], v1 = src[1]; key[0] = v0.x; key[1] = v0.y; key[2] = v0.z; key[3] = v0.w; key[4] = v1.x; key[5] = v1.y; key[6] = v1.z; key[7] = v1.w; }
        unsigned prefix = 0u, kk = CAP;
#pragma unroll 1
        for (int pass = 0; pass < 4; ++pass) {
            const int shift = 24 - 8 * pass; const unsigned himask = pass == 0 ? 0u : (0xffffffffu << (shift + 8));
            __syncthreads();
            if (tid < 256) hist[tid] = 0u;
            __syncthreads();
#pragma unroll
            for (int q = 0; q < 8; ++q) if ((key[q] & himask) == prefix) atomicAdd(&hist[(key[q] >> shift) & 255u], 1u);
            __syncthreads();
            if (w == 0) {
                unsigned c[4]; unsigned tot = 0u;
#pragma unroll
                for (int j = 0; j < 4; ++j) { c[j] = hist[255 - 4 * lane - j]; tot += c[j]; }
                unsigned inc = tot;
#pragma unroll
                for (int o = 1; o < 64; o <<= 1) { const unsigned t = __shfl_up(inc, o); if (lane >= o) inc += t; }
                unsigned before = inc - tot;
#pragma unroll
                for (int j = 0; j < 4; ++j) { if (before < kk && kk <= before + c[j]) { sel[0] = (unsigned)(255 - 4 * lane - j); sel[1] = kk - before; } before += c[j]; }
            }
            __syncthreads();
            prefix |= sel[0] << shift; kk = sel[1];
        }
        unsigned ngt = 0u, neq = 0u;
#pragma unroll
        for (int q = 0; q < 8; ++q) { ngt += key[q] > prefix ? 1u : 0u; neq += key[q] == prefix ? 1u : 0u; }
        unsigned pk = (ngt << 16) | neq, inc = pk;
#pragma unroll
        for (int o = 1; o < 64; o <<= 1) { const unsigned t = __shfl_up(inc, o); if (lane >= o) inc += t; }
        __syncthreads();
        if (lane == 63) wsum[w] = inc;
        __syncthreads();
        unsigned base = 0u;
#pragma unroll
        for (int ww = 0; ww < 8; ++ww) if (ww < w) base += wsum[ww];
        unsigned ex = base + inc - pk; unsigned gt_before = ex >> 16, eq_before = ex & 0xffffu;
#pragma unroll
        for (int q = 0; q < 8; ++q) { const int i = tid * 8 + q; const bool isgt = key[q] > prefix, iseq = key[q] == prefix; const bool take = isgt || (iseq && eq_before < kk);
            const unsigned slot = gt_before + (eq_before < kk ? eq_before : kk);
            if (take) { IDX[(size_t)be * CAP + slot] = i; GATE[(size_t)be * CAP + slot] = __builtin_bit_cast(float, key[q]); }
            SLOT[((size_t)b * T + i) * NE + e] = take ? (int)slot : -1;
            gt_before += isgt ? 1u : 0u; eq_before += iseq ? 1u : 0u; }
    }
}
__device__ __forceinline__ void phase_final(const float* __restrict__ XMID, const bf16_t* __restrict__ YE, const int* __restrict__ SLOT, const float* __restrict__ MOD, const float* __restrict__ fg, float* __restrict__ out, int bid, int nb) {
    const int tid = otid(), lane = tid & 63, p = lane & 15, gq = bid * 32 + (tid >> 4), NGQ = nb * 32;
    for (int r = gq; r < NLAT; r += NGQ) {
        const int b = r / T; const float* mr = MOD + (size_t)b * 6144 + 5120;
        const int4 s0 = *(const int4*)(SLOT + (size_t)r * NE), s1 = *(const int4*)(SLOT + (size_t)r * NE + 4), s2 = *(const int4*)(SLOT + (size_t)r * NE + 8), s3 = *(const int4*)(SLOT + (size_t)r * NE + 12);
        const int sl[16] = {s0.x, s0.y, s0.z, s0.w, s1.x, s1.y, s1.z, s1.w, s2.x, s2.y, s2.z, s2.w, s3.x, s3.y, s3.z, s3.w};
        f32x4 acc[16];
#pragma unroll
        for (int j = 0; j < 16; ++j) acc[j] = (f32x4){0.f, 0.f, 0.f, 0.f};
#pragma unroll
        for (int e = 0; e < NE; ++e) if (sl[e] >= 0) { const u32x4* yr = (const u32x4*)(YE + ((size_t)(b * NE + e) * CAP + sl[e]) * D) + p;
#pragma unroll
            for (int j = 0; j < 8; ++j) { const u32x4 v = yr[16 * j];
                acc[2 * j] += (f32x4){__builtin_bit_cast(float, v.x << 16), __builtin_bit_cast(float, v.x & 0xffff0000u), __builtin_bit_cast(float, v.y << 16), __builtin_bit_cast(float, v.y & 0xffff0000u)};
                acc[2 * j + 1] += (f32x4){__builtin_bit_cast(float, v.z << 16), __builtin_bit_cast(float, v.z & 0xffff0000u), __builtin_bit_cast(float, v.w << 16), __builtin_bit_cast(float, v.w & 0xffff0000u)}; } }
        float s = 0.f;
#pragma unroll
        for (int j = 0; j < 16; ++j) { const int f4 = 2 * (p + 16 * (j >> 1)) + (j & 1);
            acc[j] = ((const f32x4*)(XMID + (size_t)r * D))[f4] + ((const f32x4*)mr)[f4] * acc[j]; s += (acc[j].x * acc[j].x + acc[j].y * acc[j].y) + (acc[j].z * acc[j].z + acc[j].w * acc[j].w); }
        const float rstd = rsqrtf(red16(s) * (1.f / D) + RMS_EPS);
#pragma unroll
        for (int j = 0; j < 16; ++j) { const int f4 = 2 * (p + 16 * (j >> 1)) + (j & 1); ((f32x4*)(out + (size_t)r * D))[f4] = acc[j] * rstd * ((const f32x4*)fg)[f4]; }
    }
}

__device__ __forceinline__ void phase_wconv_moe_rest(const float* __restrict__ mw1, const float* __restrict__ mw3, const float* __restrict__ mw2, bf16_t* __restrict__ W13, bf16_t* __restrict__ W2, int t0, unsigned char* lds, int bid, int nb) {
    const int tid = otid(), lane = tid & 63, wv = tid >> 6, gw = bid * 8 + wv, NGW = nb * 8;
    u32x4* wl = (u32x4*)(lds + wv * 9216);
    for (int it = t0 + gw; it < 12288; it += NGW) {
        const int m = it >> 12, r = it & 4095, e = r >> 8, tt = r & 255, k0 = (tt >> 4) * 64, n0 = (tt & 15) * 64, rmul = m == 2 ? 4 : 8, radd = m == 1 ? 4 : 0;
        const float* src = (m == 0 ? mw1 : m == 1 ? mw3 : mw2) + (size_t)e * 1024 * 1024; bf16_t* dst = m == 2 ? W2 + (size_t)e * 1024 * 1024 : W13 + (size_t)e * 2048 * 1024;
        const float* sp = src + (size_t)k0 * 1024 + n0 + lane; float v[64];
#pragma unroll
        for (int i = 0; i < 64; ++i) v[i] = sp[(size_t)i * 1024];
#pragma unroll
        for (int c = 0; c < 8; ++c) { u32x4 o; o.x = pk2(v[8 * c], v[8 * c + 1]); o.y = pk2(v[8 * c + 2], v[8 * c + 3]); o.z = pk2(v[8 * c + 4], v[8 * c + 5]); o.w = pk2(v[8 * c + 6], v[8 * c + 7]); wl[lane * 9 + c] = o; }
        asm volatile("s_waitcnt lgkmcnt(0)" ::: "memory");
#pragma unroll
        for (int j = 0; j < 8; ++j) { const int n = (lane >> 3) + 8 * j, c = lane & 7; const u32x4 o = wl[n * 9 + c];
            const int nn = n0 + n, row = (nn >> 2) * rmul + (nn & 3) + radd; *(u32x4*)(dst + (size_t)row * 1024 + k0 + 8 * c) = o; }
        asm volatile("s_waitcnt lgkmcnt(0)" ::: "memory");
    }
}
constexpr int RING_BYTES = 131072, LDS_BYTES = 163840, MISC_OFF = LDS_BYTES - 256;
constexpr int CW_BAR = 4096;
constexpr size_t CTL_ZERO_BYTES = 65536;
__global__ __launch_bounds__(512, 2) void mega(Args a) {
    extern __shared__ __attribute__((aligned(16))) unsigned char lds[];
    const int bid = blockIdx.x, nb = gridDim.x, tid = threadIdx.x;
    unsigned char* ws = a.ws;
    const float* x = a.in[0]; const float* c = a.in[1]; const float* ctx = a.in[2]; const float* c_ctx = a.in[3]; const float* w_mod = a.in[4]; const float* b_mod = a.in[5];
    const float* norm1_g = a.in[6]; const float* norm2_g = a.in[7]; const float* w_in = a.in[8]; const float* mu = a.in[9]; const float* rw0 = a.in[10]; const float* rw2 = a.in[11];
    const float* ra0 = a.in[12]; const float* ra2 = a.in[13]; const float* rg2 = a.in[14]; const float* rkk = a.in[15]; const float* rka = a.in[16]; const float* rrk = a.in[17];
    const float* lnx_g = a.in[18]; const float* lnx_b = a.in[19]; const float* w_pr = a.in[20]; const float* conv_w = a.in[21]; const float* conv_b = a.in[22]; const float* lwa = a.in[23];
    const float* lba = a.in[24]; const float* lwx = a.in[25]; const float* lbx = a.in[26]; const float* llam = a.in[27]; const float* w_pl = a.in[28]; const float* w_out = a.in[29];
    const float* router = a.in[30]; const float* mw1 = a.in[31]; const float* mw3 = a.in[32]; const float* mw2 = a.in[33]; const float* final_g = a.in[34];
    float* MOD = (float*)(ws + WS_MOD); bf16_t* WIN = (bf16_t*)(ws + WS_WIN); bf16_t* WPR = (bf16_t*)(ws + WS_WPR); bf16_t* WPL = (bf16_t*)(ws + WS_WPL); bf16_t* WOUT = (bf16_t*)(ws + WS_WOUT);
    bf16_t* GT = (bf16_t*)(ws + WS_GT); float* XMID = (float*)(ws + WS_XMID); bf16_t* U = (bf16_t*)(ws + WS_U); float* Y = (float*)(ws + WS_Y); bf16_t* RW = (bf16_t*)(ws + WS_RW);
    bf16_t* MG = (bf16_t*)(ws + WS_MERGED); bf16_t* XB = (bf16_t*)(ws + WS_XB); bf16_t* GB = (bf16_t*)(ws + WS_GB); float* H = (float*)(ws + WS_H); bf16_t* O = (bf16_t*)(ws + WS_O); bf16_t* HL = (bf16_t*)(ws + WS_HL);
    bf16_t* W2 = (bf16_t*)a.out; bf16_t* W13 = (bf16_t*)((unsigned char*)a.out + 32 * MiB);
     bf16_t* H2 = (bf16_t*)(ws + WS_H2); bf16_t* HID = (bf16_t*)(ws + WS_HID); bf16_t* YE = (bf16_t*)(ws + WS_YE); bf16_t* XS = (bf16_t*)(ws + WS_XS);
    bf16_t* W2T = (bf16_t*)(ws + WS_W2T); bf16_t* A2T = (bf16_t*)(ws + WS_A2T); bf16_t* WAT = (bf16_t*)(ws + WS_WAT); bf16_t* WXT = (bf16_t*)(ws + WS_WXT); bf16_t* G2T = (bf16_t*)(ws + WS_G2T); bf16_t* H0 = (bf16_t*)(ws + WS_H); bf16_t* H1 = (bf16_t*)(ws + WS_H + 32 * MiB); bf16_t* Y0 = (bf16_t*)(ws + WS_Y); bf16_t* Y1 = (bf16_t*)(ws + WS_Y + 32 * MiB);
    float* AFF = (float*)(ws + TAB_AFF); int* IDX = (int*)(ws + TAB_IDX); float* GATE = (float*)(ws + TAB_GATE); int* SLOT = (int*)(ws + TAB_SLOT); float* KN = (float*)(ws + TAB_RSTD); bf16_t* SIDE = (bf16_t*)(ws + TAB_SIDE); float* SSQ = (float*)(ws + TAB_SSQ);

    for (int u = tid; u < (LDS_BYTES - MISC_OFF) / 4; u += 512) ((LAS unsigned*)(lds + MISC_OFF))[u] = 0u;
    __syncthreads();
    const XcdBarrier bar = xcd_barrier_post((unsigned*)(ws + WS_CTL) + CW_BAR, (volatile LAS unsigned*)(lds + MISC_OFF) + 8);
    PG8_LAS unsigned char* ring = (PG8_LAS unsigned char*)lds;

#define PH(k) for (int rep_ = 0; rep_ < (PROBE == (k) ? 3 : 1); ++rep_)
    PH(0) {
    phase_modvec(c, c_ctx, w_mod, b_mod, MOD, lds, bid, nb);
    phase_wconv(w_in, WIN, 1024, IN_COLS, 4, 0, 1, 0, 0, lds, bid, nb);
    phase_wconv(w_pr, WPR, 512, 1024, 4, 0, 1, 0, 0, lds, bid, nb);
    phase_wconv(w_pl, WPL, 512, 1024, 4, 0, 1, 0, 0, lds, bid, nb);
    phase_wconv(w_out, WOUT, 1024, 1024, 4, 0, 1, 0, 0, lds, bid, nb);
    phase_wconv(rw2, W2T, 64, 512, 4, 0, 2, (size_t)64 * 512, (size_t)512 * 64, lds, bid, nb);
    phase_wconv(ra2, A2T, 64, 512, 4, 0, 2, (size_t)64 * 512, (size_t)512 * 64, lds, bid, nb);
    phase_wconv(lwa, WAT, 64, 64, 4, 0, 16, (size_t)64 * 64, (size_t)64 * 64, lds, bid, nb);
    phase_wconv(lwx, WXT, 64, 64, 4, 0, 16, (size_t)64 * 64, (size_t)64 * 64, lds, bid, nb);
    phase_wconv(rg2, G2T, 128, 512, 4, 0, 1, 0, 0, lds, bid, nb);
    xcd_barrier(bar); }
    PH(1) { phase_normmod(x, ctx, norm1_g, MOD, U, bid, nb); xcd_barrier(bar); }
    PH(2) { SWin S{U, WIN, nb, bid}; EWin E{RW, XB, GB, GT}; pg8::gemm_phase<EWin, SWin, true>(ring, 1024, S, E); xcd_barrier(bar); }
    PH(4) { phase_mixA(RW, SIDE, bid, nb); xcd_barrier(bar); }
    PH(16) { phase_mixB(RW, SIDE, mu, rkk, KN, bid, nb); xcd_barrier(bar); }
    PH(3) { const int hb = nb >> 1;
        if (bid < hb) phase_rwkv_full(RW, KN, Y0, Y1, rw0, W2T, ra0, A2T, rkk, rka, mw1, mw3, mw2, W13, W2, lds, bid, hb);
        else { phase_lru_seq(XB, H0, H1, conv_w, conv_b, WAT, lba, WXT, lbx, llam, lds, bid - hb, nb - hb); __syncthreads(); phase_wconv_moe_rest(mw1, mw3, mw2, W13, W2, 128 * 68, lds, bid - hb, nb - hb); }
        xcd_barrier(bar); }
    PH(5) { phase_rwkv_final(RW, Y0, Y1, ra0, A2T, G2T, rka, rrk, lnx_g, lnx_b, O, lds, bid, nb); if (PROBE == 5) xcd_barrier(bar); }
    PH(14) { phase_lru_final(H0, H1, GB, HL, bid, nb); xcd_barrier(bar); }
    PH(6) { SProj S{O, HL, WPR, WPL, nb, bid}; EProj E{GT, MG}; pg8::gemm_phase<EProj, SProj, true>(ring, 512, S, E); xcd_barrier(bar); }
    PH(7) { SWout S{MG, WOUT, nb, bid}; EWout E{x, MOD, XMID, SSQ}; pg8::gemm_phase<EWout, SWout, true>(ring, 1024, S, E); xcd_barrier(bar); }
    PH(8) {
    if (PROBE == 8) xcd_barrier(bar); }
    PH(15) { phase_router(XMID, norm2_g, MOD, router, AFF, SSQ, H2, bid, nb); xcd_barrier(bar); }
    PH(9) { phase_topk(AFF, IDX, GATE, SLOT, lds, bid, nb); xcd_barrier(bar); }
    PH(11) { SMoe1 S{H2, W13, IDX, nb, bid}; EMoe1 E{HID}; pg8::gemm_phase<EMoe1, SMoe1, true>(ring, 1024, S, E); xcd_barrier(bar); }
    PH(12) { SMoe2 S{HID, W2, nb, bid}; EMoe2 E{GATE, YE}; pg8::gemm_phase<EMoe2, SMoe2, true>(ring, 1024, S, E); xcd_barrier(bar); }
    PH(13) { phase_final(XMID, YE, SLOT, MOD, final_g, a.out, bid, nb); if (PROBE == 13) xcd_barrier(bar); }
#undef PH
}

extern "C" void kernel_launch(void* const* d_in, const int* in_sizes, int n_in, void* d_out, int out_size, void* d_ws, size_t ws_size, hipStream_t stream) {
    static int grid = 0;
    if (grid == 0) {
        if (n_in != 35 || ws_size < WS_END || out_size != NLAT * D) { fprintf(stderr, "kernel_launch: unexpected problem (n_in %d, ws %zu, out %d)\n", n_in, ws_size, out_size); grid = -1; return; }
        int dev = 0, cus = 0;
        if (hipGetDevice(&dev) != hipSuccess || hipDeviceGetAttribute(&cus, hipDeviceAttributeMultiprocessorCount, dev) != hipSuccess || cus <= 0) { fprintf(stderr, "kernel_launch: device query failed\n"); grid = -1; return; }
        if (hipFuncSetAttribute((const void*)mega, hipFuncAttributeMaxDynamicSharedMemorySize, LDS_BYTES) != hipSuccess) { fprintf(stderr, "kernel_launch: hipFuncSetAttribute failed\n"); grid = -1; return; }
        int per_cu = 0;
        if (hipOccupancyMaxActiveBlocksPerMultiprocessor(&per_cu, (const void*)mega, 512, LDS_BYTES) != hipSuccess || per_cu < 1) fprintf(stderr, "kernel_launch: occupancy query reports %d blocks per CU\n", per_cu);
        (void)hipGetLastError();
        grid = cus;
    }
    if (grid < 0) return;
    (void)hipMemsetAsync((char*)d_ws + WS_CTL, 0, CTL_ZERO_BYTES, stream);
    Args a{};
    for (int i = 0; i < 35; ++i) a.in[i] = (const float*)d_in[i];
    a.out = (float*)d_out; a.ws = (unsigned char*)d_ws;
    hipLaunchKernelGGL(mega, dim3(grid), dim3(512), LDS_BYTES, stream, a);
}
```

```cpp
#include <hip/hip_runtime.h>
#include <cstdio>
#include <cstdint>

typedef unsigned short bf16_t;
typedef short bf16x8 __attribute__((ext_vector_type(8)));
typedef float f32x4 __attribute__((ext_vector_type(4)));
typedef unsigned u32x4 __attribute__((ext_vector_type(4)));
typedef unsigned u32x2 __attribute__((ext_vector_type(2)));
typedef float f32x2_ __attribute__((ext_vector_type(2)));

constexpr int D = 1024, NB = 8, T = 4096, TC = 256, GW = 64;
constexpr int NLAT = NB * T, NCTX = NB * TC, NTOK = NLAT + NCTX;
constexpr int RH = 8, RN = 64, RWD = 512, RWR = 64, RAR = 64, RGR = 128;
constexpr int RW_COLS = 3 * RWD + RWR + RAR + RGR;
constexpr int LWD = 512;
constexpr int IN_COLS = RW_COLS + 2 * LWD + 2 * D;
constexpr int NE = 16, CAP = 512, DE = 1024;
constexpr float RMS_EPS = 1e-6f, LNX_EPS = 64e-5f;
constexpr int NSLOT = NB * NE * CAP;

constexpr size_t MiB = 1u << 20;
constexpr size_t WS_CTL = 0;
constexpr size_t WS_MOD = 1 * MiB;
constexpr size_t WS_WIN = 2 * MiB;
constexpr size_t WS_WPR = 12 * MiB;
constexpr size_t WS_WPL = 13 * MiB;
constexpr size_t WS_WOUT = 14 * MiB;
constexpr size_t WS_GT = 16 * MiB;
constexpr size_t WS_XMID = 16 * MiB;
constexpr size_t WS_U = 144 * MiB;
constexpr size_t WS_Y = 144 * MiB;
constexpr size_t WS_RW = 212 * MiB;
constexpr size_t WS_MERGED = 212 * MiB;
constexpr size_t WS_XB = 331 * MiB;
constexpr size_t WS_GB = 365 * MiB;
constexpr size_t WS_H = 397 * MiB;
constexpr size_t WS_O = 461 * MiB;
constexpr size_t WS_TAB = 496 * MiB;
constexpr size_t WS_W2 = 144 * MiB;
constexpr size_t WS_W13 = 176 * MiB;
constexpr size_t WS_XS = 240 * MiB;
constexpr size_t WS_H2 = 240 * MiB;
constexpr size_t WS_HID = 368 * MiB;
constexpr size_t WS_YE = 176 * MiB;
constexpr size_t WS_END = 512 * MiB;
constexpr size_t TAB_AFF = WS_TAB;
constexpr size_t TAB_IDX = WS_TAB + 2 * MiB;
constexpr size_t TAB_GATE = WS_TAB + 3 * MiB;
constexpr size_t TAB_SLOT = WS_TAB + 4 * MiB;
constexpr size_t TAB_RSTD = WS_TAB + 6 * MiB;
constexpr size_t TAB_SIDE = WS_TAB + 8 * MiB;
constexpr size_t TAB_SSQ = WS_TAB + 8 * MiB;

__device__ __forceinline__ unsigned f2bf(float f) { return (unsigned)__builtin_bit_cast(unsigned short, (__bf16)f); }
typedef float f32x2_t_ __attribute__((ext_vector_type(2))); typedef __bf16 bf16x2_t_ __attribute__((ext_vector_type(2)));
__device__ __forceinline__ unsigned pk2(float lo, float hi) { const f32x2_t_ v = {lo, hi}; const bf16x2_t_ b = __builtin_convertvector(v, bf16x2_t_); return __builtin_bit_cast(unsigned, b); }
__device__ __forceinline__ float bf2f(bf16_t b) { return __builtin_bit_cast(float, ((unsigned)b) << 16); }
__device__ __forceinline__ float softplusf_(float x) { return fmaxf(x, 0.f) + log1pf(__expf(-fabsf(x))); }
__device__ __forceinline__ float siluf_(float x) { return x / (1.f + __expf(-x)); }
__device__ __forceinline__ float fsigmoid(float x) { return __builtin_amdgcn_rcpf(1.f + __builtin_amdgcn_exp2f(-1.4426950408889634f * x)); }
__device__ __forceinline__ float fgelu_tanh(float x) { return x * fsigmoid(1.5957691216057308f * (x + 0.044715f * x * x * x)); }
__device__ __forceinline__ float fsilu(float x) { return x * fsigmoid(x); }
__device__ __forceinline__ float wave_sum(float v) {
#pragma unroll
    for (int o = 1; o < 64; o <<= 1) v += __shfl_xor(v, o);
    return v;
}
constexpr size_t WS_W2T = WS_MOD + 256 * 1024, WS_A2T = WS_MOD + 384 * 1024, WS_WAT = WS_MOD + 512 * 1024, WS_WXT = WS_MOD + 640 * 1024, WS_G2T = WS_MOD + 768 * 1024;
constexpr size_t WS_HL = WS_XB;


__device__ __forceinline__ void st_bf16x4(bf16_t* p, f32x4 v) { u32x2 w; w.x = pk2(v.x, v.y); w.y = pk2(v.z, v.w); *(u32x2*)p = w; }
__device__ __forceinline__ f32x4 ld_bf16x4(const bf16_t* p) { const u32x2 w = *(const u32x2*)p; return (f32x4){__builtin_bit_cast(float, w.x << 16), __builtin_bit_cast(float, w.x & 0xffff0000u), __builtin_bit_cast(float, w.y << 16), __builtin_bit_cast(float, w.y & 0xffff0000u)}; }
namespace pg8 {
#define PG8_LAS __attribute__((address_space(3)))
constexpr int BM = 256, BK = 64, HALF = 128, HTB = HALF * BK * 2, STAGE_BYTES = 8 * HTB, NXCD = 8, WGM = 8;
__host__ __device__ __forceinline__ int lds_byte(int r, int c) { const int st = (r >> 4) * 2 + (c >> 5), rr = r & 15, cc = c & 31, ob = rr * 64 + cc * 2; return st * 1024 + (ob ^ (((ob >> 9) & 1) << 5)); }
__host__ __device__ __forceinline__ void stage_rc(int b, int& R, int& C) { const int st = b / 1024, sb = b % 1024, swz = sb ^ (((sb >> 9) & 1) << 5); R = (st >> 1) * 16 + swz / 64; C = (st & 1) * 32 + (swz % 64) / 2; }
__host__ __device__ __forceinline__ int perm32(int rho) { const int n = rho >> 4, i = rho & 15; return 8 * (i >> 2) + 4 * n + (i & 3); }
struct Unit { int pm, pn, aux; };
__device__ __forceinline__ void grid_order(int L, int nM, int nN, int& pm, int& pn) {
    const int nwg = nM * nN; int wgid = L; { const int q = nwg / NXCD, r = nwg % NXCD, xcd = wgid % NXCD, off = wgid / NXCD; wgid = (xcd < r ? xcd * (q + 1) : r * (q + 1) + (xcd - r) * q) + off; }
    const int nig = WGM * nN, gid = wgid / nig, fm = gid * WGM, gsz = (nM - fm) < WGM ? (nM - fm) : WGM;
    pm = fm + ((wgid % nig) % gsz); pn = (wgid % nig) / gsz;
}

template <class Epi, class Sched, bool ALIGN_EPI = true>
__device__ __forceinline__ void gemm_phase(PG8_LAS unsigned char* lds, const int K, const Sched& S, const Epi& E) {
    int tid = threadIdx.x; asm volatile("" : "+v"(tid));
    const int wid = __builtin_amdgcn_readfirstlane(tid >> 6), lane = tid & 63, wr = wid >> 2, wc = wid & 3, fr = lane & 15, fq = lane >> 4;
    const int nt = K / BK;
    unsigned voffB[2]; int RA[2]; unsigned CA[2];
#pragma unroll
    for (int i = 0; i < 2; ++i) { int R, C; stage_rc(tid * 16 + i * 8192, R, C); const int Rb = Epi::PERM ? ((R & ~31) + perm32(R & 31)) : R;
        RA[i] = R; CA[i] = (unsigned)C * 2u; voffB[i] = (unsigned)(Rb * K + C) * 2u; }
    unsigned vc[2][2], vn[2][2];
#define PG8_AOFF(dst, u) do { _Pragma("unroll") for (int _h = 0; _h < 2; ++_h) _Pragma("unroll") for (int _i = 0; _i < 2; ++_i) dst[_h][_i] = S.a_rowoff(u, _h * HALF + RA[_i], K) + CA[_i]; } while (0)
#define PG8_SEL(h) { last ? vn[h][0] : vc[h][0], last ? vn[h][1] : vc[h][1] }
    const size_t kstep = (size_t)(BK * 2);
    const size_t hstep = (size_t)HALF * K * 2;
    const unsigned ldsw = (unsigned)wid * 1024u;
    const int aoff = lds_byte(wr * 64 + fr, fq * 8), boff = lds_byte(wc * 32 + fr, fq * 8);
#define PG8_SA(b, h) (((b) * 2 + (h)) * HTB)
#define PG8_SB(b, h) ((4 + (b) * 2 + (h)) * HTB)
#define PG8_STAGE(bufoff, gbase, voff) do { _Pragma("unroll") for (int _i = 0; _i < 2; ++_i) \
        __builtin_amdgcn_global_load_lds((const unsigned*)((const char*)(gbase) + (voff)[_i]), (PG8_LAS unsigned*)(lds + (bufoff) + ldsw + _i * 8192), 16, 0, 0); } while (0)
#define PG8_LDA(dst, b, h) do { _Pragma("unroll") for (int m = 0; m < 4; ++m) _Pragma("unroll") for (int k = 0; k < 2; ++k) dst[m][k] = *(const PG8_LAS bf16x8*)(lds + PG8_SA(b, h) + aoff + m * 2048 + k * 1024); } while (0)
#define PG8_LDB(dst, b, h) do { _Pragma("unroll") for (int n = 0; n < 2; ++n) _Pragma("unroll") for (int k = 0; k < 2; ++k) dst[n][k] = *(const PG8_LAS bf16x8*)(lds + PG8_SB(b, h) + boff + n * 2048 + k * 1024); } while (0)
#define PG8_MMA(ai, bj, At, Bt) do { __builtin_amdgcn_s_setprio(1); _Pragma("unroll") for (int m = 0; m < 4; ++m) _Pragma("unroll") for (int n = 0; n < 2; ++n) _Pragma("unroll") for (int k = 0; k < 2; ++k) \
        acc[ai][bj][m][n] = __builtin_amdgcn_mfma_f32_16x16x32_bf16(Bt[n][k], At[m][k], acc[ai][bj][m][n], 0, 0, 0); __builtin_amdgcn_s_setprio(0); } while (0)
#define PG8_WAIT_V(n) asm volatile("s_waitcnt vmcnt(" #n ")" ::: "memory")
#define PG8_WAIT_L(n) asm volatile("s_waitcnt lgkmcnt(" #n ")" ::: "memory")
#define PG8_BAR __builtin_amdgcn_s_barrier()
#define PG8_SCHED __builtin_amdgcn_sched_barrier(0)
    Unit cur, nxt; int ui = 0;
    if (!S.next(0, cur)) return;
    f32x4 acc[2][2][4][2];
#pragma unroll
    for (int a = 0; a < 2; ++a)
#pragma unroll
        for (int b = 0; b < 2; ++b)
#pragma unroll
            for (int m = 0; m < 4; ++m)
#pragma unroll
                for (int n = 0; n < 2; ++n) acc[a][b][m][n] = (f32x4){0.f, 0.f, 0.f, 0.f};
    bf16x8 At[4][2], B0[2][2], B1[2][2];
    const char* cA = S.a_base(cur); const char* cB = S.b_base(cur);
    PG8_AOFF(vc, cur);
    PG8_STAGE(PG8_SB(0, 0), cB, voffB); PG8_STAGE(PG8_SB(0, 1), cB + hstep, voffB); PG8_STAGE(PG8_SA(0, 0), cA, vc[0]); PG8_STAGE(PG8_SA(0, 1), cA, vc[1]);
    if (wr == 1) PG8_BAR;
    PG8_WAIT_V(2); PG8_BAR;
    PG8_STAGE(PG8_SB(1, 0), cB + kstep, voffB); PG8_STAGE(PG8_SA(1, 0), cA + kstep, vc[0]); PG8_STAGE(PG8_SB(1, 1), cB + hstep + kstep, voffB);
    PG8_WAIT_V(6); PG8_BAR;
    for (;;) {
        const bool has_next = S.next(ui + 1, nxt);
        const char* nA = has_next ? S.a_base(nxt) : cA; const char* nB = has_next ? S.b_base(nxt) : cB;
        if (has_next) PG8_AOFF(vn, nxt); else { vn[0][0] = vc[0][0]; vn[0][1] = vc[0][1]; vn[1][0] = vc[1][0]; vn[1][1] = vc[1][1]; }
        for (int t = 0; t < nt; t += 2) {
            const bool last = (t == nt - 2);
            const char* a1 = cA + (size_t)(t + 1) * kstep;
            const char* a2 = last ? nA : cA + (size_t)(t + 2) * kstep; const char* b2 = last ? nB : cB + (size_t)(t + 2) * kstep;
            const char* a3 = a2 + kstep; const char* b3 = b2 + kstep;
            PG8_LDB(B0, 0, 0); PG8_LDB(B1, 0, 1); PG8_SCHED; PG8_LDA(At, 0, 0); PG8_STAGE(PG8_SA(1, 1), a1, vc[1]);
            PG8_WAIT_V(8); PG8_WAIT_L(0); PG8_BAR; PG8_MMA(0, 0, At, B0); PG8_MMA(0, 1, At, B1); PG8_BAR; PG8_SCHED;
            PG8_LDA(At, 0, 1); PG8_STAGE(PG8_SB(0, 0), b2, voffB); PG8_STAGE(PG8_SB(0, 1), b2 + hstep, voffB); { const unsigned vs[2] = PG8_SEL(0); PG8_STAGE(PG8_SA(0, 0), a2, vs); }
            PG8_WAIT_V(8); PG8_WAIT_L(0); PG8_BAR; PG8_MMA(1, 0, At, B0); PG8_MMA(1, 1, At, B1); PG8_BAR; PG8_SCHED;
            PG8_LDB(B0, 1, 0); PG8_LDB(B1, 1, 1); PG8_SCHED; PG8_LDA(At, 1, 0); { const unsigned vs[2] = PG8_SEL(1); PG8_STAGE(PG8_SA(0, 1), a2, vs); }
            PG8_WAIT_V(8); PG8_WAIT_L(0); PG8_BAR; PG8_MMA(0, 0, At, B0); PG8_MMA(0, 1, At, B1); PG8_BAR; PG8_SCHED;
            PG8_LDA(At, 1, 1); PG8_STAGE(PG8_SB(1, 0), b3, voffB); PG8_STAGE(PG8_SB(1, 1), b3 + hstep, voffB); { const unsigned vs[2] = PG8_SEL(0); PG8_STAGE(PG8_SA(1, 0), a3, vs); }
            PG8_WAIT_V(8); PG8_WAIT_L(0); PG8_BAR; PG8_MMA(1, 0, At, B0); PG8_MMA(1, 1, At, B1); PG8_BAR; PG8_SCHED;
        }
        if constexpr (ALIGN_EPI) { if (wr == 0) PG8_BAR; }
        E(acc, cur, wr, wc, fr, fq);
        if (!has_next) break;
#pragma unroll
        for (int a = 0; a < 2; ++a)
#pragma unroll
            for (int b = 0; b < 2; ++b)
#pragma unroll
                for (int m = 0; m < 4; ++m)
#pragma unroll
                    for (int n = 0; n < 2; ++n) acc[a][b][m][n] = (f32x4){0.f, 0.f, 0.f, 0.f};
        cur = nxt; cA = nA; cB = nB; ++ui; vc[0][0] = vn[0][0]; vc[0][1] = vn[0][1]; vc[1][0] = vn[1][0]; vc[1][1] = vn[1][1];
        if constexpr (ALIGN_EPI) { if (wr == 1) PG8_BAR; }
    }
    PG8_WAIT_V(0);
    if constexpr (!ALIGN_EPI) { if (wr == 0) PG8_BAR; }
    PG8_BAR;
#undef PG8_AOFF
#undef PG8_SEL
#undef PG8_SA
#undef PG8_SB
#undef PG8_STAGE
#undef PG8_LDA
#undef PG8_LDB
#undef PG8_MMA
#undef PG8_WAIT_V
#undef PG8_WAIT_L
#undef PG8_BAR
#undef PG8_SCHED
}
}

struct SWin {
    const bf16_t* U; const bf16_t* W; int G, c;
    __device__ __forceinline__ bool next(int i, pg8::Unit& u) const { const int L = i * G + c; if (L < 128 * 19) { pg8::grid_order(L, 128, 19, u.pm, u.pn); u.aux = 0; return true; }
        const int r = L - 128 * 19; if (r >= 72) return false; u.pm = 128 + (r & 7); u.pn = r >> 3; u.aux = 0; return true; }
    __device__ __forceinline__ const char* a_base(const pg8::Unit& u) const { return (const char*)(U + (size_t)u.pm * 256 * D); }
    __device__ __forceinline__ unsigned a_rowoff(const pg8::Unit&, int r, int K) const { return (unsigned)(r * K) * 2u; }
    __device__ __forceinline__ const char* b_base(const pg8::Unit& u) const { return (const char*)(W + (size_t)u.pn * 256 * D); }
};
struct EWin {
    static constexpr bool PERM = true;
    bf16_t* RW; bf16_t* XB; bf16_t* GB; bf16_t* GT;
    __device__ __forceinline__ void operator()(const f32x4 (&acc)[2][2][4][2], const pg8::Unit& u, int wr, int wc, int fr, int fq) const {
        const int row0 = u.pm * 256 + wr * 64 + fr, colt = u.pn * 256, cl = wc * 32 + 8 * fq;
        bf16_t* base; int ldc, act;
        if (colt < 1792) { base = RW + colt; ldc = RW_COLS; act = 0; } else if (colt < 2304) { base = XB + (colt - 1792); ldc = LWD; act = 0; }
        else if (colt < 2816) { base = GB + (colt - 2304); ldc = LWD; act = 1; } else { base = GT + (colt - 2816); ldc = 2048; act = 2; }
#pragma unroll
        for (int ai = 0; ai < 2; ++ai)
#pragma unroll
            for (int m = 0; m < 4; ++m) { bf16_t* rowp = base + (size_t)(row0 + ai * 128 + m * 16) * ldc + cl;
#pragma unroll
                for (int bj = 0; bj < 2; ++bj) { f32x4 v0 = acc[ai][bj][m][0], v1 = acc[ai][bj][m][1];
                    if (act == 1) {
#pragma unroll
                        for (int j = 0; j < 4; ++j) { v0[j] = fgelu_tanh(v0[j]); v1[j] = fgelu_tanh(v1[j]); } }
                    else if (act == 2) {
#pragma unroll
                        for (int j = 0; j < 4; ++j) { v0[j] = fsigmoid(v0[j]); v1[j] = fsigmoid(v1[j]); } }
                    u32x4 w; w.x = pk2(v0[0], v0[1]); w.y = pk2(v0[2], v0[3]); w.z = pk2(v1[0], v1[1]); w.w = pk2(v1[2], v1[3]);
                    *(u32x4*)(rowp + bj * 128) = w; } }
    }
};
struct SProj {
    const bf16_t* O; const bf16_t* HL; const bf16_t* Wr; const bf16_t* Wl; int G, c;
    __device__ __forceinline__ bool next(int i, pg8::Unit& u) const { const int L = (i >> 1) * G + c; if (L >= 128 * 4) return false; pg8::grid_order(L, 128, 4, u.pm, u.pn); u.aux = i & 1; return true; }
    __device__ __forceinline__ const char* a_base(const pg8::Unit& u) const { return (const char*)((u.aux ? HL : O) + (size_t)u.pm * 256 * 512); }
    __device__ __forceinline__ unsigned a_rowoff(const pg8::Unit&, int r, int K) const { return (unsigned)(r * K) * 2u; }
    __device__ __forceinline__ const char* b_base(const pg8::Unit& u) const { return (const char*)((u.aux ? Wl : Wr) + (size_t)u.pn * 256 * 512); }
};
struct EProj {
    static constexpr bool PERM = true;
    const bf16_t* GT; bf16_t* MG;
    __device__ __forceinline__ void operator()(const f32x4 (&acc)[2][2][4][2], const pg8::Unit& u, int wr, int wc, int fr, int fq) const {
        const int row0 = u.pm * 256 + wr * 64 + fr, col0 = u.pn * 256 + wc * 32 + 8 * fq;
#pragma unroll
        for (int ai = 0; ai < 2; ++ai)
#pragma unroll
            for (int m = 0; m < 4; ++m) { const size_t r = (size_t)(row0 + ai * 128 + m * 16);
#pragma unroll
                for (int bj = 0; bj < 2; ++bj) { const int cc = col0 + bj * 128; const bf16_t* gp = GT + r * 2048 + (u.aux ? 1024 : 0) + cc; bf16_t* op = MG + r * D + cc;
                    const f32x4 g0 = ld_bf16x4(gp), g1 = ld_bf16x4(gp + 4); f32x4 v0 = g0 * acc[ai][bj][m][0], v1 = g1 * acc[ai][bj][m][1];
                    if (u.aux) { v0 += ld_bf16x4(op); v1 += ld_bf16x4(op + 4); }
                    u32x4 w; w.x = pk2(v0[0], v0[1]); w.y = pk2(v0[2], v0[3]); w.z = pk2(v1[0], v1[1]); w.w = pk2(v1[2], v1[3]);
                    *(u32x4*)op = w; } }
    }
};
struct SWout {
    const bf16_t* MG; const bf16_t* W; int G, c;
    __device__ __forceinline__ bool next(int i, pg8::Unit& u) const { const int L = i * G + c; if (L >= 128 * 4) return false; pg8::grid_order(L, 128, 4, u.pm, u.pn); u.aux = 0; return true; }
    __device__ __forceinline__ const char* a_base(const pg8::Unit& u) const { return (const char*)(MG + (size_t)u.pm * 256 * D); }
    __device__ __forceinline__ unsigned a_rowoff(const pg8::Unit&, int r, int K) const { return (unsigned)(r * K) * 2u; }
    __device__ __forceinline__ const char* b_base(const pg8::Unit& u) const { return (const char*)(W + (size_t)u.pn * 256 * D); }
};
struct EWout {
    static constexpr bool PERM = false;
    const float* x; const float* MOD; float* XMID; float* SSQ;
    __device__ __forceinline__ void operator()(const f32x4 (&acc)[2][2][4][2], const pg8::Unit& u, int wr, int wc, int fr, int fq) const {
        const int row0 = u.pm * 256 + wr * 64 + fr, col0 = u.pn * 256 + wc * 32 + 4 * fq; const float* gt1 = MOD + (size_t)(u.pm >> 4) * 6144 + 2048;
        f32x4 gv[2][2];
#pragma unroll
        for (int bj = 0; bj < 2; ++bj)
#pragma unroll
            for (int n = 0; n < 2; ++n) gv[bj][n] = *(const f32x4*)(gt1 + col0 + bj * 128 + n * 16);
#pragma unroll
        for (int ai = 0; ai < 2; ++ai)
#pragma unroll
            for (int m = 0; m < 4; ++m) { const size_t row = (size_t)(row0 + ai * 128 + m * 16), off = row * D + col0; float ss = 0.f;
#pragma unroll
                for (int bj = 0; bj < 2; ++bj)
#pragma unroll
                    for (int n = 0; n < 2; ++n) { const f32x4 v = *(const f32x4*)(x + off + bj * 128 + n * 16) + gv[bj][n] * acc[ai][bj][m][n]; *(f32x4*)(XMID + off + bj * 128 + n * 16) = v; ss += (v.x * v.x + v.y * v.y) + (v.z * v.z + v.w * v.w); }
                ss += __shfl_xor(ss, 16); ss += __shfl_xor(ss, 32);
                if (fq == 0) SSQ[row * 16 + u.pn * 4 + wc] = ss; }
    }
};
struct SMoe1 {
    const bf16_t* H2; const bf16_t* W13; const int* IDX; int G, c;
    __device__ __forceinline__ bool next(int i, pg8::Unit& u) const { const int L = i * G + c; if (L >= 256 * 8) return false; pg8::grid_order(L, 256, 8, u.pm, u.pn); u.aux = (u.pm >> 1) & 15; return true; }
    __device__ __forceinline__ const char* a_base(const pg8::Unit&) const { return (const char*)H2; }
    __device__ __forceinline__ unsigned a_rowoff(const pg8::Unit& u, int r, int K) const { return (unsigned)((u.pm >> 5) * T + IDX[u.pm * 256 + r]) * (unsigned)(K * 2); }
    __device__ __forceinline__ const char* b_base(const pg8::Unit& u) const { return (const char*)(W13 + ((size_t)u.aux * 2048 + (size_t)u.pn * 256) * D); }
};
struct EMoe1 {
    static constexpr bool PERM = true;
    bf16_t* HID;
    __device__ __forceinline__ void operator()(const f32x4 (&acc)[2][2][4][2], const pg8::Unit& u, int wr, int wc, int fr, int fq) const {
        const int row0 = u.pm * 256 + wr * 64 + fr, col0 = (u.pn * 256 + wc * 32 + 8 * fq) >> 1;
#pragma unroll
        for (int ai = 0; ai < 2; ++ai)
#pragma unroll
            for (int m = 0; m < 4; ++m) { bf16_t* rowp = HID + (size_t)(row0 + ai * 128 + m * 16) * DE + col0;
#pragma unroll
                for (int bj = 0; bj < 2; ++bj) { const f32x4 a = acc[ai][bj][m][0], b = acc[ai][bj][m][1]; u32x2 w;
                    w.x = pk2(fsilu(a[0]) * b[0], fsilu(a[1]) * b[1]); w.y = pk2(fsilu(a[2]) * b[2], fsilu(a[3]) * b[3]);
                    *(u32x2*)(rowp + bj * 64) = w; } }
    }
};
struct SMoe2 {
    const bf16_t* HID; const bf16_t* W2; int G, c;
    __device__ __forceinline__ bool next(int i, pg8::Unit& u) const { const int L = i * G + c; if (L >= 256 * 4) return false; pg8::grid_order(L, 256, 4, u.pm, u.pn); u.aux = (u.pm >> 1) & 15; return true; }
    __device__ __forceinline__ const char* a_base(const pg8::Unit& u) const { return (const char*)(HID + (size_t)u.pm * 256 * DE); }
    __device__ __forceinline__ unsigned a_rowoff(const pg8::Unit&, int r, int K) const { return (unsigned)(r * K) * 2u; }
    __device__ __forceinline__ const char* b_base(const pg8::Unit& u) const { return (const char*)(W2 + ((size_t)u.aux * D + (size_t)u.pn * 256) * DE); }
};
struct EMoe2 {
    static constexpr bool PERM = true;
    const float* GATE; bf16_t* YE;
    __device__ __forceinline__ void operator()(const f32x4 (&acc)[2][2][4][2], const pg8::Unit& u, int wr, int wc, int fr, int fq) const {
        const int row0 = u.pm * 256 + wr * 64 + fr, col0 = u.pn * 256 + wc * 32 + 8 * fq;
#pragma unroll
        for (int ai = 0; ai < 2; ++ai)
#pragma unroll
            for (int m = 0; m < 4; ++m) { const int r = row0 + ai * 128 + m * 16; const float gt = GATE[r]; bf16_t* rowp = YE + (size_t)r * D + col0;
#pragma unroll
                for (int bj = 0; bj < 2; ++bj) { const f32x4 v0 = acc[ai][bj][m][0] * gt, v1 = acc[ai][bj][m][1] * gt;
                    u32x4 w; w.x = pk2(v0[0], v0[1]); w.y = pk2(v0[2], v0[3]); w.z = pk2(v1[0], v1[1]); w.w = pk2(v1[2], v1[3]);
                    *(u32x4*)(rowp + bj * 128) = w; } }
    }
};
#ifndef PROBE
#define PROBE (-1)
#endif
#define LAS __attribute__((address_space(3)))
__device__ __forceinline__ int otid() { int t = threadIdx.x; asm volatile("" : "+v"(t)); return t; }
#define XB_TMO      128
#define XB_XCNT(j)  (256  + 64 * (j))
#define XB_XSUB(j)  (1280 + 64 * (j))
#define XB_XGEN(j)  (2304 + 64 * (j))
#define XB_TOP      3328
#define XB_TOPGEN   3392
#define XCD_BAR_WORDS 3456
#define XB_SPIN_CAP (1u << 22)
__device__ __forceinline__ unsigned xb_ld(unsigned* p)              { return __hip_atomic_load(p, __ATOMIC_RELAXED, __HIP_MEMORY_SCOPE_AGENT); }
__device__ __forceinline__ unsigned xb_add(unsigned* p, unsigned v) { return __hip_atomic_fetch_add(p, v, __ATOMIC_RELAXED, __HIP_MEMORY_SCOPE_AGENT); }
__device__ __forceinline__ unsigned xb_xcc_id() { return (unsigned)__builtin_amdgcn_s_getreg((3 << 11) | 20) & 0xFu; }
#define XB_SPIN(cond, bar) do { unsigned _sp = 0; while (cond) { __builtin_amdgcn_s_sleep(1); \
    if ((++_sp & 255u) == 0u) { if (xb_ld(&(bar)[XB_TMO])) break; if (_sp > XB_SPIN_CAP) { atomicAdd(&(bar)[XB_TMO], 1u); break; } } } } while (0)
struct XcdBarrier { unsigned* bar; unsigned x; volatile LAS unsigned* st; };
__device__ __forceinline__ XcdBarrier xcd_barrier_post(unsigned* bar, volatile LAS unsigned* st) {
    XcdBarrier b; b.bar = bar; b.x = xb_xcc_id(); b.st = st;
    if (threadIdx.x == 0) (void)xb_add(&bar[XB_XCNT(b.x)], 1u);
    return b;
}
__device__ __forceinline__ void xcd_barrier_complete(unsigned* bar, unsigned x, unsigned& nloc, unsigned& nx) {
    const unsigned G = gridDim.x * gridDim.y * gridDim.z;
    unsigned sum, cnt, mine, sp = 0u;
    for (;;) {
        sum = 0u; cnt = 0u; mine = 0u;
#pragma unroll
        for (unsigned j = 0; j < 16; ++j) { const unsigned c = xb_ld(&bar[XB_XCNT(j)]); sum += c; cnt += (c > 0u) ? 1u : 0u; mine = (j == x) ? c : mine; }
        if (sum == G) break;
        __builtin_amdgcn_s_sleep(1);
        if ((++sp & 255u) == 0u) { if (xb_ld(&bar[XB_TMO])) break; if (sp > XB_SPIN_CAP) { atomicAdd(&bar[XB_TMO], 1u); break; } }
    }
    nloc = mine > 0u ? mine : 1u; nx = cnt > 0u ? cnt : 1u;
}
__device__ __forceinline__ void xcd_barrier(const XcdBarrier& b) {
    asm volatile("s_waitcnt vmcnt(0)" ::: "memory");
    __syncthreads();
    if (threadIdx.x == 0) {
        unsigned* bar = b.bar;
        __builtin_amdgcn_s_waitcnt(0);
        unsigned nloc = b.st[0], nx = b.st[1];
        if (nloc == 0u) { xcd_barrier_complete(bar, b.x, nloc, nx); b.st[0] = nloc; b.st[1] = nx; }
        const unsigned old = xb_add(&bar[XB_XSUB(b.x)], 1u);
        const unsigned gen = old / nloc;
        if (old + 1u == (gen + 1u) * nloc) {
            __builtin_amdgcn_fence(__ATOMIC_RELEASE, "agent");
            asm volatile("s_waitcnt vmcnt(0)" ::: "memory");
            const unsigned og = xb_add(&bar[XB_TOP], 1u);
            const unsigned tg = og / nx;
            if (og + 1u == (tg + 1u) * nx) xb_add(&bar[XB_TOPGEN], 1u);
            else XB_SPIN(xb_ld(&bar[XB_TOPGEN]) == tg, bar);
            __builtin_amdgcn_fence(__ATOMIC_ACQUIRE, "agent");
            xb_add(&bar[XB_XGEN(b.x)], 1u);
            asm volatile("s_waitcnt vmcnt(0)" ::: "memory");
        } else {
            XB_SPIN(xb_ld(&bar[XB_XGEN(b.x)]) == gen, bar);
            __builtin_amdgcn_fence(__ATOMIC_ACQUIRE, "agent");
            asm volatile("s_waitcnt vmcnt(0)" ::: "memory");
        }
    }
    __syncthreads();
}

struct Args { const float* in[35]; float* out; unsigned char* ws; };

__device__ __forceinline__ void phase_modvec(const float* __restrict__ c, const float* __restrict__ c_ctx, const float* __restrict__ w_mod, const float* __restrict__ b_mod, float* __restrict__ MOD, unsigned char* lds, int bid, int nb) {
    float (*sv)[1024] = (float (*)[1024])lds; float (*red)[9][32] = (float (*)[9][32])(lds + 9 * 1024 * 4);
    const int tid = otid(), lane = tid & 63, w = tid >> 6;
    if (bid >= 192) return;
    for (int i = tid; i < 9 * 1024; i += 512) { const int r = i >> 10, k = i & 1023; const float v = r < 8 ? c[r * 1024 + k] : c_ctx[k]; sv[r][k] = siluf_(v); }
    __syncthreads();
    for (int item = bid; item < 192; item += nb) {
        const int col = item * 32 + (lane & 31), kg = w * 2 + (lane >> 5);
        float acc[9];
#pragma unroll
        for (int r = 0; r < 9; ++r) acc[r] = 0.f;
#pragma unroll 8
        for (int kk = 0; kk < 64; ++kk) { const int k = kg * 64 + kk; const float wv = w_mod[(size_t)k * 6144 + col];
#pragma unroll
            for (int r = 0; r < 9; ++r) acc[r] += sv[r][k] * wv; }
#pragma unroll
        for (int r = 0; r < 9; ++r) red[kg][r][lane & 31] = acc[r];
        __syncthreads();
        if (tid < 288) { const int r = tid >> 5, cc = tid & 31; float s = b_mod[item * 32 + cc];
#pragma unroll
            for (int g = 0; g < 16; ++g) s += red[g][r][cc];
            MOD[r * 6144 + item * 32 + cc] = s; }
        __syncthreads();
    }
}
__device__ __forceinline__ void phase_wconv(const float* __restrict__ src0, bf16_t* __restrict__ dst0, int K, int N, int rmul, int radd, int nbatch, size_t sstride, size_t dstride, unsigned char* lds, int bid, int nb) {
    const int tid = otid(), lane = tid & 63, wv = tid >> 6, gw = bid * 8 + wv, NGW = nb * 8, nkt = K / 64, nnt = N / 64, per = nkt * nnt;
    u32x4* wl = (u32x4*)(lds + wv * 9216);
    for (int it = gw; it < per * nbatch; it += NGW) {
        const int bt = it / per, r = it % per; const float* src = src0 + (size_t)bt * sstride; bf16_t* dst = dst0 + (size_t)bt * dstride;
        const int k0 = (r / nnt) * 64, n0 = (r % nnt) * 64;
        const float* sp = src + (size_t)k0 * N + n0 + lane; float v[64];
#pragma unroll
        for (int i = 0; i < 64; ++i) v[i] = sp[(size_t)i * N];
#pragma unroll
        for (int c = 0; c < 8; ++c) { u32x4 o; o.x = pk2(v[8 * c], v[8 * c + 1]); o.y = pk2(v[8 * c + 2], v[8 * c + 3]); o.z = pk2(v[8 * c + 4], v[8 * c + 5]); o.w = pk2(v[8 * c + 6], v[8 * c + 7]); wl[lane * 9 + c] = o; }
        asm volatile("s_waitcnt lgkmcnt(0)" ::: "memory");
#pragma unroll
        for (int j = 0; j < 8; ++j) { const int n = (lane >> 3) + 8 * j, c = lane & 7; const u32x4 o = wl[n * 9 + c];
            const int nn = n0 + n, row = (nn >> 2) * rmul + (nn & 3) + radd; *(u32x4*)(dst + (size_t)row * K + k0 + 8 * c) = o; }
        asm volatile("s_waitcnt lgkmcnt(0)" ::: "memory");
    }
}
__device__ __forceinline__ void phase_normmod(const float* __restrict__ x, const float* __restrict__ ctx, const float* __restrict__ g1, const float* __restrict__ MOD, bf16_t* __restrict__ U, int bid, int nb) {
    const int tid = otid(), lane = tid & 63, gw = bid * 8 + (tid >> 6), NGW = nb * 8;
    for (int r0 = gw * 4; r0 < NTOK; r0 += NGW * 4) {
        const float* src = r0 < NLAT ? x + (size_t)r0 * D : ctx + (size_t)(r0 - NLAT) * D;
        f32x4 v[4][4]; float ss[4];
#pragma unroll
        for (int q = 0; q < 4; ++q) { ss[q] = 0.f;
#pragma unroll
            for (int j = 0; j < 4; ++j) { v[q][j] = ((const f32x4*)(src + (size_t)q * D))[lane + 64 * j]; } }
#pragma unroll
        for (int q = 0; q < 4; ++q) {
#pragma unroll
            for (int j = 0; j < 4; ++j) ss[q] += (v[q][j].x * v[q][j].x + v[q][j].y * v[q][j].y) + (v[q][j].z * v[q][j].z + v[q][j].w * v[q][j].w);
            const int r = r0 + q; const float* mr = MOD + (size_t)(r < NLAT ? r / T : 8) * 6144;
            const float rstd = rsqrtf(wave_sum(ss[q]) * (1.f / D) + RMS_EPS);
#pragma unroll
            for (int j = 0; j < 4; ++j) { const f32x4 g = ((const f32x4*)g1)[lane + 64 * j], sh = ((const f32x4*)mr)[lane + 64 * j], sc = ((const f32x4*)(mr + 1024))[lane + 64 * j];
                const f32x4 o = (v[q][j] * rstd * g) * (sc + 1.f) + sh; u32x2 w; w.x = pk2(o.x, o.y); w.y = pk2(o.z, o.w);
                ((u32x2*)(U + (size_t)r * D))[lane + 64 * j] = w; } }
    }
}
template <int CTRL> __device__ __forceinline__ float dpp_mov(float x) { return __builtin_bit_cast(float, __builtin_amdgcn_update_dpp(0, __builtin_bit_cast(int, x), CTRL, 0xF, 0xF, true)); }
__device__ __forceinline__ float red16(float x) { x += dpp_mov<0xB1>(x); x += dpp_mov<0x4E>(x); x += dpp_mov<0x141>(x); x += dpp_mov<0x140>(x); return x; }
__device__ __forceinline__ float fmul_s(float a, float b) { float r; asm("v_mul_f32_e32 %0, %1, %2" : "=v"(r) : "v"(a), "v"(b)); return r; }
__device__ __forceinline__ float ffma_s(float a, float b, float c) { float r; asm("v_fma_f32 %0, %1, %2, %3" : "=v"(r) : "v"(a), "v"(b), "v"(c)); return r; }
__device__ __forceinline__ float fnma_s(float a, float b, float c) { float r; asm("v_fma_f32 %0, -%1, %2, %3" : "=v"(r) : "v"(a), "v"(b), "v"(c)); return r; }
__device__ __forceinline__ float ftanh(float x) { return 2.f * fsigmoid(2.f * x) - 1.f; }
__device__ __forceinline__ void unpack8(const u32x4 v, float (&f)[8]) {
    f[0] = __builtin_bit_cast(float, v.x << 16); f[1] = __builtin_bit_cast(float, v.x & 0xffff0000u); f[2] = __builtin_bit_cast(float, v.y << 16); f[3] = __builtin_bit_cast(float, v.y & 0xffff0000u);
    f[4] = __builtin_bit_cast(float, v.z << 16); f[5] = __builtin_bit_cast(float, v.z & 0xffff0000u); f[6] = __builtin_bit_cast(float, v.w << 16); f[7] = __builtin_bit_cast(float, v.w & 0xffff0000u); }
__device__ __forceinline__ void phase_lru_seq(const bf16_t* __restrict__ XB, bf16_t* __restrict__ H0, bf16_t* __restrict__ H1, const float* __restrict__ conv_w, const float* __restrict__ conv_b, const bf16_t* __restrict__ WAT,
                                              const float* __restrict__ ba, const bf16_t* __restrict__ WXT, const float* __restrict__ bx, const float* __restrict__ lam, unsigned char* lds, int bid, int nb) {
    const int tid = otid(), lane = tid & 63, w = __builtin_amdgcn_readfirstlane(tid >> 6), fr = lane & 15, fq = lane >> 4;
    bf16_t* RAW = (bf16_t*)(lds + w * 18944);
    bf16_t* XC = (bf16_t*)(lds + w * 18944 + 9728);
    float* CW = (float*)(lds + 151552);
    float* TOT = (float*)(lds + 152832);
    for (int item = bid; item < 256; item += nb) {
        const int b = item >> 5, g = (item >> 2) & 7, d = (item >> 1) & 1, half = item & 1;
        bf16_t* Hd = d ? H1 : H0;
        __syncthreads();
        float cwr[5][8];
#pragma unroll
        for (int k = 0; k < 5; ++k)
#pragma unroll
            for (int e = 0; e < 8; ++e) cwr[k][e] = k < 4 ? conv_w[(d * 4 + k) * 512 + g * 64 + 8 * (lane & 7) + e] : conv_b[d * 512 + g * 64 + 8 * (lane & 7) + e];
        bf16x8 waf[2][2], wxf[2][2]; float bav[2], bxv[2], spv[2], hcar[2];
#pragma unroll
        for (int mt = 0; mt < 2; ++mt) { const int co = half * 32 + 16 * mt + fr, cg = d * 512 + g * 64 + co; bav[mt] = ba[cg]; bxv[mt] = bx[cg]; spv[mt] = softplusf_(-lam[cg]); hcar[mt] = 0.f;
#pragma unroll
            for (int ks = 0; ks < 2; ++ks) { const size_t off = (((size_t)d * 8 + g) * 64 + co) * 64 + ks * 32 + fq * 8; waf[mt][ks] = *(const bf16x8*)(WAT + off); wxf[mt][ks] = *(const bf16x8*)(WXT + off); } }
        __syncthreads();
        for (int sc = 0; sc < 9; ++sc) {
            const int ch = sc * 8 + w; const bool active = ch < 68; const bool isctx = ch < 4; const int len = isctx ? TC : T; const int s0 = isctx ? ch * 64 : (ch - 4) * 64;
            float Atot[2] = {1.f, 1.f}, Btot[2] = {0.f, 0.f}, Aex[2] = {1.f, 1.f}, Bex[2] = {0.f, 0.f};
            float av[2][16], bv[2][16];
            if (active) {
                auto rowof = [&](int sseg) -> size_t { const int i = d ? len - 1 - sseg : sseg; return isctx ? (size_t)NLAT + (size_t)b * TC + i : (size_t)b * T + (size_t)((i & 63) * 64 + (i >> 6)); };
                { const int lr = lane >> 3, lc = lane & 7; const u32x4 z = {0u, 0u, 0u, 0u};
#pragma unroll
                  for (int g8 = 0; g8 < 9; ++g8) { const int rr = 8 * g8 + lr; if (rr < 67) { const int sh = s0 - 3 + rr; *(u32x4*)(RAW + rr * 72 + 8 * lc) = sh >= 0 ? *(const u32x4*)(XB + rowof(sh) * LWD + g * 64 + 8 * lc) : z; } } }
                { const int j8 = lane & 7, p0 = 8 * (lane >> 3); float win[4][8];
#pragma unroll
                  for (int q = 0; q < 3; ++q) unpack8(*(const u32x4*)(RAW + (p0 + q) * 72 + 8 * j8), win[q]);
#pragma unroll
                  for (int q = 0; q < 8; ++q) { const int s = p0 + q, rho = 16 * ((s >> 2) & 3) + 4 * (s >> 4) + (s & 3); unpack8(*(const u32x4*)(RAW + (s + 3) * 72 + 8 * j8), win[(q + 3) & 3]);
                      float o[8];
#pragma unroll
                      for (int e = 0; e < 8; ++e) o[e] = cwr[4][e] + cwr[0][e] * win[q & 3][e] + cwr[1][e] * win[(q + 1) & 3][e] + cwr[2][e] * win[(q + 2) & 3][e] + cwr[3][e] * win[(q + 3) & 3][e];
                      u32x4 pk; pk.x = pk2(o[0], o[1]); pk.y = pk2(o[2], o[3]); pk.z = pk2(o[4], o[5]); pk.w = pk2(o[6], o[7]); *(u32x4*)(XC + rho * 72 + 8 * j8) = pk; } }
                f32x4 pa[2][4], px[2][4];
#pragma unroll
                for (int mt = 0; mt < 2; ++mt)
#pragma unroll
                    for (int nt = 0; nt < 4; ++nt) { pa[mt][nt] = (f32x4){0.f, 0.f, 0.f, 0.f}; px[mt][nt] = (f32x4){0.f, 0.f, 0.f, 0.f}; }
#pragma unroll
                for (int nt = 0; nt < 4; ++nt)
#pragma unroll
                    for (int ks = 0; ks < 2; ++ks) { const bf16x8 xf = *(const bf16x8*)(XC + (16 * nt + fr) * 72 + ks * 32 + fq * 8);
#pragma unroll
                        for (int mt = 0; mt < 2; ++mt) { pa[mt][nt] = __builtin_amdgcn_mfma_f32_16x16x32_bf16(xf, waf[mt][ks], pa[mt][nt], 0, 0, 0); px[mt][nt] = __builtin_amdgcn_mfma_f32_16x16x32_bf16(xf, wxf[mt][ks], px[mt][nt], 0, 0, 0); } }
#pragma unroll
                for (int mt = 0; mt < 2; ++mt) { float A = 1.f, B = 0.f;
#pragma unroll
                    for (int nt = 0; nt < 4; ++nt)
#pragma unroll
                        for (int j = 0; j < 4; ++j) { const float xc = bf2f(XC[(16 * nt + 4 * fq + j) * 72 + half * 32 + 16 * mt + fr]);
                            const float rg = fsigmoid(pa[mt][nt][j] + bav[mt]), ig = fsigmoid(px[mt][nt][j] + bxv[mt]); const float a = __expf(-8.f * rg * spv[mt]); const float bt = sqrtf((1.f - a) * (1.f + a)) * (ig * xc);
                            av[mt][nt * 4 + j] = a; bv[mt][nt * 4 + j] = bt; B = a * B + bt; A = A * a; }
                    { const float Al = __shfl_up(A, 16), Bl = __shfl_up(B, 16); if (fq >= 1) { B = A * Bl + B; A = A * Al; } }
                    { const float Al = __shfl_up(A, 32), Bl = __shfl_up(B, 32); if (fq >= 2) { B = A * Bl + B; A = A * Al; } }
                    { const float Al = __shfl_up(A, 16), Bl = __shfl_up(B, 16); Aex[mt] = fq >= 1 ? Al : 1.f; Bex[mt] = fq >= 1 ? Bl : 0.f; }
                    Atot[mt] = __shfl(A, 48 + fr); Btot[mt] = __shfl(B, 48 + fr); }
            }
            if (fq == 3) {
#pragma unroll
                for (int mt = 0; mt < 2; ++mt) { TOT[(w * 32 + 16 * mt + fr) * 2] = Atot[mt]; TOT[(w * 32 + 16 * mt + fr) * 2 + 1] = Btot[mt]; } }
            __syncthreads();
            float hin[2];
#pragma unroll
            for (int mt = 0; mt < 2; ++mt) { float h = hcar[mt]; hin[mt] = h;
#pragma unroll
                for (int ww = 0; ww < 8; ++ww) { const float At = TOT[(ww * 32 + 16 * mt + fr) * 2], Bt = TOT[(ww * 32 + 16 * mt + fr) * 2 + 1]; h = At * h + Bt; if (ww + 1 == w) hin[mt] = h; }
                hcar[mt] = h; }
            if (active && !isctx) {
                bf16_t* OUT = RAW;
#pragma unroll
                for (int mt = 0; mt < 2; ++mt) { float h = Aex[mt] * hin[mt] + Bex[mt];
#pragma unroll
                    for (int q = 0; q < 16; ++q) { h = av[mt][q] * h + bv[mt][q]; OUT[(16 * fq + q) * 40 + 16 * mt + fr] = (bf16_t)f2bf(h); } }
#pragma unroll
                for (int j = 0; j < 4; ++j) { const int ps = 16 * j + (lane >> 2), lc = lane & 3; const int sseg = s0 + ps; const int i = d ? len - 1 - sseg : sseg; const size_t row = (size_t)b * T + (size_t)((i & 63) * 64 + (i >> 6));
                    *(u32x4*)(Hd + row * LWD + g * 64 + half * 32 + 8 * lc) = *(const u32x4*)(OUT + ps * 40 + 8 * lc); }
            }
            __syncthreads();
        }
    }
}

constexpr int NSTRIP = NTOK / 32, NCHUNK = RW_COLS / 8;
__device__ __forceinline__ void phase_mixA(const bf16_t* __restrict__ RW, bf16_t* __restrict__ SIDE, int bid, int nb) {
    const int tid = otid(), lane = tid & 63, gw = bid * 8 + (tid >> 6), NGW = nb * 8;
    for (int it = gw; it < NSTRIP * 2; it += NGW) { const int sidx = it >> 1, wh = it & 1; const u32x4* src = (const u32x4*)(RW + (size_t)(sidx * 32 + wh * 31) * RW_COLS); u32x4* dst = (u32x4*)(SIDE + (size_t)it * RW_COLS);
        for (int ch = lane; ch < NCHUNK; ch += 64) dst[ch] = src[ch]; }
}
__device__ __forceinline__ void phase_mixB(bf16_t* __restrict__ RW, const bf16_t* __restrict__ SIDE, const float* __restrict__ mu, const float* __restrict__ k_k, float* __restrict__ KN, int bid, int nb) {
    const int tid = otid();
    for (int it = bid * 512 + tid; it < NSTRIP * NCHUNK; it += nb * 512) {
        const int sidx = it / NCHUNK, ch = it - sidx * NCHUNK, r0 = sidx * 32;
        const bool first = r0 < NLAT ? (r0 & (T - 1)) == 0 : ((r0 - NLAT) & (TC - 1)) == 0, last = r0 < NLAT ? ((r0 + 32) & (T - 1)) == 0 : ((r0 + 32 - NLAT) & (TC - 1)) == 0;
        const int act = (ch >= 192 && ch < 200) ? 1 : (ch >= 208 ? 2 : 0);
        const f32x4 mu0 = *(const f32x4*)(mu + 8 * ch), mu1 = *(const f32x4*)(mu + 8 * ch + 4); const float mm[8] = {mu0.x, mu0.y, mu0.z, mu0.w, mu1.x, mu1.y, mu1.z, mu1.w};
        const bool isk = ch >= 64 && ch < 128; const int kc = isk ? 8 * (ch - 64) : 0; const f32x4 kk0 = *(const f32x4*)(k_k + kc), kk1 = *(const f32x4*)(k_k + kc + 4); const float kkc[8] = {kk0.x, kk0.y, kk0.z, kk0.w, kk1.x, kk1.y, kk1.z, kk1.w};
        const u32x4 z = {0u, 0u, 0u, 0u};
        u32x4* col = (u32x4*)(RW + (size_t)r0 * RW_COLS + 8 * ch);
        u32x4 prev = first ? z : *(const u32x4*)(SIDE + ((size_t)(sidx - 1) * 2 + 1) * RW_COLS + 8 * ch);
        const u32x4 after = last ? z : *(const u32x4*)(SIDE + ((size_t)(sidx + 1) * 2) * RW_COLS + 8 * ch);
#pragma unroll 1
        for (int sb = 0; sb < 4; ++sb) { u32x4 rw[9];
#pragma unroll
            for (int j = 0; j < 8; ++j) rw[j] = col[(size_t)(sb * 8 + j) * NCHUNK];
            rw[8] = sb < 3 ? col[(size_t)(sb * 8 + 8) * NCHUNK] : after;
#pragma unroll
            for (int j = 0; j < 8; ++j) { float p_[8], m_[8], n_[8]; unpack8(rw[j], p_); unpack8(j == 0 ? prev : rw[j - 1], m_); unpack8(rw[j + 1], n_); float o[8];
#pragma unroll
                for (int e = 0; e < 8; ++e) { float v = p_[e] + mm[e] * (0.5f * (m_[e] + n_[e]) - p_[e]); o[e] = act == 1 ? ftanh(v) : act == 2 ? fsigmoid(v) : v; }
                u32x4 pk; pk.x = pk2(o[0], o[1]); pk.y = pk2(o[2], o[3]); pk.z = pk2(o[4], o[5]); pk.w = pk2(o[6], o[7]); col[(size_t)(sb * 8 + j) * NCHUNK] = pk;
                float ss = 0.f;
#pragma unroll
                for (int e = 0; e < 8; ++e) { const float kv = o[e] * kkc[e]; ss += kv * kv; }
                ss += __shfl_xor(ss, 1); ss += __shfl_xor(ss, 2); ss += __shfl_xor(ss, 4);
                if (isk && (ch & 7) == 0) KN[(size_t)(r0 + sb * 8 + j) * 8 + ((ch - 64) >> 3)] = 1.f / fmaxf(sqrtf(ss), 1e-12f); }
            prev = rw[7]; }
    }
}
__device__ __forceinline__ void phase_rwkv_seq2(const bf16_t* __restrict__ RW, const float* __restrict__ KN, bf16_t* __restrict__ Y0, bf16_t* __restrict__ Y1, const float* __restrict__ w0, const bf16_t* __restrict__ W2T,
                                                const float* __restrict__ a0, const bf16_t* __restrict__ A2T, const float* __restrict__ k_k, const float* __restrict__ k_a, unsigned char* lds, int bid, int nb) {
    const int tid0 = otid(), w = __builtin_amdgcn_readfirstlane(tid0 >> 6);
    constexpr int BUFB = 65536 + 8192 + 4096 + 256;
    for (int item = bid; item < 256; item += nb) {
        const int chain = item >> 1, vh = item & 1, b = chain >> 4, h = (chain >> 1) & 7, d = chain & 1;
        bf16_t* Yd = d ? Y1 : Y0;
        auto tok_row = [&](int cc, int j) -> size_t { const bool ic = cc < 4; const int ln = ic ? TC : T; const int ss = (ic ? cc * 64 : (cc - 4) * 64) + j, t = d == 0 ? ss : ln - 1 - ss; return (ic ? (size_t)NLAT + (size_t)b * TC : (size_t)b * T) + t; };
        auto prep = [&](int cc, int lane, int pw) {
            unsigned char* B_ = lds + (cc & 1) * BUFB; float* VEC = (float*)B_; float* VV = (float*)(B_ + 65536); float* PCV = (float*)(B_ + 65536 + 8192 + 4096);
            const int fr = lane & 15, fq = lane >> 4, i0 = 16 * pw + 4 * fq;
            { const int ptid = pw * 64 + lane, tk = ptid >> 2, part = ptid & 3; float v8[8]; unpack8(*(const u32x4*)(RW + tok_row(cc, tk) * RW_COLS + 1024 + h * 64 + vh * 32 + 8 * part), v8);
              *(f32x4*)(VV + tk * 32 + 8 * part) = (f32x4){v8[0], v8[1], v8[2], v8[3]}; *(f32x4*)(VV + tk * 32 + 8 * part + 4) = (f32x4){v8[4], v8[5], v8[6], v8[7]}; }
            bf16x8 bw[2], ba[2];
#pragma unroll
            for (int ks = 0; ks < 2; ++ks) { const size_t off = ((size_t)d * 512 + h * 64 + 16 * pw + fr) * 64 + ks * 32 + fq * 8; bw[ks] = *(const bf16x8*)(W2T + off); ba[ks] = *(const bf16x8*)(A2T + off); }
            const f32x4 w0c = *(const f32x4*)(w0 + d * 512 + h * 64 + i0), a0c = *(const f32x4*)(a0 + d * 512 + h * 64 + i0), kkc = *(const f32x4*)(k_k + h * 64 + i0), kac = *(const f32x4*)(k_a + h * 64 + i0);
            f32x4 run = {0.f, 0.f, 0.f, 0.f};
#pragma unroll 1
            for (int mt = 0; mt < 4; ++mt) {
                const int tk = 16 * mt + fr; const size_t row = tok_row(cc, tk); const bf16_t* p0 = RW + row * RW_COLS;
                f32x4 aw = {0.f, 0.f, 0.f, 0.f}, aa = {0.f, 0.f, 0.f, 0.f};
#pragma unroll
                for (int ks = 0; ks < 2; ++ks) { const bf16x8 fw = *(const bf16x8*)(p0 + 1536 + ks * 32 + fq * 8), fa = *(const bf16x8*)(p0 + 1600 + ks * 32 + fq * 8);
                    aw = __builtin_amdgcn_mfma_f32_16x16x32_bf16(bw[ks], fw, aw, 0, 0, 0); aa = __builtin_amdgcn_mfma_f32_16x16x32_bf16(ba[ks], fa, aa, 0, 0, 0); }
                const f32x4 r4 = ld_bf16x4(p0 + h * 64 + i0), k4 = ld_bf16x4(p0 + 512 + h * 64 + i0); const float inv = KN[row * 8 + h];
                f32x4 kkt, bt, kt, rt, tot;
#pragma unroll
                for (int r = 0; r < 4; ++r) { const float L = -0.6065306597126334f * fsigmoid(aw[r] + w0c[r]); float cs = L;
                    cs += dpp_mov<0x111>(cs); cs += dpp_mov<0x112>(cs); cs += dpp_mov<0x114>(cs); cs += dpp_mov<0x118>(cs);
                    tot[r] = __shfl(cs, (lane & 48) + 15);
                    const float cum = cs + run[r]; const float e1 = __expf(cum), ei = __builtin_amdgcn_rcpf(e1), e0 = __expf(cum - L);
                    const float a = fsigmoid(aa[r] + a0c[r]); const float kkn = k4[r] * kkc[r] * inv;
                    kkt[r] = kkn * e0; bt[r] = kkn * a * ei; kt[r] = k4[r] * (1.f + (a - 1.f) * kac[r]) * ei; rt[r] = r4[r] * e1; }
                run += tot;
                *(f32x4*)(VEC + (tk * 4 + 0) * 64 + i0) = kkt; *(f32x4*)(VEC + (tk * 4 + 1) * 64 + i0) = bt; *(f32x4*)(VEC + (tk * 4 + 2) * 64 + i0) = kt; *(f32x4*)(VEC + (tk * 4 + 3) * 64 + i0) = rt;
            }
            if (fr == 0) *(f32x4*)(PCV + i0) = (f32x4){__expf(run.x), __expf(run.y), __expf(run.z), __expf(run.w)};
        };
        auto yout = [&](int cc, int lane, int pw) { if (cc < 4) return; const bf16_t* YB = (const bf16_t*)(lds + (cc & 1) * BUFB + 65536 + 8192);
            const int ptid = pw * 64 + lane, tk = ptid >> 2, part = ptid & 3;
            *(u32x4*)(Yd + tok_row(cc, tk) * RWD + h * 64 + vh * 32 + 8 * part) = *(const u32x4*)(YB + tk * 32 + 8 * part); };
        f32x4 S = {0.f, 0.f, 0.f, 0.f}, S2 = {0.f, 0.f, 0.f, 0.f};
        __syncthreads();
        if (w >= 4) prep(0, tid0 & 63, w - 4);
        __syncthreads();
        for (int c = 0; c < 68; ++c) {
            int tid = tid0; asm volatile("" : "+v"(tid));
            const int lane = tid & 63;
            if (w < 4) {
                unsigned char* B_ = lds + (c & 1) * BUFB; const float* VEC = (const float*)B_; const float* VV = (const float*)(B_ + 65536); unsigned* YBw = (unsigned*)(B_ + 65536 + 8192); const float* PCV = (const float*)(B_ + 65536 + 8192 + 4096);
                const int sp = lane & 15, fq = lane >> 4, rA = w * 8 + fq * 2;
                const float* vp = VEC + 4 * sp; f32x4 kkv_ = *(const f32x4*)(vp), bv_ = *(const f32x4*)(vp + 64), kdv = *(const f32x4*)(vp + 128), rv = *(const f32x4*)(vp + 192); f32x2_ vv2 = *(const f32x2_*)(VV + rA);
                float a0_ = S.x, a1_ = S.y, a2_ = S.z, a3_ = S.w, b0_ = S2.x, b1_ = S2.y, b2_ = S2.z, b3_ = S2.w;
                f32x4 rpv = {0.f, 0.f, 0.f, 0.f};
                const bool o1 = sp & 1, o2 = sp & 2;
                auto yred = [&](const float (&yA)[4], const float (&yB)[4], int trow) {
                    float a_ = o1 ? yA[1] : yA[0], b_ = o1 ? yA[0] : yA[1], c_ = o1 ? yA[3] : yA[2], d_ = o1 ? yA[2] : yA[3];
                    float g_ = o1 ? yB[1] : yB[0], h_ = o1 ? yB[0] : yB[1], i_ = o1 ? yB[3] : yB[2], j_ = o1 ? yB[2] : yB[3];
                    a_ += dpp_mov<0xB1>(b_); g_ += dpp_mov<0xB1>(h_); c_ += dpp_mov<0xB1>(d_); i_ += dpp_mov<0xB1>(j_);
                    float e_ = o2 ? c_ : a_, f_ = o2 ? a_ : c_, k_ = o2 ? i_ : g_, l_ = o2 ? g_ : i_; e_ += dpp_mov<0x4E>(f_); k_ += dpp_mov<0x4E>(l_);
                    e_ += dpp_mov<0x124>(e_); k_ += dpp_mov<0x124>(k_); e_ += dpp_mov<0x128>(e_); k_ += dpp_mov<0x128>(k_);
                    const int tr = trow + sp; if (sp < 4 && tr >= 0) YBw[tr * 16 + (rA >> 1)] = pk2(e_, k_); };
#pragma unroll 1
                for (int t4 = 0; t4 < 64; t4 += 4) { float yA[4], yB[4];
#pragma unroll
                  for (int u = 0; u < 4; ++u) { const int t = t4 + u;
                    const int tn = t < 63 ? t + 1 : 63; const float* vn = VEC + tn * 256 + 4 * sp;
                    const f32x4 kkn_ = *(const f32x4*)(vn), bn = *(const f32x4*)(vn + 64), kdn = *(const f32x4*)(vn + 128), rn = *(const f32x4*)(vn + 192); const f32x2_ vvn = *(const f32x2_*)(VV + tn * 32 + rA);
                    asm volatile("" ::: "memory");
                    const float vva = vv2.x, vvb = vv2.y; float sa, sb, ya, yb;
                    asm volatile("v_mul_f32_e32 %0, %4, %12\n\tv_mul_f32_e32 %1, %8, %12\n\tv_fmac_f32_e32 %0, %5, %13\n\tv_fmac_f32_e32 %1, %9, %13\n\tv_fmac_f32_e32 %0, %6, %14\n\tv_fmac_f32_e32 %1, %10, %14\n\tv_fmac_f32_e32 %0, %7, %15\n\tv_fmac_f32_e32 %1, %11, %15\n\t"
                                 "v_mul_f32_e32 %2, %4, %16\n\tv_add_f32_dpp %0, %0, %0 quad_perm:[1,0,3,2] row_mask:0xf bank_mask:0xf bound_ctrl:1\n\tv_mul_f32_e32 %3, %8, %16\n\tv_add_f32_dpp %1, %1, %1 quad_perm:[1,0,3,2] row_mask:0xf bank_mask:0xf bound_ctrl:1\n\t"
                                 "v_fmac_f32_e32 %2, %5, %17\n\tv_add_f32_dpp %0, %0, %0 quad_perm:[2,3,0,1] row_mask:0xf bank_mask:0xf bound_ctrl:1\n\tv_fmac_f32_e32 %3, %9, %17\n\tv_add_f32_dpp %1, %1, %1 quad_perm:[2,3,0,1] row_mask:0xf bank_mask:0xf bound_ctrl:1\n\t"
                                 "v_fmac_f32_e32 %2, %6, %18\n\tv_add_f32_dpp %0, %0, %0 row_half_mirror row_mask:0xf bank_mask:0xf bound_ctrl:1\n\tv_fmac_f32_e32 %3, %10, %18\n\tv_add_f32_dpp %1, %1, %1 row_half_mirror row_mask:0xf bank_mask:0xf bound_ctrl:1\n\t"
                                 "v_fmac_f32_e32 %2, %7, %19\n\tv_add_f32_dpp %0, %0, %0 row_mirror row_mask:0xf bank_mask:0xf bound_ctrl:1\n\tv_fmac_f32_e32 %3, %11, %19\n\tv_add_f32_dpp %1, %1, %1 row_mirror row_mask:0xf bank_mask:0xf bound_ctrl:1\n\ts_nop 1"
                                 : "=&v"(sa), "=&v"(sb), "=&v"(ya), "=&v"(yb)
                                 : "v"(a0_), "v"(a1_), "v"(a2_), "v"(a3_), "v"(b0_), "v"(b1_), "v"(b2_), "v"(b3_), "v"(kkv_.x), "v"(kkv_.y), "v"(kkv_.z), "v"(kkv_.w), "v"(rpv.x), "v"(rpv.y), "v"(rpv.z), "v"(rpv.w));
                    yA[u] = ya; yB[u] = yb;
                    a0_ = fnma_s(bv_.x, sa, a0_); b0_ = fnma_s(bv_.x, sb, b0_); a1_ = fnma_s(bv_.y, sa, a1_); b1_ = fnma_s(bv_.y, sb, b1_); a2_ = fnma_s(bv_.z, sa, a2_); b2_ = fnma_s(bv_.z, sb, b2_); a3_ = fnma_s(bv_.w, sa, a3_); b3_ = fnma_s(bv_.w, sb, b3_);
                    a0_ = ffma_s(kdv.x, vva, a0_); b0_ = ffma_s(kdv.x, vvb, b0_); a1_ = ffma_s(kdv.y, vva, a1_); b1_ = ffma_s(kdv.y, vvb, b1_); a2_ = ffma_s(kdv.z, vva, a2_); b2_ = ffma_s(kdv.z, vvb, b2_); a3_ = ffma_s(kdv.w, vva, a3_); b3_ = ffma_s(kdv.w, vvb, b3_);
                    rpv = rv; kkv_ = kkn_; bv_ = bn; kdv = kdn; rv = rn; vv2 = vvn; }
                  yred(yA, yB, t4 - 1); }
                {
                  float ya = fmul_s(a0_, rpv.x), yb = fmul_s(b0_, rpv.x); ya = ffma_s(a1_, rpv.y, ya); yb = ffma_s(b1_, rpv.y, yb); ya = ffma_s(a2_, rpv.z, ya); yb = ffma_s(b2_, rpv.z, yb); ya = ffma_s(a3_, rpv.w, ya); yb = ffma_s(b3_, rpv.w, yb);
                  ya = red16(ya); yb = red16(yb); if (sp == 0) YBw[63 * 16 + (rA >> 1)] = pk2(ya, yb); }
                const f32x4 pc = *(const f32x4*)(PCV + 4 * sp); S = (f32x4){a0_ * pc.x, a1_ * pc.y, a2_ * pc.z, a3_ * pc.w}; S2 = (f32x4){b0_ * pc.x, b1_ * pc.y, b2_ * pc.z, b3_ * pc.w};
            } else {
                if (c >= 1) yout(c - 1, lane, w - 4);
                if (c + 1 < 68) prep(c + 1, lane, w - 4);
            }
            __syncthreads();
        }
        if (w >= 4) yout(67, tid0 & 63, w - 4);
    }
}
__device__ __forceinline__ void phase_rwkv_seq3(const bf16_t* __restrict__ RW, const float* __restrict__ KN, bf16_t* __restrict__ Y0, bf16_t* __restrict__ Y1, const float* __restrict__ w0, const bf16_t* __restrict__ W2T,
                                                const float* __restrict__ a0, const bf16_t* __restrict__ A2T, const float* __restrict__ k_k, const float* __restrict__ k_a, unsigned char* lds, int bid, int nb) {
    const int tid0 = otid(), w = __builtin_amdgcn_readfirstlane(tid0 >> 6);
    constexpr int CH = 32, NCH = (TC + T) / CH, NCX = TC / CH;
    constexpr int VSTR = 196;
    constexpr int A_BYTES = CH * VSTR * 4 + CH * 32 * 4 + 256;
    constexpr int B_BYTES = 3 * CH * 144 + 32 * 80;
    constexpr int C_BYTES = 32 * 144 + 32 * 144;
    constexpr int OFF_B = 2 * A_BYTES, OFF_C = OFF_B + 3 * B_BYTES;
    static_assert(OFF_C + 2 * C_BYTES <= 163584, "LDS");
    for (int item = bid; item < 256; item += nb) {
        const int chain = item >> 1, vh = item & 1, b = chain >> 4, h = (chain >> 1) & 7, d = chain & 1;
        bf16_t* Yd = d ? Y1 : Y0;
        auto tok_row = [&](int cc, int j) -> size_t { const bool ic = cc < NCX; const int ln = ic ? TC : T; const int ss = (ic ? cc : cc - NCX) * CH + j, t = d == 0 ? ss : ln - 1 - ss; return (ic ? (size_t)NLAT + (size_t)b * TC : (size_t)b * T) + t; };
        struct Raw { bf16x8 fw[2][2], fa[2][2], bw[2], ba[2]; u32x2 r4[2], k4[2], v; float inv[2]; f32x4 w0c, a0c, kkc, kac; };
        auto prep_load = [&](int cc, int lane, int pw, Raw& R) {
            const int fr = lane & 15, fq = lane >> 4, i0 = 16 * pw + 4 * fq;
            { const int ptid = pw * 64 + lane, tk = ptid >> 3, part = ptid & 7; R.v = *(const u32x2*)(RW + tok_row(cc, tk) * RW_COLS + 1024 + h * 64 + vh * 32 + 4 * part); }
#pragma unroll
            for (int mt = 0; mt < 2; ++mt) { const size_t row = tok_row(cc, 16 * mt + fr); const bf16_t* p0 = RW + row * RW_COLS;
#pragma unroll
                for (int ks = 0; ks < 2; ++ks) { R.fw[mt][ks] = *(const bf16x8*)(p0 + 1536 + ks * 32 + fq * 8); R.fa[mt][ks] = *(const bf16x8*)(p0 + 1600 + ks * 32 + fq * 8); }
                R.r4[mt] = *(const u32x2*)(p0 + h * 64 + i0); R.k4[mt] = *(const u32x2*)(p0 + 512 + h * 64 + i0); R.inv[mt] = KN[row * 8 + h]; }
#pragma unroll
            for (int ks = 0; ks < 2; ++ks) { const size_t off = ((size_t)d * 512 + h * 64 + 16 * pw + fr) * 64 + ks * 32 + fq * 8; R.bw[ks] = *(const bf16x8*)(W2T + off); R.ba[ks] = *(const bf16x8*)(A2T + off); }
            R.w0c = *(const f32x4*)(w0 + d * 512 + h * 64 + i0); R.a0c = *(const f32x4*)(a0 + d * 512 + h * 64 + i0); R.kkc = *(const f32x4*)(k_k + h * 64 + i0); R.kac = *(const f32x4*)(k_a + h * 64 + i0);
            asm volatile("" ::: "memory");
        };
        auto prep = [&](int cc, int lane, int pw, const Raw& R) {
            unsigned char* A_ = lds + (cc & 1) * A_BYTES; float* VEC = (float*)A_; float* VV = (float*)(A_ + CH * VSTR * 4); float* PCV = (float*)(A_ + CH * VSTR * 4 + CH * 32 * 4);
            bf16_t* RBp = (bf16_t*)(lds + OFF_B + (cc % 3) * B_BYTES); bf16_t* KBp = RBp + CH * 72; bf16_t* BBp = KBp + CH * 72; bf16_t* VTp = BBp + CH * 72;
            const int fr = lane & 15, fq = lane >> 4, i0 = 16 * pw + 4 * fq;
            { const int ptid = pw * 64 + lane, tk = ptid >> 3, part = ptid & 7; const u32x2 raw = R.v;
              *(f32x4*)(VV + tk * 32 + 4 * part) = (f32x4){__builtin_bit_cast(float, raw.x << 16), __builtin_bit_cast(float, raw.x & 0xffff0000u), __builtin_bit_cast(float, raw.y << 16), __builtin_bit_cast(float, raw.y & 0xffff0000u)};
              bf16_t* vt = VTp + (4 * part) * 40 + tk; vt[0] = (bf16_t)raw.x; vt[40] = (bf16_t)(raw.x >> 16); vt[80] = (bf16_t)raw.y; vt[120] = (bf16_t)(raw.y >> 16); }
            const f32x4 w0c = R.w0c, a0c = R.a0c, kkc = R.kkc, kac = R.kac;
            f32x4 run = {0.f, 0.f, 0.f, 0.f};
#pragma unroll
            for (int mt = 0; mt < 2; ++mt) {
                const int tk = 16 * mt + fr;
                f32x4 aw = {0.f, 0.f, 0.f, 0.f}, aa = {0.f, 0.f, 0.f, 0.f};
#pragma unroll
                for (int ks = 0; ks < 2; ++ks) { aw = __builtin_amdgcn_mfma_f32_16x16x32_bf16(R.bw[ks], R.fw[mt][ks], aw, 0, 0, 0); aa = __builtin_amdgcn_mfma_f32_16x16x32_bf16(R.ba[ks], R.fa[mt][ks], aa, 0, 0, 0); }
                const u32x2 rr = R.r4[mt], kr = R.k4[mt];
                const f32x4 r4 = {__builtin_bit_cast(float, rr.x << 16), __builtin_bit_cast(float, rr.x & 0xffff0000u), __builtin_bit_cast(float, rr.y << 16), __builtin_bit_cast(float, rr.y & 0xffff0000u)};
                const f32x4 k4 = {__builtin_bit_cast(float, kr.x << 16), __builtin_bit_cast(float, kr.x & 0xffff0000u), __builtin_bit_cast(float, kr.y << 16), __builtin_bit_cast(float, kr.y & 0xffff0000u)};
                const float inv = R.inv[mt];
                f32x4 kkt, bt, kt, rt, tot;
#pragma unroll
                for (int r = 0; r < 4; ++r) { const float L = -0.6065306597126334f * fsigmoid(aw[r] + w0c[r]); float cs = L;
                    cs += dpp_mov<0x111>(cs); cs += dpp_mov<0x112>(cs); cs += dpp_mov<0x114>(cs); cs += dpp_mov<0x118>(cs);
                    tot[r] = __shfl(cs, (lane & 48) + 15);
                    const float cum = cs + run[r]; const float e1 = __expf(cum), ei = __builtin_amdgcn_rcpf(e1), e0 = __expf(cum - L);
                    const float a = fsigmoid(aa[r] + a0c[r]); const float kkn = k4[r] * kkc[r] * inv;
                    kkt[r] = kkn * e0; bt[r] = kkn * a * ei; kt[r] = k4[r] * (1.f + (a - 1.f) * kac[r]) * ei; rt[r] = r4[r] * e1; }
                run += tot;
                float* vp = VEC + tk * VSTR + i0; *(f32x4*)(vp) = kkt; *(f32x4*)(vp + 64) = bt; *(f32x4*)(vp + 128) = kt;
                *(u32x2*)(RBp + tk * 72 + i0) = (u32x2){pk2(rt.x, rt.y), pk2(rt.z, rt.w)}; *(u32x2*)(KBp + tk * 72 + i0) = (u32x2){pk2(kt.x, kt.y), pk2(kt.z, kt.w)}; *(u32x2*)(BBp + tk * 72 + i0) = (u32x2){pk2(bt.x, bt.y), pk2(bt.z, bt.w)};
            }
            if (fr == 0) *(f32x4*)(PCV + i0) = (f32x4){__expf(run.x), __expf(run.y), __expf(run.z), __expf(run.w)};
        };
        auto ycomp = [&](int cc, int lane, int pw) {
            if (cc < NCX) return;
            const bf16_t* RBp = (const bf16_t*)(lds + OFF_B + (cc % 3) * B_BYTES); const bf16_t* KBp = RBp + CH * 72; const bf16_t* BBp = KBp + CH * 72; const bf16_t* VTp = BBp + CH * 72;
            const float* SAF = (const float*)(lds + OFF_C + (cc & 1) * C_BYTES); const bf16_t* S0B = (const bf16_t*)(lds + OFF_C + (cc & 1) * C_BYTES + 32 * 144);
            const int fr = lane & 15, q = lane >> 4, mt = pw >> 1, nt = pw & 1;
            const bf16x8 r0 = *(const bf16x8*)(RBp + (16 * mt + fr) * 72 + 8 * q), r1 = *(const bf16x8*)(RBp + (16 * mt + fr) * 72 + 32 + 8 * q);
            const f32x4 z4 = {0.f, 0.f, 0.f, 0.f};
            f32x4 gk0, gb0, gk1 = z4, gb1 = z4;
            { const bf16x8 k0 = *(const bf16x8*)(KBp + fr * 72 + 8 * q), k1 = *(const bf16x8*)(KBp + fr * 72 + 32 + 8 * q), b0 = *(const bf16x8*)(BBp + fr * 72 + 8 * q), b1 = *(const bf16x8*)(BBp + fr * 72 + 32 + 8 * q);
              gk0 = __builtin_amdgcn_mfma_f32_16x16x32_bf16(k0, r0, z4, 0, 0, 0); gk0 = __builtin_amdgcn_mfma_f32_16x16x32_bf16(k1, r1, gk0, 0, 0, 0);
              gb0 = __builtin_amdgcn_mfma_f32_16x16x32_bf16(b0, r0, z4, 0, 0, 0); gb0 = __builtin_amdgcn_mfma_f32_16x16x32_bf16(b1, r1, gb0, 0, 0, 0); }
            if (mt == 1) {
              const bf16x8 k0 = *(const bf16x8*)(KBp + (16 + fr) * 72 + 8 * q), k1 = *(const bf16x8*)(KBp + (16 + fr) * 72 + 32 + 8 * q), b0 = *(const bf16x8*)(BBp + (16 + fr) * 72 + 8 * q), b1 = *(const bf16x8*)(BBp + (16 + fr) * 72 + 32 + 8 * q);
              gk1 = __builtin_amdgcn_mfma_f32_16x16x32_bf16(k0, r0, z4, 0, 0, 0); gk1 = __builtin_amdgcn_mfma_f32_16x16x32_bf16(k1, r1, gk1, 0, 0, 0);
              gb1 = __builtin_amdgcn_mfma_f32_16x16x32_bf16(b0, r0, z4, 0, 0, 0); gb1 = __builtin_amdgcn_mfma_f32_16x16x32_bf16(b1, r1, gb1, 0, 0, 0);
#pragma unroll
              for (int r = 0; r < 4; ++r) { const bool keep = 4 * q + r <= fr; gk1[r] = keep ? gk1[r] : 0.f; gb1[r] = keep ? gb1[r] : 0.f; }
            } else {
#pragma unroll
              for (int r = 0; r < 4; ++r) { const bool keep = 4 * q + r <= fr; gk0[r] = keep ? gk0[r] : 0.f; gb0[r] = keep ? gb0[r] : 0.f; }
            }
            const u32x4 gkp = {pk2(gk0[0], gk0[1]), pk2(gk0[2], gk0[3]), pk2(gk1[0], gk1[1]), pk2(gk1[2], gk1[3])};
            const u32x4 gbp = {pk2(-gb0[0], -gb0[1]), pk2(-gb0[2], -gb0[3]), pk2(-gb1[0], -gb1[1]), pk2(-gb1[2], -gb1[3])};
            const int ri = 16 * nt + fr;
            const u32x2 v0 = *(const u32x2*)(VTp + ri * 40 + 4 * q), v1 = *(const u32x2*)(VTp + ri * 40 + 16 + 4 * q);
            const f32x4 s0 = *(const f32x4*)(SAF + ri * 36 + 4 * q), s1 = *(const f32x4*)(SAF + ri * 36 + 16 + 4 * q);
            const u32x4 vtp = {v0.x, v0.y, v1.x, v1.y}, sap = {pk2(s0.x, s0.y), pk2(s0.z, s0.w), pk2(s1.x, s1.y), pk2(s1.z, s1.w)};
            const bf16x8 z0 = *(const bf16x8*)(S0B + ri * 72 + 8 * q), z1 = *(const bf16x8*)(S0B + ri * 72 + 32 + 8 * q);
            f32x4 y = __builtin_amdgcn_mfma_f32_16x16x32_bf16(__builtin_bit_cast(bf16x8, vtp), __builtin_bit_cast(bf16x8, gkp), z4, 0, 0, 0);
            y = __builtin_amdgcn_mfma_f32_16x16x32_bf16(__builtin_bit_cast(bf16x8, sap), __builtin_bit_cast(bf16x8, gbp), y, 0, 0, 0);
            y = __builtin_amdgcn_mfma_f32_16x16x32_bf16(z0, r0, y, 0, 0, 0); y = __builtin_amdgcn_mfma_f32_16x16x32_bf16(z1, r1, y, 0, 0, 0);
            *(u32x2*)(Yd + tok_row(cc, 16 * mt + fr) * RWD + h * 64 + vh * 32 + 16 * nt + 4 * q) = (u32x2){pk2(y[0], y[1]), pk2(y[2], y[3])};
        };
        f32x4 S = {0.f, 0.f, 0.f, 0.f}, S2 = {0.f, 0.f, 0.f, 0.f};
        __syncthreads();
        if (w >= 4) { Raw raw; prep_load(0, tid0 & 63, w - 4, raw); prep(0, tid0 & 63, w - 4, raw); }
        __syncthreads();
        for (int c = 0; c < NCH; ++c) {
            int tid = tid0; asm volatile("" : "+v"(tid));
            const int lane = tid & 63;
            if (w < 4) {
                const unsigned char* A_ = lds + (c & 1) * A_BYTES; const float* VEC = (const float*)A_; const float* VV = (const float*)(A_ + CH * VSTR * 4); const float* PCV = (const float*)(A_ + CH * VSTR * 4 + CH * 32 * 4);
                float* SAF = (float*)(lds + OFF_C + (c & 1) * C_BYTES); bf16_t* S0B = (bf16_t*)(lds + OFF_C + (c & 1) * C_BYTES + 32 * 144);
                const int sp = lane & 15, fq = lane >> 4, rA = w * 8 + fq * 2;
                *(u32x2*)(S0B + rA * 72 + 4 * sp) = (u32x2){pk2(S.x, S.y), pk2(S.z, S.w)}; *(u32x2*)(S0B + (rA + 1) * 72 + 4 * sp) = (u32x2){pk2(S2.x, S2.y), pk2(S2.z, S2.w)};
                unsigned saw = (unsigned)(size_t)(LAS float*)(SAF + rA * 36); asm volatile("" : "+v"(saw));
                const unsigned long long m_sp0 = __ballot(sp == 0);
                const float* vp = VEC + 4 * sp; f32x4 kkv_ = *(const f32x4*)(vp), bv_ = *(const f32x4*)(vp + 64), kdv = *(const f32x4*)(vp + 128); f32x2_ vv2 = *(const f32x2_*)(VV + rA);
                float a0_ = S.x, a1_ = S.y, a2_ = S.z, a3_ = S.w, b0_ = S2.x, b1_ = S2.y, b2_ = S2.z, b3_ = S2.w;
#pragma unroll 1
                for (int t4 = 0; t4 < CH; t4 += 4) {
#pragma unroll
                  for (int u = 0; u < 4; ++u) { const int t = t4 + u;
                    const int tn = t < CH - 1 ? t + 1 : CH - 1; const float* vn = VEC + tn * VSTR + 4 * sp;
                    const f32x4 kkn_ = *(const f32x4*)(vn), bn = *(const f32x4*)(vn + 64), kdn = *(const f32x4*)(vn + 128); const f32x2_ vvn = *(const f32x2_*)(VV + tn * 32 + rA);
                    asm volatile("" ::: "memory");
                    const float vva = vv2.x, vvb = vv2.y; float sa, sb;
                    asm volatile("v_mul_f32_e32 %8, %0, %10\n\tv_mul_f32_e32 %9, %4, %10\n\tv_fmac_f32_e32 %8, %1, %11\n\tv_fmac_f32_e32 %9, %5, %11\n\tv_fmac_f32_e32 %8, %2, %12\n\tv_fmac_f32_e32 %9, %6, %12\n\tv_fmac_f32_e32 %8, %3, %13\n\tv_fmac_f32_e32 %9, %7, %13\n\t"
                                 "v_fmac_f32_e32 %0, %14, %18\n\tv_add_f32_dpp %8, %8, %8 quad_perm:[1,0,3,2] row_mask:0xf bank_mask:0xf bound_ctrl:1\n\tv_fmac_f32_e32 %4, %14, %19\n\tv_add_f32_dpp %9, %9, %9 quad_perm:[1,0,3,2] row_mask:0xf bank_mask:0xf bound_ctrl:1\n\t"
                                 "v_fmac_f32_e32 %1, %15, %18\n\tv_add_f32_dpp %8, %8, %8 quad_perm:[2,3,0,1] row_mask:0xf bank_mask:0xf bound_ctrl:1\n\tv_fmac_f32_e32 %5, %15, %19\n\tv_add_f32_dpp %9, %9, %9 quad_perm:[2,3,0,1] row_mask:0xf bank_mask:0xf bound_ctrl:1\n\t"
                                 "v_fmac_f32_e32 %2, %16, %18\n\tv_add_f32_dpp %8, %8, %8 row_half_mirror row_mask:0xf bank_mask:0xf bound_ctrl:1\n\tv_fmac_f32_e32 %6, %16, %19\n\tv_add_f32_dpp %9, %9, %9 row_half_mirror row_mask:0xf bank_mask:0xf bound_ctrl:1\n\t"
                                 "v_fmac_f32_e32 %3, %17, %18\n\tv_add_f32_dpp %8, %8, %8 row_mirror row_mask:0xf bank_mask:0xf bound_ctrl:1\n\tv_fmac_f32_e32 %7, %17, %19\n\tv_add_f32_dpp %9, %9, %9 row_mirror row_mask:0xf bank_mask:0xf bound_ctrl:1"
                                 : "+v"(a0_), "+v"(a1_), "+v"(a2_), "+v"(a3_), "+v"(b0_), "+v"(b1_), "+v"(b2_), "+v"(b3_), "=&v"(sa), "=&v"(sb)
                                 : "v"(kkv_.x), "v"(kkv_.y), "v"(kkv_.z), "v"(kkv_.w), "v"(kdv.x), "v"(kdv.y), "v"(kdv.z), "v"(kdv.w), "v"(vva), "v"(vvb));
                    asm volatile("s_mov_b64 exec, %3\n\tds_write2_b32 %0, %1, %2 offset0:%4 offset1:%5\n\ts_mov_b64 exec, -1" :: "v"(saw + 4 * t4), "v"(sa), "v"(sb), "s"(m_sp0), "n"(u), "n"(36 + u) : "memory");
                    a0_ = fnma_s(bv_.x, sa, a0_); b0_ = fnma_s(bv_.x, sb, b0_); a1_ = fnma_s(bv_.y, sa, a1_); b1_ = fnma_s(bv_.y, sb, b1_); a2_ = fnma_s(bv_.z, sa, a2_); b2_ = fnma_s(bv_.z, sb, b2_); a3_ = fnma_s(bv_.w, sa, a3_); b3_ = fnma_s(bv_.w, sb, b3_);
                    kkv_ = kkn_; bv_ = bn; kdv = kdn; vv2 = vvn; }
                }
                const f32x4 pc = *(const f32x4*)(PCV + 4 * sp); S = (f32x4){a0_ * pc.x, a1_ * pc.y, a2_ * pc.z, a3_ * pc.w}; S2 = (f32x4){b0_ * pc.x, b1_ * pc.y, b2_ * pc.z, b3_ * pc.w};
            } else {
                Raw raw; prep_load(c + 1 < NCH ? c + 1 : NCH - 1, lane, w - 4, raw);
                if (c >= 1) ycomp(c - 1, lane, w - 4);
                if (c + 1 < NCH) prep(c + 1, lane, w - 4, raw);
            }
            __syncthreads();
        }
        if (w >= 4) ycomp(NCH - 1, tid0 & 63, w - 4);
    }
}
__device__ __forceinline__ void phase_rwkv_full(const bf16_t* __restrict__ RW, const float* __restrict__ KN, bf16_t* __restrict__ Y0, bf16_t* __restrict__ Y1, const float* __restrict__ w0, const bf16_t* __restrict__ W2T,
                                                const float* __restrict__ a0, const bf16_t* __restrict__ A2T, const float* __restrict__ k_k, const float* __restrict__ k_a,
                                                const float* __restrict__ mw1, const float* __restrict__ mw3, const float* __restrict__ mw2, bf16_t* __restrict__ W13, bf16_t* __restrict__ W2, unsigned char* lds, int bid, int nb) {
    const int tid0 = otid(), w = __builtin_amdgcn_readfirstlane(tid0 >> 6);
    constexpr int CH = 32, NCH = (TC + T) / CH, NCX = TC / CH;
    constexpr int A_BYTES = 256;
    constexpr int B_BYTES = 3 * CH * 144 + 64 * 80;
    constexpr int E_BYTES = CH * 144 + 2 * 64 * 80;
    constexpr int C_BYTES = 64 * 80 + 64 * 144;
    constexpr int D_BYTES = 5 * CH * 144 + 128;
    constexpr int OFF_B = 2 * A_BYTES, OFF_C = OFF_B + 3 * B_BYTES, OFF_D = OFF_C + 2 * C_BYTES, OFF_E = OFF_D + 2 * D_BYTES;
    static_assert(OFF_E + 2 * E_BYTES <= 163584, "LDS");
    for (int item = bid; item < 128; item += nb) {
        const int chain = item, b = chain >> 4, h = (chain >> 1) & 7, d = chain & 1;
        bf16_t* Yd = d ? Y1 : Y0;
        auto tok_row = [&](int cc, int j) -> size_t { const bool ic = cc < NCX; const int ln = ic ? TC : T; const int ss = (ic ? cc : cc - NCX) * CH + j, t = d == 0 ? ss : ln - 1 - ss; return (ic ? (size_t)NLAT + (size_t)b * TC : (size_t)b * T) + t; };
        auto tok_ri = [&](int cc, int j) -> unsigned { const bool ic = cc < NCX; const int ln = ic ? TC : T; const int ss = (ic ? cc : cc - NCX) * CH + j, t = d == 0 ? ss : ln - 1 - ss; return (unsigned)((ic ? NLAT + b * TC : b * T) + t); };
        struct RawL { u32x4 p[20]; float kn; };
        auto ld_issue = [&](int cc, int lane, RawL& R) {
            const char* RWb = (const char*)RW;
#pragma unroll
            for (int it = 0; it < 8; ++it) { const int tok = it * 4 + (lane >> 4), p = lane & 15; R.p[it] = *(const u32x4*)(RWb + (tok_ri(cc, tok) * (unsigned)(RW_COLS * 2) + (unsigned)(3072 + 16 * p))); }
#pragma unroll
            for (int it = 0; it < 4; ++it) { const int tok = it * 8 + (lane >> 3), p = lane & 7; const unsigned o_ = tok_ri(cc, tok) * (unsigned)(RW_COLS * 2) + (unsigned)(h * 128 + 16 * p); R.p[8 + it] = *(const u32x4*)(RWb + o_); R.p[12 + it] = *(const u32x4*)(RWb + (o_ + 1024u)); }
#pragma unroll
            for (int it = 0; it < 4; ++it) { const int tok = it * 8 + (lane >> 3), p = lane & 7; R.p[16 + it] = *(const u32x4*)(RWb + (tok_ri(cc, tok) * (unsigned)(RW_COLS * 2) + (unsigned)(2048 + h * 128 + 16 * p))); }
            R.kn = *(const float*)((const char*)KN + (tok_ri(cc, lane & 31) * 32u + (unsigned)(h * 4)));
            asm volatile("" ::: "memory");
        };
        auto ld_commit = [&](int cc, int lane, const RawL& R) {
            bf16_t* WD = (bf16_t*)(lds + OFF_D + (cc & 1) * D_BYTES); bf16_t* RI = WD + 2 * CH * 72; bf16_t* KI = RI + CH * 72; bf16_t* VI = KI + CH * 72; float* KNs = (float*)(VI + CH * 72);
#pragma unroll
            for (int it = 0; it < 8; ++it) { const int tok = it * 4 + (lane >> 4), p = lane & 15; *(u32x4*)(WD + (p >> 3) * (CH * 72) + tok * 72 + 8 * (p & 7)) = R.p[it]; }
#pragma unroll
            for (int it = 0; it < 4; ++it) { const int tok = it * 8 + (lane >> 3), p = lane & 7; *(u32x4*)(RI + tok * 72 + 8 * p) = R.p[8 + it]; *(u32x4*)(KI + tok * 72 + 8 * p) = R.p[12 + it]; }
#pragma unroll
            for (int it = 0; it < 4; ++it) { const int tok = it * 8 + (lane >> 3), p = lane & 7; *(u32x4*)(VI + tok * 72 + 8 * p) = R.p[16 + it]; }
            if (lane < 32) KNs[lane] = R.kn;
        };
        auto wt_src = [&](int it, int& k0, int& n0, int& rmul, int& radd, bf16_t*& dst) -> const float* {
            const int m = it >> 12, r = it & 4095, e = r >> 8, tt = r & 255; k0 = (tt >> 4) * 64; n0 = (tt & 15) * 64;
            const float* src = (m == 0 ? mw1 : m == 1 ? mw3 : mw2) + (size_t)e * 1024 * 1024; rmul = m == 2 ? 4 : 8; radd = m == 1 ? 4 : 0; dst = m == 2 ? W2 + (size_t)e * 1024 * 1024 : W13 + (size_t)e * 2048 * 1024;
            return src + (size_t)k0 * 1024 + n0; };
        auto wt_issue = [&](int it, int lane, float (&v)[64]) { int k0, n0, rmul, radd; bf16_t* dst; const float* sp = wt_src(it, k0, n0, rmul, radd, dst); const unsigned lo = (unsigned)lane * 4u;
            const unsigned long long pb = (unsigned long long)sp; const __attribute__((address_space(1))) char* sb = (const __attribute__((address_space(1))) char*)(((unsigned long long)(unsigned)__builtin_amdgcn_readfirstlane((int)(pb >> 32)) << 32) | (unsigned)__builtin_amdgcn_readfirstlane((int)pb));
#pragma unroll
            for (int i = 0; i < 64; ++i) v[i] = *(const __attribute__((address_space(1))) float*)(sb + ((unsigned)(i * 4096) + lo));
            asm volatile("" ::: "memory"); };
        auto wt_finish = [&](int it, int lane, const float (&v)[64]) { int k0, n0, rmul, radd; bf16_t* dst; (void)wt_src(it, k0, n0, rmul, radd, dst);
            const int nn = n0 + lane, row = (nn >> 2) * rmul + (nn & 3) + radd; bf16_t* dp = dst + (size_t)row * 1024 + k0;
#pragma unroll
            for (int c = 0; c < 8; ++c) { u32x4 o; o.x = pk2(v[8 * c], v[8 * c + 1]); o.y = pk2(v[8 * c + 2], v[8 * c + 3]); o.z = pk2(v[8 * c + 4], v[8 * c + 5]); o.w = pk2(v[8 * c + 6], v[8 * c + 7]); *(u32x4*)(dp + 8 * c) = o; } };
        struct PCst { bf16x8 bw[2], ba[2]; f32x4 w0c, a0c, kkc, kac; };
        PCst PC_;
        if (w >= 4) { const int lane = tid0 & 63, pw = w - 4, fr = lane & 15, fq = lane >> 4, i0 = 16 * pw + 4 * fq;
#pragma unroll
            for (int ks = 0; ks < 2; ++ks) { const size_t off = ((size_t)d * 512 + h * 64 + 16 * pw + fr) * 64 + ks * 32 + fq * 8; PC_.bw[ks] = *(const bf16x8*)(W2T + off); PC_.ba[ks] = *(const bf16x8*)(A2T + off); }
            PC_.w0c = *(const f32x4*)(w0 + d * 512 + h * 64 + i0); PC_.a0c = *(const f32x4*)(a0 + d * 512 + h * 64 + i0); PC_.kkc = *(const f32x4*)(k_k + h * 64 + i0); PC_.kac = *(const f32x4*)(k_a + h * 64 + i0); }
        auto prep = [&](int cc, int lane, int pw) {
            float* PCV = (float*)(lds + (cc & 1) * A_BYTES);
            const bf16_t* WD = (const bf16_t*)(lds + OFF_D + (cc & 1) * D_BYTES); const bf16_t* AD = WD + CH * 72; const bf16_t* RI = AD + CH * 72; const bf16_t* KI = RI + CH * 72; const bf16_t* VI = KI + CH * 72; const float* KNs = (const float*)(VI + CH * 72);
            bf16_t* RBp = (bf16_t*)(lds + OFF_B + (cc % 3) * B_BYTES); bf16_t* KBp = RBp + CH * 72; bf16_t* BBp = KBp + CH * 72; bf16_t* VTp = BBp + CH * 72; bf16_t* KKp = (bf16_t*)(lds + OFF_E + (cc & 1) * E_BYTES); bf16_t* KTp = KKp + CH * 72; bf16_t* BTp = KTp + 64 * 40;
            const int fr = lane & 15, fq = lane >> 4, i0 = 16 * pw + 4 * fq;
            { const int ptid = pw * 64 + lane, tk = ptid >> 3, part = ptid & 7; const u32x4 raw = *(const u32x4*)(VI + tk * 72 + 8 * part);
              bf16_t* vt = VTp + (8 * part) * 40 + tk; vt[0] = (bf16_t)raw.x; vt[40] = (bf16_t)(raw.x >> 16); vt[80] = (bf16_t)raw.y; vt[120] = (bf16_t)(raw.y >> 16); vt[160] = (bf16_t)raw.z; vt[200] = (bf16_t)(raw.z >> 16); vt[240] = (bf16_t)raw.w; vt[280] = (bf16_t)(raw.w >> 16); }
            const f32x4 w0c = PC_.w0c, a0c = PC_.a0c, kkc = PC_.kkc, kac = PC_.kac;
            f32x4 run = {0.f, 0.f, 0.f, 0.f};
#pragma unroll
            for (int mt = 0; mt < 2; ++mt) {
                const int tk = 16 * mt + fr;
                f32x4 aw = {0.f, 0.f, 0.f, 0.f}, aa = {0.f, 0.f, 0.f, 0.f};
#pragma unroll
                for (int ks = 0; ks < 2; ++ks) { const bf16x8 fw = *(const bf16x8*)(WD + tk * 72 + ks * 32 + fq * 8), fa = *(const bf16x8*)(AD + tk * 72 + ks * 32 + fq * 8);
                    aw = __builtin_amdgcn_mfma_f32_16x16x32_bf16(PC_.bw[ks], fw, aw, 0, 0, 0); aa = __builtin_amdgcn_mfma_f32_16x16x32_bf16(PC_.ba[ks], fa, aa, 0, 0, 0); }
                const u32x2 rr = *(const u32x2*)(RI + tk * 72 + i0), kr = *(const u32x2*)(KI + tk * 72 + i0);
                const f32x4 r4 = {__builtin_bit_cast(float, rr.x << 16), __builtin_bit_cast(float, rr.x & 0xffff0000u), __builtin_bit_cast(float, rr.y << 16), __builtin_bit_cast(float, rr.y & 0xffff0000u)};
                const f32x4 k4 = {__builtin_bit_cast(float, kr.x << 16), __builtin_bit_cast(float, kr.x & 0xffff0000u), __builtin_bit_cast(float, kr.y << 16), __builtin_bit_cast(float, kr.y & 0xffff0000u)};
                const float inv = KNs[tk];
                f32x4 kkt, bt, kt, rt, tot;
#pragma unroll
                for (int r = 0; r < 4; ++r) { const float L = -0.6065306597126334f * fsigmoid(aw[r] + w0c[r]); float cs = L;
                    cs += dpp_mov<0x111>(cs); cs += dpp_mov<0x112>(cs); cs += dpp_mov<0x114>(cs); cs += dpp_mov<0x118>(cs);
                    tot[r] = __shfl(cs, (lane & 48) + 15);
                    const float cum = cs + run[r]; const float e1 = __expf(cum), ei = __builtin_amdgcn_rcpf(e1), e0 = __expf(cum - L);
                    const float a = fsigmoid(aa[r] + a0c[r]); const float kkn = k4[r] * kkc[r] * inv;
                    kkt[r] = kkn * e0; bt[r] = kkn * a * ei; kt[r] = k4[r] * (1.f + (a - 1.f) * kac[r]) * ei; rt[r] = r4[r] * e1; }
                run += tot;
                const u32x2 kp = {pk2(kt.x, kt.y), pk2(kt.z, kt.w)}, bp = {pk2(bt.x, bt.y), pk2(bt.z, bt.w)};
                *(u32x2*)(RBp + tk * 72 + i0) = (u32x2){pk2(rt.x, rt.y), pk2(rt.z, rt.w)}; *(u32x2*)(KBp + tk * 72 + i0) = kp; *(u32x2*)(BBp + tk * 72 + i0) = bp; *(u32x2*)(KKp + tk * 72 + i0) = (u32x2){pk2(kkt.x, kkt.y), pk2(kkt.z, kkt.w)};
                bf16_t* ktc = KTp + i0 * 40 + tk; ktc[0] = (bf16_t)kp.x; ktc[40] = (bf16_t)(kp.x >> 16); ktc[80] = (bf16_t)kp.y; ktc[120] = (bf16_t)(kp.y >> 16);
                bf16_t* btc = BTp + i0 * 40 + tk; btc[0] = (bf16_t)bp.x; btc[40] = (bf16_t)(bp.x >> 16); btc[80] = (bf16_t)bp.y; btc[120] = (bf16_t)(bp.y >> 16);
            }
            if (fr == 0) *(f32x4*)(PCV + i0) = (f32x4){__expf(run.x), __expf(run.y), __expf(run.z), __expf(run.w)};
        };
        auto ycomp1 = [&](int cc, int lane, int mt) {
            const bf16_t* RBp = (const bf16_t*)(lds + OFF_B + (cc % 3) * B_BYTES); const bf16_t* KBp = RBp + CH * 72; const bf16_t* BBp = KBp + CH * 72; const bf16_t* VTp = BBp + CH * 72;
            const bf16_t* SAF = (const bf16_t*)(lds + OFF_C + (cc & 1) * C_BYTES); const bf16_t* S0B = (const bf16_t*)(lds + OFF_C + (cc & 1) * C_BYTES + 64 * 80);
            const int fr = lane & 15, q = lane >> 4;
            const bf16x8 r0 = *(const bf16x8*)(RBp + (16 * mt + fr) * 72 + 8 * q), r1 = *(const bf16x8*)(RBp + (16 * mt + fr) * 72 + 32 + 8 * q);
            const f32x4 z4 = {0.f, 0.f, 0.f, 0.f};
            f32x4 gk0, gb0, gk1 = z4, gb1 = z4;
            { const bf16x8 k0 = *(const bf16x8*)(KBp + fr * 72 + 8 * q), k1 = *(const bf16x8*)(KBp + fr * 72 + 32 + 8 * q), b0 = *(const bf16x8*)(BBp + fr * 72 + 8 * q), b1 = *(const bf16x8*)(BBp + fr * 72 + 32 + 8 * q);
              gk0 = __builtin_amdgcn_mfma_f32_16x16x32_bf16(k0, r0, z4, 0, 0, 0); gk0 = __builtin_amdgcn_mfma_f32_16x16x32_bf16(k1, r1, gk0, 0, 0, 0);
              gb0 = __builtin_amdgcn_mfma_f32_16x16x32_bf16(b0, r0, z4, 0, 0, 0); gb0 = __builtin_amdgcn_mfma_f32_16x16x32_bf16(b1, r1, gb0, 0, 0, 0); }
            if (mt == 1) {
              const bf16x8 k0 = *(const bf16x8*)(KBp + (16 + fr) * 72 + 8 * q), k1 = *(const bf16x8*)(KBp + (16 + fr) * 72 + 32 + 8 * q), b0 = *(const bf16x8*)(BBp + (16 + fr) * 72 + 8 * q), b1 = *(const bf16x8*)(BBp + (16 + fr) * 72 + 32 + 8 * q);
              gk1 = __builtin_amdgcn_mfma_f32_16x16x32_bf16(k0, r0, z4, 0, 0, 0); gk1 = __builtin_amdgcn_mfma_f32_16x16x32_bf16(k1, r1, gk1, 0, 0, 0);
              gb1 = __builtin_amdgcn_mfma_f32_16x16x32_bf16(b0, r0, z4, 0, 0, 0); gb1 = __builtin_amdgcn_mfma_f32_16x16x32_bf16(b1, r1, gb1, 0, 0, 0);
#pragma unroll
              for (int r = 0; r < 4; ++r) { const bool keep = 4 * q + r <= fr; gk1[r] = keep ? gk1[r] : 0.f; gb1[r] = keep ? gb1[r] : 0.f; }
            } else {
#pragma unroll
              for (int r = 0; r < 4; ++r) { const bool keep = 4 * q + r <= fr; gk0[r] = keep ? gk0[r] : 0.f; gb0[r] = keep ? gb0[r] : 0.f; }
            }
            const u32x4 gkp = {pk2(gk0[0], gk0[1]), pk2(gk0[2], gk0[3]), pk2(gk1[0], gk1[1]), pk2(gk1[2], gk1[3])};
            const u32x4 gbp = {pk2(-gb0[0], -gb0[1]), pk2(-gb0[2], -gb0[3]), pk2(-gb1[0], -gb1[1]), pk2(-gb1[2], -gb1[3])};
            bf16_t* yrow = Yd + tok_row(cc, 16 * mt + fr) * RWD + h * 64 + 4 * q;
#pragma unroll
            for (int nt = 0; nt < 4; ++nt) { const int ri = 16 * nt + fr;
                const u32x2 v0 = *(const u32x2*)(VTp + ri * 40 + 4 * q), v1 = *(const u32x2*)(VTp + ri * 40 + 16 + 4 * q);
                const u32x2 s0 = *(const u32x2*)(SAF + ri * 40 + 4 * q), s1 = *(const u32x2*)(SAF + ri * 40 + 16 + 4 * q);
                const u32x4 vtp = {v0.x, v0.y, v1.x, v1.y}, sap = {s0.x, s0.y, s1.x, s1.y};
                const bf16x8 z0 = *(const bf16x8*)(S0B + ri * 72 + 8 * q), z1 = *(const bf16x8*)(S0B + ri * 72 + 32 + 8 * q);
                f32x4 y = __builtin_amdgcn_mfma_f32_16x16x32_bf16(__builtin_bit_cast(bf16x8, vtp), __builtin_bit_cast(bf16x8, gkp), z4, 0, 0, 0);
                y = __builtin_amdgcn_mfma_f32_16x16x32_bf16(__builtin_bit_cast(bf16x8, sap), __builtin_bit_cast(bf16x8, gbp), y, 0, 0, 0);
                y = __builtin_amdgcn_mfma_f32_16x16x32_bf16(z0, r0, y, 0, 0, 0); y = __builtin_amdgcn_mfma_f32_16x16x32_bf16(z1, r1, y, 0, 0, 0);
                *(u32x2*)(yrow + 16 * nt) = (u32x2){pk2(y[0], y[1]), pk2(y[2], y[3])}; }
        };
        auto ycomp = [&](int cc, int lane) { ycomp1(cc, lane, 0); ycomp1(cc, lane, 1); };
        f32x4 ST[4][2];
#pragma unroll
        for (int u = 0; u < 4; ++u) { ST[u][0] = (f32x4){0.f, 0.f, 0.f, 0.f}; ST[u][1] = (f32x4){0.f, 0.f, 0.f, 0.f}; }
        __syncthreads();
        if (w == 3) {
#pragma unroll 1
            for (int cc = 0; cc < 2; ++cc) { int tidp = tid0; asm volatile("" : "+v"(tidp)); RawL rl; ld_issue(cc, tidp & 63, rl); ld_commit(cc, tidp & 63, rl); } }
        __syncthreads();
        if (w >= 4) prep(0, tid0 & 63, w - 4);
        __syncthreads();
        if (w == 3) {
            for (int c = 0; c < NCH; c += 2) {
                int tid = tid0; asm volatile("" : "+v"(tid));
                const int lane = tid & 63, wit = item + 128 * (c >> 1); const bool hw = true;
                float wv[64];
                { RawL ra; ld_issue(c + 2 < NCH ? c + 2 : NCH - 1, lane, ra); if (hw) wt_issue(wit, lane, wv); ld_commit(c + 2, lane, ra); }
                __syncthreads();
                { RawL rb; ld_issue(c + 3 < NCH ? c + 3 : NCH - 1, lane, rb); if (hw) wt_finish(wit, lane, wv); ld_commit(c + 3, lane, rb); }
                __syncthreads();
            }
        } else
        for (int c = 0; c < NCH; ++c) {
            int tid = tid0; asm volatile("" : "+v"(tid));
            const int lane = tid & 63;
            if (w < 2) {
                const int rb = w;
                const float* PCV = (const float*)(lds + (c & 1) * A_BYTES);
                const bf16_t* RBp = (const bf16_t*)(lds + OFF_B + (c % 3) * B_BYTES); const bf16_t* KBp = RBp + CH * 72; const bf16_t* BBp = KBp + CH * 72; const bf16_t* VTp = BBp + CH * 72; const bf16_t* KKp = (const bf16_t*)(lds + OFF_E + (c & 1) * E_BYTES); const bf16_t* KTp = KKp + CH * 72; const bf16_t* BTp = KTp + 64 * 40;
                bf16_t* SAF = (bf16_t*)(lds + OFF_C + (c & 1) * C_BYTES); bf16_t* S0B = (bf16_t*)(lds + OFF_C + (c & 1) * C_BYTES + 64 * 80);
                const int fr = lane & 15, q = lane >> 4;
                const f32x4 z4 = {0.f, 0.f, 0.f, 0.f};
                auto mf = [](bf16x8 a_, bf16x8 b_, f32x4 c_) -> f32x4 { return __builtin_amdgcn_mfma_f32_16x16x32_bf16(a_, b_, c_, 0, 0, 0); };
                auto opA = [](f32x4 x) -> bf16x8 { const u32x4 v = {pk2(x[0], x[1]), pk2(x[2], x[3]), 0u, 0u}; return __builtin_bit_cast(bf16x8, v); };
                auto opN = [](f32x4 x) -> bf16x8 { const u32x4 v = {pk2(-x[0], -x[1]), pk2(-x[2], -x[3]), 0u, 0u}; return __builtin_bit_cast(bf16x8, v); };
                typedef short bf16x4_ __attribute__((ext_vector_type(4)));
                auto m16 = [](bf16x4_ a_, bf16x4_ b_, f32x4 c_) -> f32x4 { return __builtin_amdgcn_mfma_f32_16x16x16bf16_1k(a_, b_, c_, 0, 0, 0); };
                auto o4 = [](f32x4 x) -> bf16x4_ { const u32x2 v = {pk2(x[0], x[1]), pk2(x[2], x[3])}; return __builtin_bit_cast(bf16x4_, v); };
                auto o4n = [](f32x4 x) -> bf16x4_ { const u32x2 v = {pk2(-x[0], -x[1]), pk2(-x[2], -x[3])}; return __builtin_bit_cast(bf16x4_, v); };
                auto op2 = [](f32x4 lo, f32x4 hi) -> bf16x8 { const u32x4 v = {pk2(lo[0], lo[1]), pk2(lo[2], lo[3]), pk2(hi[0], hi[1]), pk2(hi[2], hi[3])}; return __builtin_bit_cast(bf16x8, v); };
                auto op2n = [](f32x4 lo, f32x4 hi) -> bf16x8 { const u32x4 v = {pk2(-lo[0], -lo[1]), pk2(-lo[2], -lo[3]), pk2(-hi[0], -hi[1]), pk2(-hi[2], -hi[3])}; return __builtin_bit_cast(bf16x8, v); };
                auto rf = [&](const bf16_t* X, int stride, int r0, int k0) -> bf16x8 { return *(const bf16x8*)(X + (r0 + fr) * stride + k0 + 8 * q); };
                auto pf = [&](const bf16_t* X, int stride, int r0, int k0) -> bf16x8 { const u32x2 a_ = *(const u32x2*)(X + (r0 + fr) * stride + k0 + 4 * q), b_ = *(const u32x2*)(X + (r0 + fr) * stride + k0 + 16 + 4 * q);
                    const u32x4 v = {a_.x, a_.y, b_.x, b_.y}; return __builtin_bit_cast(bf16x8, v); };
                bf16x8 kkf[2][2], bbf[2][2], kf[2][2];
#pragma unroll
                for (int a_ = 0; a_ < 2; ++a_)
#pragma unroll
                    for (int ks = 0; ks < 2; ++ks) { kkf[a_][ks] = rf(KKp, 72, 16 * a_, 32 * ks); bbf[a_][ks] = rf(BBp, 72, 16 * a_, 32 * ks); kf[a_][ks] = rf(KBp, 72, 16 * a_, 32 * ks); }
                auto gram = [&](const bf16x8 (&P)[2], const bf16x8 (&Q)[2]) -> f32x4 { return mf(P[1], Q[1], mf(P[0], Q[0], z4)); };
                bool lo_[4], up_[4], dg_[4];
#pragma unroll
                for (int r = 0; r < 4; ++r) { lo_[r] = fr < 4 * q + r; up_[r] = 4 * q + r < fr; dg_[r] = 4 * q + r == fr; }
                f32x4 TT[2];
#pragma unroll
                for (int bl = 0; bl < 2; ++bl) {
                    f32x4 N = gram(kkf[bl], bbf[bl]), NT = gram(bbf[bl], kkf[bl]), PT;
#pragma unroll
                    for (int r = 0; r < 4; ++r) { N[r] = lo_[r] ? -N[r] : 0.f; NT[r] = up_[r] ? -NT[r] : 0.f; PT[r] = NT[r] + (dg_[r] ? 1.f : 0.f); }
                    const f32x4 N2 = m16(o4(NT), o4(N), z4), N2T = m16(o4(N), o4(NT), z4); PT = m16(o4(N2), o4(PT), PT);
                    const f32x4 N4 = m16(o4(N2T), o4(N2), z4), N4T = m16(o4(N2), o4(N2T), z4); PT = m16(o4(N4), o4(PT), PT);
                    const f32x4 N8 = m16(o4(N4T), o4(N4), z4); PT = m16(o4(N8), o4(PT), PT);
                    TT[bl] = PT; }
                const f32x4 L21T = gram(bbf[0], kkf[1]);
                f32x4 AkT00 = gram(kf[0], kkf[0]), AkT10 = gram(kf[0], kkf[1]), AkT11 = gram(kf[1], kkf[1]);
#pragma unroll
                for (int r = 0; r < 4; ++r) { AkT00[r] = up_[r] ? AkT00[r] : 0.f; AkT11[r] = up_[r] ? AkT11[r] : 0.f; }
                f32x4 RH[2][2];
                { const bf16x8 a0op = opA(AkT00), a1op = op2(AkT10, AkT11);
#pragma unroll
                  for (int cI = 0; cI < 2; ++cI) { const bf16x8 vp_ = pf(VTp, 40, 32 * rb + 16 * cI, 0); RH[0][cI] = mf(a0op, vp_, z4); RH[1][cI] = mf(a1op, vp_, z4); } }
                bf16x8 sop[2][2];
#pragma unroll
                for (int ks = 0; ks < 2; ++ks)
#pragma unroll
                    for (int cI = 0; cI < 2; ++cI) { sop[ks][cI] = op2(ST[2 * ks][cI], ST[2 * ks + 1][cI]); const u32x4 sv = __builtin_bit_cast(u32x4, sop[ks][cI]);
                        *(u32x2*)(S0B + (32 * rb + 16 * cI + fr) * 72 + 32 * ks + 4 * q) = (u32x2){sv.x, sv.y}; *(u32x2*)(S0B + (32 * rb + 16 * cI + fr) * 72 + 32 * ks + 16 + 4 * q) = (u32x2){sv.z, sv.w}; }
#pragma unroll
                for (int a_ = 0; a_ < 2; ++a_)
#pragma unroll
                    for (int ks = 0; ks < 2; ++ks) { const bf16x8 kp_ = pf(KKp, 72, 16 * a_, 32 * ks); RH[a_][0] = mf(kp_, sop[ks][0], RH[a_][0]); RH[a_][1] = mf(kp_, sop[ks][1], RH[a_][1]); }
                bf16x8 nsa[2];
                { const bf16x4_ t0op = o4(TT[0]), t1op = o4(TT[1]), l21n = o4n(L21T);
#pragma unroll
                  for (int cI = 0; cI < 2; ++cI) { const f32x4 sa0 = m16(t0op, o4(RH[0][cI]), z4); const f32x4 r2 = m16(l21n, o4(sa0), RH[1][cI]); const f32x4 sa1 = m16(t1op, o4(r2), z4);
                      *(u32x2*)(SAF + (32 * rb + 16 * cI + fr) * 40 + 4 * q) = (u32x2){pk2(sa0[0], sa0[1]), pk2(sa0[2], sa0[3])}; *(u32x2*)(SAF + (32 * rb + 16 * cI + fr) * 40 + 16 + 4 * q) = (u32x2){pk2(sa1[0], sa1[1]), pk2(sa1[2], sa1[3])}; nsa[cI] = op2n(sa0, sa1); } }
                { const bf16x8 vr0 = rf(VTp, 40, 32 * rb, 0), vr1 = rf(VTp, 40, 32 * rb + 16, 0);
#pragma unroll
                  for (int u = 0; u < 4; ++u) { const bf16x8 kt_ = rf(KTp, 40, 16 * u, 0), bt_ = pf(BTp, 40, 16 * u, 0); const f32x4 pc = *(const f32x4*)(PCV + 16 * u + 4 * q);
                      ST[u][0] = mf(bt_, nsa[0], mf(kt_, vr0, ST[u][0])) * pc; ST[u][1] = mf(bt_, nsa[1], mf(kt_, vr1, ST[u][1])) * pc; } }
            } else if (w == 2) {
                if (c - 1 >= NCX) ycomp(c - 1, lane);
            } else {
                if (c + 1 < NCH) prep(c + 1, lane, w - 4);
            }
            __syncthreads();
        }
        if (w == 2) ycomp(NCH - 1, tid0 & 63);
    }
}
__device__ __forceinline__ void phase_rwkv_final(const bf16_t* __restrict__ RW, const bf16_t* __restrict__ Y0, const bf16_t* __restrict__ Y1, const float* __restrict__ a0, const bf16_t* __restrict__ A2T,
                                                 const bf16_t* __restrict__ G2T, const float* __restrict__ k_a, const float* __restrict__ r_k, const float* __restrict__ lnx_g, const float* __restrict__ lnx_b, bf16_t* __restrict__ O, unsigned char* lds, int bid, int nb) {
    const int tid = otid(), lane = tid & 63, h = __builtin_amdgcn_readfirstlane(tid >> 6), fr = lane & 15, fq = lane >> 4;
    bf16_t* const IM = (bf16_t*)(lds + h * 11520);
    const int lr = lane >> 3, lc = lane & 7;
    for (int tile = bid; tile < NLAT / 64; tile += nb) {
#pragma unroll 1
        for (int mt = 0; mt < 4; ++mt) {
            const size_t rowb = (size_t)tile * 64 + 16 * mt;
            asm volatile("s_waitcnt lgkmcnt(0)" ::: "memory");
#pragma unroll
            for (int g = 0; g < 2; ++g) { const size_t row = rowb + 8 * g + lr; const bf16_t* p0 = RW + row * RW_COLS + h * 64 + 8 * lc; const int lo = (8 * g + lr) * 72 + 8 * lc;
                const u32x4 vr = *(const u32x4*)(p0), vk = *(const u32x4*)(p0 + 512), vv = *(const u32x4*)(p0 + 1024), v0 = *(const u32x4*)(Y0 + row * RWD + h * 64 + 8 * lc), v1 = *(const u32x4*)(Y1 + row * RWD + h * 64 + 8 * lc);
                *(u32x4*)(IM + lo) = vr; *(u32x4*)(IM + 1152 + lo) = vk; *(u32x4*)(IM + 2304 + lo) = vv; *(u32x4*)(IM + 3456 + lo) = v0; *(u32x4*)(IM + 4608 + lo) = v1; }
            const bf16_t* pa = RW + (rowb + fr) * RW_COLS;
            bf16x8 fa[2], fg[4];
#pragma unroll
            for (int ks = 0; ks < 2; ++ks) fa[ks] = *(const bf16x8*)(pa + 1600 + ks * 32 + fq * 8);
#pragma unroll
            for (int ks = 0; ks < 4; ++ks) fg[ks] = *(const bf16x8*)(pa + 1664 + ks * 32 + fq * 8);
            asm volatile("s_waitcnt vmcnt(0) lgkmcnt(0)" ::: "memory");
            float bsum = 0.f, ysum = 0.f, ysq = 0.f; f32x4 yv[4];
#pragma unroll
            for (int nt = 0; nt < 4; ++nt) {
                const int c0 = h * 64 + 16 * nt + 4 * fq, lo = fr * 72 + 16 * nt + 4 * fq; f32x4 aa0 = {0.f, 0.f, 0.f, 0.f}, aa1 = {0.f, 0.f, 0.f, 0.f};
#pragma unroll
                for (int ks = 0; ks < 2; ++ks) { const bf16x8 b0 = *(const bf16x8*)(A2T + ((size_t)(h * 64 + 16 * nt + fr)) * 64 + ks * 32 + fq * 8), b1 = *(const bf16x8*)(A2T + ((size_t)(512 + h * 64 + 16 * nt + fr)) * 64 + ks * 32 + fq * 8);
                    aa0 = __builtin_amdgcn_mfma_f32_16x16x32_bf16(b0, fa[ks], aa0, 0, 0, 0); aa1 = __builtin_amdgcn_mfma_f32_16x16x32_bf16(b1, fa[ks], aa1, 0, 0, 0); }
                const f32x4 r = ld_bf16x4(IM + lo), k = ld_bf16x4(IM + 1152 + lo); yv[nt] = ld_bf16x4(IM + 3456 + lo) + ld_bf16x4(IM + 4608 + lo);
                const f32x4 a00 = *(const f32x4*)(a0 + c0), a01 = *(const f32x4*)(a0 + 512 + c0), ka = *(const f32x4*)(k_a + c0), rk = *(const f32x4*)(r_k + c0);
#pragma unroll
                for (int j = 0; j < 4; ++j) { const float av0 = fsigmoid(aa0[j] + a00[j]), av1 = fsigmoid(aa1[j] + a01[j]); const float ksum = k[j] * (2.f + (av0 + av1 - 2.f) * ka[j]); bsum += r[j] * ksum * rk[j]; ysum += yv[nt][j]; ysq += yv[nt][j] * yv[nt][j]; }
                asm volatile("" ::: "memory");
            }
            bsum += __shfl_xor(bsum, 16); bsum += __shfl_xor(bsum, 32); ysum += __shfl_xor(ysum, 16); ysum += __shfl_xor(ysum, 32); ysq += __shfl_xor(ysq, 16); ysq += __shfl_xor(ysq, 32);
            const float mean = ysum * (1.f / 64.f); const float var = fmaxf(ysq * (1.f / 64.f) - mean * mean, 0.f); const float rstd = rsqrtf(var + LNX_EPS);
#pragma unroll
            for (int nt = 0; nt < 4; ++nt) {
                const int c0 = h * 64 + 16 * nt + 4 * fq, lo = fr * 72 + 16 * nt + 4 * fq; f32x4 gg = {0.f, 0.f, 0.f, 0.f};
#pragma unroll
                for (int ks = 0; ks < 4; ++ks) { const bf16x8 bg = *(const bf16x8*)(G2T + ((size_t)(h * 64 + 16 * nt + fr)) * 128 + ks * 32 + fq * 8); gg = __builtin_amdgcn_mfma_f32_16x16x32_bf16(bg, fg[ks], gg, 0, 0, 0); }
                const f32x4 v = ld_bf16x4(IM + 2304 + lo); const f32x4 lg = *(const f32x4*)(lnx_g + c0), lb = *(const f32x4*)(lnx_b + c0); f32x4 o;
#pragma unroll
                for (int j = 0; j < 4; ++j) o[j] = ((yv[nt][j] - mean) * rstd * lg[j] + lb[j] + bsum * v[j]) * gg[j];
                st_bf16x4(IM + lo, o);
                asm volatile("" ::: "memory");
            }
            asm volatile("s_waitcnt lgkmcnt(0)" ::: "memory");
#pragma unroll
            for (int g = 0; g < 2; ++g) { const size_t row = rowb + 8 * g + lr; *(u32x4*)(O + row * RWD + h * 64 + 8 * lc) = *(const u32x4*)(IM + (8 * g + lr) * 72 + 8 * lc); }
        }
    }
}
__device__ __forceinline__ void phase_lru_final(const bf16_t* __restrict__ H0, const bf16_t* __restrict__ H1, const bf16_t* __restrict__ GB, bf16_t* __restrict__ HL, int bid, int nb) {
    const size_t n8 = (size_t)NLAT * LWD / 8, stride = (size_t)nb * 512;
    for (size_t i = (size_t)bid * 512 + otid(); i < n8; i += 4 * stride) { u32x4 a[4], c[4], g[4];
#pragma unroll
        for (int q = 0; q < 4; ++q) { const size_t k = i + q * stride; if (k < n8) { a[q] = ((const u32x4*)H0)[k]; c[q] = ((const u32x4*)H1)[k]; g[q] = ((const u32x4*)GB)[k]; } }
#pragma unroll
        for (int q = 0; q < 4; ++q) { const size_t k = i + q * stride; if (k < n8) { float fa[8], fc[8], fg[8]; unpack8(a[q], fa); unpack8(c[q], fc); unpack8(g[q], fg); u32x4 o;
            o.x = pk2((fa[0] + fc[0]) * fg[0], (fa[1] + fc[1]) * fg[1]); o.y = pk2((fa[2] + fc[2]) * fg[2], (fa[3] + fc[3]) * fg[3]); o.z = pk2((fa[4] + fc[4]) * fg[4], (fa[5] + fc[5]) * fg[5]); o.w = pk2((fa[6] + fc[6]) * fg[6], (fa[7] + fc[7]) * fg[7]);
            ((u32x4*)HL)[k] = o; } }
    }
}
template <int CTRL> __device__ __forceinline__ float dpp_max(float x) { return fmaxf(x, __builtin_bit_cast(float, __builtin_amdgcn_update_dpp(0, __builtin_bit_cast(int, x), CTRL, 0xF, 0xF, true))); }
__device__ __forceinline__ float max16(float x) { x = dpp_max<0xB1>(x); x = dpp_max<0x4E>(x); x = dpp_max<0x141>(x); x = dpp_max<0x140>(x); return x; }
__device__ __forceinline__ void phase_router(const float* __restrict__ XMID, const float* __restrict__ g2n, const float* __restrict__ MOD, const float* __restrict__ router, float* __restrict__ AFF, const float* __restrict__ SSQ, bf16_t* __restrict__ H2, unsigned char* lds, int bid, int nb) {
    const int tid = otid(), lane = tid & 63, w = __builtin_amdgcn_readfirstlane(tid >> 6), e = lane & 15, q = lane >> 4;
    float* IMG = (float*)(lds + w * 16640);
    for (int tile = bid * 8 + w; tile < NLAT / 16; tile += nb * 8) {
        const int row0 = tile * 16, b = row0 / T;
        float rstd; { const f32x4* sp_ = (const f32x4*)(SSQ + (size_t)(row0 + e) * 16); const f32x4 s0 = sp_[0], s1 = sp_[1], s2 = sp_[2], s3 = sp_[3];
            const float ssq = (((s0.x + s0.y) + (s0.z + s0.w)) + ((s1.x + s1.y) + (s1.z + s1.w))) + (((s2.x + s2.y) + (s2.z + s2.w)) + ((s3.x + s3.y) + (s3.z + s3.w))); rstd = rsqrtf(ssq * (1.f / D) + RMS_EPS); }
        const float* xr = XMID + (size_t)row0 * D + 4 * lane; const float* gp = g2n + 4 * lane; const float* scp = MOD + (size_t)b * 6144 + 4096 + 4 * lane; const float* shp = MOD + (size_t)b * 6144 + 3072 + 4 * lane; const float* rp = router + (4 * q) * 16 + e;
        bf16_t* hp = H2 + (size_t)row0 * D + 4 * lane;
        f32x4 acc = {0.f, 0.f, 0.f, 0.f};
#pragma unroll 1
        for (int kc = 0; kc < D; kc += 256) {
            f32x4 xq[16];
#pragma unroll
            for (int r = 0; r < 16; ++r) xq[r] = *(const f32x4*)(xr + (size_t)r * D + kc);
            const f32x4 gv = *(const f32x4*)(gp + kc), sv = *(const f32x4*)(scp + kc), hv = *(const f32x4*)(shp + kc);
#pragma unroll
            for (int r = 0; r < 16; ++r) { const float rs = __builtin_bit_cast(float, __builtin_amdgcn_readlane(__builtin_bit_cast(int, rstd), r));
                const f32x4 av = (xq[r] * rs * gv) * (sv + 1.f) + hv;
                u32x2 o; o.x = pk2(av.x, av.y); o.y = pk2(av.z, av.w); *(u32x2*)(hp + (size_t)r * D + kc) = o;
                *(f32x4*)(IMG + r * 260 + 4 * lane) = av; }
            asm volatile("s_waitcnt lgkmcnt(0)" ::: "memory");
#pragma unroll
            for (int u = 0; u < 16; ++u) { const int kb = 16 * u; const f32x4 av = *(const f32x4*)(IMG + e * 260 + kb + 4 * q);
#pragma unroll
                for (int c = 0; c < 4; ++c) acc = __builtin_amdgcn_mfma_f32_16x16x4f32(av[c], rp[(kc + kb + c) * 16], acc, 0, 0, 0); }
            asm volatile("s_waitcnt lgkmcnt(0)" ::: "memory");
        }
#pragma unroll
        for (int r = 0; r < 4; ++r) { const int tok = 4 * q + r; const float lg = acc[r];
            const float mx = max16(lg); const float ex = __expf(lg - mx); const float sm = red16(ex);
            AFF[((size_t)b * NE + e) * T + (row0 & (T - 1)) + tok] = ex / sm; }
    }
}
__device__ __forceinline__ void phase_topk(const float* __restrict__ AFF, int* __restrict__ IDX, float* __restrict__ GATE, int* __restrict__ SLOT, unsigned char* lds, int bid, int nb) {
    unsigned* hist = (unsigned*)lds;
    unsigned* sel = (unsigned*)(lds + 1024);
    unsigned* wsum = (unsigned*)(lds + 1040);
    const int tid = otid(), lane = tid & 63, w = tid >> 6;
    for (int be = bid; be < NB * NE; be += nb) {
        const int b = be >> 4, e = be & 15;
        unsigned key[8];
        { const u32x4* src = (const u32x4*)(AFF + (size_t)be * T + tid * 8); const u32x4 v0 = src[0], v1 = src[1]; key[0] = v0.x; key[1] = v0.y; key[2] = v0.z; key[3] = v0.w; key[4] = v1.x; key[5] = v1.y; key[6] = v1.z; key[7] = v1.w; }
        unsigned prefix = 0u, kk = CAP;
#pragma unroll 1
        for (int pass = 0; pass < 4; ++pass) {
            const int shift = 24 - 8 * pass; const unsigned himask = pass == 0 ? 0u : (0xffffffffu << (shift + 8));
            __syncthreads();
            if (tid < 256) hist[tid] = 0u;
            __syncthreads();
#pragma unroll
            for (int q = 0; q < 8; ++q) if ((key[q] & himask) == prefix) atomicAdd(&hist[(key[q] >> shift) & 255u], 1u);
            __syncthreads();
            if (w == 0) {
                unsigned c[4]; unsigned tot = 0u;
#pragma unroll
                for (int j = 0; j < 4; ++j) { c[j] = hist[255 - 4 * lane - j]; tot += c[j]; }
                unsigned inc = tot;
#pragma unroll
                for (int o = 1; o < 64; o <<= 1) { const unsigned t = __shfl_up(inc, o); if (lane >= o) inc += t; }
                unsigned before = inc - tot;
#pragma unroll
                for (int j = 0; j < 4; ++j) { if (before < kk && kk <= before + c[j]) { sel[0] = (unsigned)(255 - 4 * lane - j); sel[1] = kk - before; } before += c[j]; }
            }
            __syncthreads();
            prefix |= sel[0] << shift; kk = sel[1];
        }
        unsigned ngt = 0u, neq = 0u;
#pragma unroll
        for (int q = 0; q < 8; ++q) { ngt += key[q] > prefix ? 1u : 0u; neq += key[q] == prefix ? 1u : 0u; }
        unsigned pk = (ngt << 16) | neq, inc = pk;
#pragma unroll
        for (int o = 1; o < 64; o <<= 1) { const unsigned t = __shfl_up(inc, o); if (lane >= o) inc += t; }
        __syncthreads();
        if (lane == 63) wsum[w] = inc;
        __syncthreads();
        unsigned base = 0u;
#pragma unroll
        for (int ww = 0; ww < 8; ++ww) if (ww < w) base += wsum[ww];
        unsigned ex = base + inc - pk; unsigned gt_before = ex >> 16, eq_before = ex & 0xffffu;
#pragma unroll
        for (int q = 0; q < 8; ++q) { const int i = tid * 8 + q; const bool isgt = key[q] > prefix, iseq = key[q] == prefix; const bool take = isgt || (iseq && eq_before < kk);
            const unsigned slot = gt_before + (eq_before < kk ? eq_before : kk);
            if (take) { IDX[(size_t)be * CAP + slot] = i; GATE[(size_t)be * CAP + slot] = __builtin_bit_cast(float, key[q]); }
            SLOT[((size_t)b * T + i) * NE + e] = take ? (int)slot : -1;
            gt_before += isgt ? 1u : 0u; eq_before += iseq ? 1u : 0u; }
    }
}
__device__ __forceinline__ void phase_final(const float* __restrict__ XMID, const bf16_t* __restrict__ YE, const int* __restrict__ SLOT, const float* __restrict__ MOD, const float* __restrict__ fg, float* __restrict__ out, int bid, int nb) {
    const int tid = otid(), lane = tid & 63, p = lane & 15, gq = bid * 32 + (tid >> 4), NGQ = nb * 32;
    for (int r = gq; r < NLAT; r += NGQ) {
        const int b = r / T; const float* mr = MOD + (size_t)b * 6144 + 5120;
        const int4 s0 = *(const int4*)(SLOT + (size_t)r * NE), s1 = *(const int4*)(SLOT + (size_t)r * NE + 4), s2 = *(const int4*)(SLOT + (size_t)r * NE + 8), s3 = *(const int4*)(SLOT + (size_t)r * NE + 12);
        const int sl[16] = {s0.x, s0.y, s0.z, s0.w, s1.x, s1.y, s1.z, s1.w, s2.x, s2.y, s2.z, s2.w, s3.x, s3.y, s3.z, s3.w};
        f32x4 acc[16];
#pragma unroll
        for (int j = 0; j < 16; ++j) acc[j] = (f32x4){0.f, 0.f, 0.f, 0.f};
#pragma unroll
        for (int e = 0; e < NE; ++e) if (sl[e] >= 0) { const u32x4* yr = (const u32x4*)(YE + ((size_t)(b * NE + e) * CAP + sl[e]) * D) + p;
#pragma unroll
            for (int j = 0; j < 8; ++j) { const u32x4 v = yr[16 * j];
                acc[2 * j] += (f32x4){__builtin_bit_cast(float, v.x << 16), __builtin_bit_cast(float, v.x & 0xffff0000u), __builtin_bit_cast(float, v.y << 16), __builtin_bit_cast(float, v.y & 0xffff0000u)};
                acc[2 * j + 1] += (f32x4){__builtin_bit_cast(float, v.z << 16), __builtin_bit_cast(float, v.z & 0xffff0000u), __builtin_bit_cast(float, v.w << 16), __builtin_bit_cast(float, v.w & 0xffff0000u)}; } }
        float s = 0.f;
#pragma unroll
        for (int j = 0; j < 16; ++j) { const int f4 = 2 * (p + 16 * (j >> 1)) + (j & 1);
            acc[j] = ((const f32x4*)(XMID + (size_t)r * D))[f4] + ((const f32x4*)mr)[f4] * acc[j]; s += (acc[j].x * acc[j].x + acc[j].y * acc[j].y) + (acc[j].z * acc[j].z + acc[j].w * acc[j].w); }
        const float rstd = rsqrtf(red16(s) * (1.f / D) + RMS_EPS);
#pragma unroll
        for (int j = 0; j < 16; ++j) { const int f4 = 2 * (p + 16 * (j >> 1)) + (j & 1); ((f32x4*)(out + (size_t)r * D))[f4] = acc[j] * rstd * ((const f32x4*)fg)[f4]; }
    }
}

__device__ __forceinline__ void phase_wconv_moe_rest(const float* __restrict__ mw1, const float* __restrict__ mw3, const float* __restrict__ mw2, bf16_t* __restrict__ W13, bf16_t* __restrict__ W2, int t0, unsigned char* lds, int bid, int nb) {
    const int tid = otid(), lane = tid & 63, wv = tid >> 6, gw = bid * 8 + wv, NGW = nb * 8;
    u32x4* wl = (u32x4*)(lds + wv * 9216);
    for (int it = t0 + gw; it < 12288; it += NGW) {
        const int m = it >> 12, r = it & 4095, e = r >> 8, tt = r & 255, k0 = (tt >> 4) * 64, n0 = (tt & 15) * 64, rmul = m == 2 ? 4 : 8, radd = m == 1 ? 4 : 0;
        const float* src = (m == 0 ? mw1 : m == 1 ? mw3 : mw2) + (size_t)e * 1024 * 1024; bf16_t* dst = m == 2 ? W2 + (size_t)e * 1024 * 1024 : W13 + (size_t)e * 2048 * 1024;
        const float* sp = src + (size_t)k0 * 1024 + n0 + lane; float v[64];
#pragma unroll
        for (int i = 0; i < 64; ++i) v[i] = sp[(size_t)i * 1024];
#pragma unroll
        for (int c = 0; c < 8; ++c) { u32x4 o; o.x = pk2(v[8 * c], v[8 * c + 1]); o.y = pk2(v[8 * c + 2], v[8 * c + 3]); o.z = pk2(v[8 * c + 4], v[8 * c + 5]); o.w = pk2(v[8 * c + 6], v[8 * c + 7]); wl[lane * 9 + c] = o; }
        asm volatile("s_waitcnt lgkmcnt(0)" ::: "memory");
#pragma unroll
        for (int j = 0; j < 8; ++j) { const int n = (lane >> 3) + 8 * j, c = lane & 7; const u32x4 o = wl[n * 9 + c];
            const int nn = n0 + n, row = (nn >> 2) * rmul + (nn & 3) + radd; *(u32x4*)(dst + (size_t)row * 1024 + k0 + 8 * c) = o; }
        asm volatile("s_waitcnt lgkmcnt(0)" ::: "memory");
    }
}
constexpr int RING_BYTES = 131072, LDS_BYTES = 163840, MISC_OFF = LDS_BYTES - 256;
constexpr int CW_BAR = 4096;
constexpr size_t CTL_ZERO_BYTES = 65536;
__global__ __launch_bounds__(512, 2) void mega(Args a) {
    extern __shared__ __attribute__((aligned(16))) unsigned char lds[];
    const int bid = blockIdx.x, nb = gridDim.x, tid = threadIdx.x;
    unsigned char* ws = a.ws;
    const float* x = a.in[0]; const float* c = a.in[1]; const float* ctx = a.in[2]; const float* c_ctx = a.in[3]; const float* w_mod = a.in[4]; const float* b_mod = a.in[5];
    const float* norm1_g = a.in[6]; const float* norm2_g = a.in[7]; const float* w_in = a.in[8]; const float* mu = a.in[9]; const float* rw0 = a.in[10]; const float* rw2 = a.in[11];
    const float* ra0 = a.in[12]; const float* ra2 = a.in[13]; const float* rg2 = a.in[14]; const float* rkk = a.in[15]; const float* rka = a.in[16]; const float* rrk = a.in[17];
    const float* lnx_g = a.in[18]; const float* lnx_b = a.in[19]; const float* w_pr = a.in[20]; const float* conv_w = a.in[21]; const float* conv_b = a.in[22]; const float* lwa = a.in[23];
    const float* lba = a.in[24]; const float* lwx = a.in[25]; const float* lbx = a.in[26]; const float* llam = a.in[27]; const float* w_pl = a.in[28]; const float* w_out = a.in[29];
    const float* router = a.in[30]; const float* mw1 = a.in[31]; const float* mw3 = a.in[32]; const float* mw2 = a.in[33]; const float* final_g = a.in[34];
    float* MOD = (float*)(ws + WS_MOD); bf16_t* WIN = (bf16_t*)(ws + WS_WIN); bf16_t* WPR = (bf16_t*)(ws + WS_WPR); bf16_t* WPL = (bf16_t*)(ws + WS_WPL); bf16_t* WOUT = (bf16_t*)(ws + WS_WOUT);
    bf16_t* GT = (bf16_t*)(ws + WS_GT); float* XMID = (float*)(ws + WS_XMID); bf16_t* U = (bf16_t*)(ws + WS_U); float* Y = (float*)(ws + WS_Y); bf16_t* RW = (bf16_t*)(ws + WS_RW);
    bf16_t* MG = (bf16_t*)(ws + WS_MERGED); bf16_t* XB = (bf16_t*)(ws + WS_XB); bf16_t* GB = (bf16_t*)(ws + WS_GB); float* H = (float*)(ws + WS_H); bf16_t* O = (bf16_t*)(ws + WS_O); bf16_t* HL = (bf16_t*)(ws + WS_HL);
    bf16_t* W2 = (bf16_t*)a.out; bf16_t* W13 = (bf16_t*)((unsigned char*)a.out + 32 * MiB);
     bf16_t* H2 = (bf16_t*)(ws + WS_H2); bf16_t* HID = (bf16_t*)(ws + WS_HID); bf16_t* YE = (bf16_t*)(ws + WS_YE); bf16_t* XS = (bf16_t*)(ws + WS_XS);
    bf16_t* W2T = (bf16_t*)(ws + WS_W2T); bf16_t* A2T = (bf16_t*)(ws + WS_A2T); bf16_t* WAT = (bf16_t*)(ws + WS_WAT); bf16_t* WXT = (bf16_t*)(ws + WS_WXT); bf16_t* G2T = (bf16_t*)(ws + WS_G2T); bf16_t* H0 = (bf16_t*)(ws + WS_H); bf16_t* H1 = (bf16_t*)(ws + WS_H + 32 * MiB); bf16_t* Y0 = (bf16_t*)(ws + WS_Y); bf16_t* Y1 = (bf16_t*)(ws + WS_Y + 32 * MiB);
    float* AFF = (float*)(ws + TAB_AFF); int* IDX = (int*)(ws + TAB_IDX); float* GATE = (float*)(ws + TAB_GATE); int* SLOT = (int*)(ws + TAB_SLOT); float* KN = (float*)(ws + TAB_RSTD); bf16_t* SIDE = (bf16_t*)(ws + TAB_SIDE); float* SSQ = (float*)(ws + TAB_SSQ);

    for (int u = tid; u < (LDS_BYTES - MISC_OFF) / 4; u += 512) ((LAS unsigned*)(lds + MISC_OFF))[u] = 0u;
    __syncthreads();
    const XcdBarrier bar = xcd_barrier_post((unsigned*)(ws + WS_CTL) + CW_BAR, (volatile LAS unsigned*)(lds + MISC_OFF) + 8);
    PG8_LAS unsigned char* ring = (PG8_LAS unsigned char*)lds;

#define PH(k) for (int rep_ = 0; rep_ < (PROBE == (k) ? 3 : 1); ++rep_)
    PH(0) {
    phase_modvec(c, c_ctx, w_mod, b_mod, MOD, lds, bid, nb);
    phase_wconv(w_in, WIN, 1024, IN_COLS, 4, 0, 1, 0, 0, lds, bid, nb);
    phase_wconv(w_pr, WPR, 512, 1024, 4, 0, 1, 0, 0, lds, bid, nb);
    phase_wconv(w_pl, WPL, 512, 1024, 4, 0, 1, 0, 0, lds, bid, nb);
    phase_wconv(w_out, WOUT, 1024, 1024, 4, 0, 1, 0, 0, lds, bid, nb);
    phase_wconv(rw2, W2T, 64, 512, 4, 0, 2, (size_t)64 * 512, (size_t)512 * 64, lds, bid, nb);
    phase_wconv(ra2, A2T, 64, 512, 4, 0, 2, (size_t)64 * 512, (size_t)512 * 64, lds, bid, nb);
    phase_wconv(lwa, WAT, 64, 64, 4, 0, 16, (size_t)64 * 64, (size_t)64 * 64, lds, bid, nb);
    phase_wconv(lwx, WXT, 64, 64, 4, 0, 16, (size_t)64 * 64, (size_t)64 * 64, lds, bid, nb);
    phase_wconv(rg2, G2T, 128, 512, 4, 0, 1, 0, 0, lds, bid, nb);
    xcd_barrier(bar); }
    PH(1) { phase_normmod(x, ctx, norm1_g, MOD, U, bid, nb); xcd_barrier(bar); }
    PH(2) { SWin S{U, WIN, nb, bid}; EWin E{RW, XB, GB, GT}; pg8::gemm_phase<EWin, SWin, true>(ring, 1024, S, E); xcd_barrier(bar); }
    PH(4) { phase_mixA(RW, SIDE, bid, nb); xcd_barrier(bar); }
    PH(16) { phase_mixB(RW, SIDE, mu, rkk, KN, bid, nb); xcd_barrier(bar); }
    PH(3) { const int hb = nb >> 1;
        if (bid < hb) phase_rwkv_full(RW, KN, Y0, Y1, rw0, W2T, ra0, A2T, rkk, rka, mw1, mw3, mw2, W13, W2, lds, bid, hb);
        else { phase_lru_seq(XB, H0, H1, conv_w, conv_b, WAT, lba, WXT, lbx, llam, lds, bid - hb, nb - hb); __syncthreads(); phase_wconv_moe_rest(mw1, mw3, mw2, W13, W2, 128 * 68, lds, bid - hb, nb - hb); }
        xcd_barrier(bar); }
    PH(5) { phase_rwkv_final(RW, Y0, Y1, ra0, A2T, G2T, rka, rrk, lnx_g, lnx_b, O, lds, bid, nb); if (PROBE == 5) xcd_barrier(bar); }
    PH(14) { phase_lru_final(H0, H1, GB, HL, bid, nb); xcd_barrier(bar); }
    PH(6) { SProj S{O, HL, WPR, WPL, nb, bid}; EProj E{GT, MG}; pg8::gemm_phase<EProj, SProj, true>(ring, 512, S, E); xcd_barrier(bar); }
    PH(7) { SWout S{MG, WOUT, nb, bid}; EWout E{x, MOD, XMID, SSQ}; pg8::gemm_phase<EWout, SWout, true>(ring, 1024, S, E); xcd_barrier(bar); }
    PH(8) {
    if (PROBE == 8) xcd_barrier(bar); }
    PH(15) { phase_router(XMID, norm2_g, MOD, router, AFF, SSQ, H2, lds, bid, nb); xcd_barrier(bar); }
    PH(9) { phase_topk(AFF, IDX, GATE, SLOT, lds, bid, nb); xcd_barrier(bar); }
    PH(11) { SMoe1 S{H2, W13, IDX, nb, bid}; EMoe1 E{HID}; pg8::gemm_phase<EMoe1, SMoe1, true>(ring, 1024, S, E); xcd_barrier(bar); }
    PH(12) { SMoe2 S{HID, W2, nb, bid}; EMoe2 E{GATE, YE}; pg8::gemm_phase<EMoe2, SMoe2, true>(ring, 1024, S, E); xcd_barrier(bar); }
    PH(13) { phase_final(XMID, YE, SLOT, MOD, final_g, a.out, bid, nb); if (PROBE == 13) xcd_barrier(bar); }
#undef PH
}

extern "C" void kernel_launch(void* const* d_in, const int* in_sizes, int n_in, void* d_out, int out_size, void* d_ws, size_t ws_size, hipStream_t stream) {
    static int grid = 0;
    if (grid == 0) {
        if (n_in != 35 || ws_size < WS_END || out_size != NLAT * D) { fprintf(stderr, "kernel_launch: unexpected problem (n_in %d, ws %zu, out %d)\n", n_in, ws_size, out_size); grid = -1; return; }
        int dev = 0, cus = 0;
        if (hipGetDevice(&dev) != hipSuccess || hipDeviceGetAttribute(&cus, hipDeviceAttributeMultiprocessorCount, dev) != hipSuccess || cus <= 0) { fprintf(stderr, "kernel_launch: device query failed\n"); grid = -1; return; }
        if (hipFuncSetAttribute((const void*)mega, hipFuncAttributeMaxDynamicSharedMemorySize, LDS_BYTES) != hipSuccess) { fprintf(stderr, "kernel_launch: hipFuncSetAttribute failed\n"); grid = -1; return; }
        int per_cu = 0;
        if (hipOccupancyMaxActiveBlocksPerMultiprocessor(&per_cu, (const void*)mega, 512, LDS_BYTES) != hipSuccess || per_cu < 1) fprintf(stderr, "kernel_launch: occupancy query reports %d blocks per CU\n", per_cu);
        (void)hipGetLastError();
        grid = cus;
    }
    if (grid < 0) return;
    (void)hipMemsetAsync((char*)d_ws + WS_CTL, 0, CTL_ZERO_BYTES, stream);
    Args a{};
    for (int i = 0; i < 35; ++i) a.in[i] = (const float*)d_in[i];
    a.out = (float*)d_out; a.ws = (unsigned char*)d_ws;
    hipLaunchKernelGGL(mega, dim3(grid), dim3(512), LDS_BYTES, stream, a);
}
```

```cpp
#include <hip/hip_runtime.h>
#include <cstdio>
#include <cstdint>

typedef unsigned short bf16_t;
typedef short bf16x8 __attribute__((ext_vector_type(8)));
typedef float f32x4 __attribute__((ext_vector_type(4)));
typedef unsigned u32x4 __attribute__((ext_vector_type(4)));
typedef unsigned u32x2 __attribute__((ext_vector_type(2)));
typedef float f32x2_ __attribute__((ext_vector_type(2)));

constexpr int D = 1024, NB = 8, T = 4096, TC = 256, GW = 64;
constexpr int NLAT = NB * T, NCTX = NB * TC, NTOK = NLAT + NCTX;
constexpr int RH = 8, RN = 64, RWD = 512, RWR = 64, RAR = 64, RGR = 128;
constexpr int RW_COLS = 3 * RWD + RWR + RAR + RGR;
constexpr int LWD = 512;
constexpr int IN_COLS = RW_COLS + 2 * LWD + 2 * D;
constexpr int NE = 16, CAP = 512, DE = 1024;
constexpr float RMS_EPS = 1e-6f, LNX_EPS = 64e-5f;
constexpr int NSLOT = NB * NE * CAP;

constexpr size_t MiB = 1u << 20;
constexpr size_t WS_CTL = 0;
constexpr size_t WS_MOD = 1 * MiB;
constexpr size_t WS_WIN = 2 * MiB;
constexpr size_t WS_WPR = 12 * MiB;
constexpr size_t WS_WPL = 13 * MiB;
constexpr size_t WS_WOUT = 14 * MiB;
constexpr size_t WS_GT = 16 * MiB;
constexpr size_t WS_XMID = 16 * MiB;
constexpr size_t WS_U = 144 * MiB;
constexpr size_t WS_Y = 144 * MiB;
constexpr size_t WS_RW = 212 * MiB;
constexpr size_t WS_MERGED = 212 * MiB;
constexpr size_t WS_XB = 331 * MiB;
constexpr size_t WS_GB = 365 * MiB;
constexpr size_t WS_H = 397 * MiB;
constexpr size_t WS_O = 461 * MiB;
constexpr size_t WS_TAB = 496 * MiB;
constexpr size_t WS_W2 = 144 * MiB;
constexpr size_t WS_W13 = 176 * MiB;
constexpr size_t WS_XS = 240 * MiB;
constexpr size_t WS_H2 = 240 * MiB;
constexpr size_t WS_HID = 368 * MiB;
constexpr size_t WS_YE = 176 * MiB;
constexpr size_t WS_END = 512 * MiB;
constexpr size_t TAB_AFF = WS_TAB;
constexpr size_t TAB_IDX = WS_TAB + 2 * MiB;
constexpr size_t TAB_GATE = WS_TAB + 3 * MiB;
constexpr size_t TAB_SLOT = WS_TAB + 4 * MiB;
constexpr size_t TAB_RSTD = WS_TAB + 6 * MiB;
constexpr size_t TAB_SIDE = WS_TAB + 8 * MiB;
constexpr size_t TAB_SSQ = WS_TAB + 8 * MiB;

__device__ __forceinline__ unsigned f2bf(float f) { return (unsigned)__builtin_bit_cast(unsigned short, (__bf16)f); }
typedef float f32x2_t_ __attribute__((ext_vector_type(2))); typedef __bf16 bf16x2_t_ __attribute__((ext_vector_type(2)));
__device__ __forceinline__ unsigned pk2(float lo, float hi) { const f32x2_t_ v = {lo, hi}; const bf16x2_t_ b = __builtin_convertvector(v, bf16x2_t_); return __builtin_bit_cast(unsigned, b); }
__device__ __forceinline__ float bf2f(bf16_t b) { return __builtin_bit_cast(float, ((unsigned)b) << 16); }
__device__ __forceinline__ float softplusf_(float x) { return fmaxf(x, 0.f) + log1pf(__expf(-fabsf(x))); }
__device__ __forceinline__ float siluf_(float x) { return x / (1.f + __expf(-x)); }
__device__ __forceinline__ float fsigmoid(float x) { return __builtin_amdgcn_rcpf(1.f + __builtin_amdgcn_exp2f(-1.4426950408889634f * x)); }
__device__ __forceinline__ float fgelu_tanh(float x) { return x * fsigmoid(1.5957691216057308f * (x + 0.044715f * x * x * x)); }
__device__ __forceinline__ float fsilu(float x) { return x * fsigmoid(x); }
__device__ __forceinline__ float wave_sum(float v) {
#pragma unroll
    for (int o = 1; o < 64; o <<= 1) v += __shfl_xor(v, o);
    return v;
}
constexpr size_t WS_W2T = WS_MOD + 256 * 1024, WS_A2T = WS_MOD + 384 * 1024, WS_WAT = WS_MOD + 512 * 1024, WS_WXT = WS_MOD + 640 * 1024, WS_G2T = WS_MOD + 768 * 1024;
constexpr size_t WS_HL = WS_XB;


__device__ __forceinline__ void st_bf16x4(bf16_t* p, f32x4 v) { u32x2 w; w.x = pk2(v.x, v.y); w.y = pk2(v.z, v.w); *(u32x2*)p = w; }
__device__ __forceinline__ f32x4 ld_bf16x4(const bf16_t* p) { const u32x2 w = *(const u32x2*)p; return (f32x4){__builtin_bit_cast(float, w.x << 16), __builtin_bit_cast(float, w.x & 0xffff0000u), __builtin_bit_cast(float, w.y << 16), __builtin_bit_cast(float, w.y & 0xffff0000u)}; }
namespace pg8 {
#define PG8_LAS __attribute__((address_space(3)))
constexpr int BM = 256, BK = 64, HALF = 128, HTB = HALF * BK * 2, STAGE_BYTES = 8 * HTB, NXCD = 8, WGM = 8;
__host__ __device__ __forceinline__ int lds_byte(int r, int c) { const int st = (r >> 4) * 2 + (c >> 5), rr = r & 15, cc = c & 31, ob = rr * 64 + cc * 2; return st * 1024 + (ob ^ (((ob >> 9) & 1) << 5)); }
__host__ __device__ __forceinline__ void stage_rc(int b, int& R, int& C) { const int st = b / 1024, sb = b % 1024, swz = sb ^ (((sb >> 9) & 1) << 5); R = (st >> 1) * 16 + swz / 64; C = (st & 1) * 32 + (swz % 64) / 2; }
__host__ __device__ __forceinline__ int perm32(int rho) { const int n = rho >> 4, i = rho & 15; return 8 * (i >> 2) + 4 * n + (i & 3); }
struct Unit { int pm, pn, aux; };
__device__ __forceinline__ void grid_order(int L, int nM, int nN, int& pm, int& pn) {
    const int nwg = nM * nN; int wgid = L; { const int q = nwg / NXCD, r = nwg % NXCD, xcd = wgid % NXCD, off = wgid / NXCD; wgid = (xcd < r ? xcd * (q + 1) : r * (q + 1) + (xcd - r) * q) + off; }
    const int nig = WGM * nN, gid = wgid / nig, fm = gid * WGM, gsz = (nM - fm) < WGM ? (nM - fm) : WGM;
    pm = fm + ((wgid % nig) % gsz); pn = (wgid % nig) / gsz;
}

template <class Epi, class Sched, bool ALIGN_EPI = true>
__device__ __forceinline__ void gemm_phase(PG8_LAS unsigned char* lds, const int K, const Sched& S, const Epi& E) {
    int tid = threadIdx.x; asm volatile("" : "+v"(tid));
    const int wid = __builtin_amdgcn_readfirstlane(tid >> 6), lane = tid & 63, wr = wid >> 2, wc = wid & 3, fr = lane & 15, fq = lane >> 4;
    const int nt = K / BK;
    unsigned voffB[2]; int RA[2]; unsigned CA[2];
#pragma unroll
    for (int i = 0; i < 2; ++i) { int R, C; stage_rc(tid * 16 + i * 8192, R, C); const int Rb = Epi::PERM ? ((R & ~31) + perm32(R & 31)) : R;
        RA[i] = R; CA[i] = (unsigned)C * 2u; voffB[i] = (unsigned)(Rb * K + C) * 2u; }
    unsigned vc[2][2], vn[2][2];
#define PG8_AOFF(dst, u) do { _Pragma("unroll") for (int _h = 0; _h < 2; ++_h) _Pragma("unroll") for (int _i = 0; _i < 2; ++_i) dst[_h][_i] = S.a_rowoff(u, _h * HALF + RA[_i], K) + CA[_i]; } while (0)
#define PG8_SEL(h) { last ? vn[h][0] : vc[h][0], last ? vn[h][1] : vc[h][1] }
    const size_t kstep = (size_t)(BK * 2);
    const size_t hstep = (size_t)HALF * K * 2;
    const unsigned ldsw = (unsigned)wid * 1024u;
    const int aoff = lds_byte(wr * 64 + fr, fq * 8), boff = lds_byte(wc * 32 + fr, fq * 8);
#define PG8_SA(b, h) (((b) * 2 + (h)) * HTB)
#define PG8_SB(b, h) ((4 + (b) * 2 + (h)) * HTB)
#define PG8_STAGE(bufoff, gbase, voff) do { _Pragma("unroll") for (int _i = 0; _i < 2; ++_i) \
        __builtin_amdgcn_global_load_lds((const unsigned*)((const char*)(gbase) + (voff)[_i]), (PG8_LAS unsigned*)(lds + (bufoff) + ldsw + _i * 8192), 16, 0, 0); } while (0)
#define PG8_LDA(dst, b, h) do { _Pragma("unroll") for (int m = 0; m < 4; ++m) _Pragma("unroll") for (int k = 0; k < 2; ++k) dst[m][k] = *(const PG8_LAS bf16x8*)(lds + PG8_SA(b, h) + aoff + m * 2048 + k * 1024); } while (0)
#define PG8_LDB(dst, b, h) do { _Pragma("unroll") for (int n = 0; n < 2; ++n) _Pragma("unroll") for (int k = 0; k < 2; ++k) dst[n][k] = *(const PG8_LAS bf16x8*)(lds + PG8_SB(b, h) + boff + n * 2048 + k * 1024); } while (0)
#define PG8_MMA(ai, bj, At, Bt) do { __builtin_amdgcn_s_setprio(1); _Pragma("unroll") for (int m = 0; m < 4; ++m) _Pragma("unroll") for (int n = 0; n < 2; ++n) _Pragma("unroll") for (int k = 0; k < 2; ++k) \
        acc[ai][bj][m][n] = __builtin_amdgcn_mfma_f32_16x16x32_bf16(Bt[n][k], At[m][k], acc[ai][bj][m][n], 0, 0, 0); __builtin_amdgcn_s_setprio(0); } while (0)
#define PG8_WAIT_V(n) asm volatile("s_waitcnt vmcnt(" #n ")" ::: "memory")
#define PG8_WAIT_L(n) asm volatile("s_waitcnt lgkmcnt(" #n ")" ::: "memory")
#define PG8_BAR __builtin_amdgcn_s_barrier()
#define PG8_SCHED __builtin_amdgcn_sched_barrier(0)
    Unit cur, nxt; int ui = 0;
    if (!S.next(0, cur)) return;
    f32x4 acc[2][2][4][2];
#pragma unroll
    for (int a = 0; a < 2; ++a)
#pragma unroll
        for (int b = 0; b < 2; ++b)
#pragma unroll
            for (int m = 0; m < 4; ++m)
#pragma unroll
                for (int n = 0; n < 2; ++n) acc[a][b][m][n] = (f32x4){0.f, 0.f, 0.f, 0.f};
    bf16x8 At[4][2], B0[2][2], B1[2][2];
    const char* cA = S.a_base(cur); const char* cB = S.b_base(cur);
    PG8_AOFF(vc, cur);
    PG8_STAGE(PG8_SB(0, 0), cB, voffB); PG8_STAGE(PG8_SB(0, 1), cB + hstep, voffB); PG8_STAGE(PG8_SA(0, 0), cA, vc[0]); PG8_STAGE(PG8_SA(0, 1), cA, vc[1]);
    if (wr == 1) PG8_BAR;
    PG8_WAIT_V(2); PG8_BAR;
    PG8_STAGE(PG8_SB(1, 0), cB + kstep, voffB); PG8_STAGE(PG8_SA(1, 0), cA + kstep, vc[0]); PG8_STAGE(PG8_SB(1, 1), cB + hstep + kstep, voffB);
    PG8_WAIT_V(6); PG8_BAR;
    for (;;) {
        const bool has_next = S.next(ui + 1, nxt);
        const char* nA = has_next ? S.a_base(nxt) : cA; const char* nB = has_next ? S.b_base(nxt) : cB;
        if (has_next) PG8_AOFF(vn, nxt); else { vn[0][0] = vc[0][0]; vn[0][1] = vc[0][1]; vn[1][0] = vc[1][0]; vn[1][1] = vc[1][1]; }
        for (int t = 0; t < nt; t += 2) {
            const bool last = (t == nt - 2);
            const char* a1 = cA + (size_t)(t + 1) * kstep;
            const char* a2 = last ? nA : cA + (size_t)(t + 2) * kstep; const char* b2 = last ? nB : cB + (size_t)(t + 2) * kstep;
            const char* a3 = a2 + kstep; const char* b3 = b2 + kstep;
            PG8_LDB(B0, 0, 0); PG8_LDB(B1, 0, 1); PG8_SCHED; PG8_LDA(At, 0, 0); PG8_STAGE(PG8_SA(1, 1), a1, vc[1]);
            PG8_WAIT_V(8); PG8_WAIT_L(0); PG8_BAR; PG8_MMA(0, 0, At, B0); PG8_MMA(0, 1, At, B1); PG8_BAR; PG8_SCHED;
            PG8_LDA(At, 0, 1); PG8_STAGE(PG8_SB(0, 0), b2, voffB); PG8_STAGE(PG8_SB(0, 1), b2 + hstep, voffB); { const unsigned vs[2] = PG8_SEL(0); PG8_STAGE(PG8_SA(0, 0), a2, vs); }
            PG8_WAIT_V(8); PG8_WAIT_L(0); PG8_BAR; PG8_MMA(1, 0, At, B0); PG8_MMA(1, 1, At, B1); PG8_BAR; PG8_SCHED;
            PG8_LDB(B0, 1, 0); PG8_LDB(B1, 1, 1); PG8_SCHED; PG8_LDA(At, 1, 0); { const unsigned vs[2] = PG8_SEL(1); PG8_STAGE(PG8_SA(0, 1), a2, vs); }
            PG8_WAIT_V(8); PG8_WAIT_L(0); PG8_BAR; PG8_MMA(0, 0, At, B0); PG8_MMA(0, 1, At, B1); PG8_BAR; PG8_SCHED;
            PG8_LDA(At, 1, 1); PG8_STAGE(PG8_SB(1, 0), b3, voffB); PG8_STAGE(PG8_SB(1, 1), b3 + hstep, voffB); { const unsigned vs[2] = PG8_SEL(0); PG8_STAGE(PG8_SA(1, 0), a3, vs); }
            PG8_WAIT_V(8); PG8_WAIT_L(0); PG8_BAR; PG8_MMA(1, 0, At, B0); PG8_MMA(1, 1, At, B1); PG8_BAR; PG8_SCHED;
        }
        if constexpr (ALIGN_EPI) { if (wr == 0) PG8_BAR; }
        E(acc, cur, wr, wc, fr, fq);
        if (!has_next) break;
        if (!(Epi::CHAIN && cur.aux == 0)) {
#pragma unroll
        for (int a = 0; a < 2; ++a)
#pragma unroll
            for (int b = 0; b < 2; ++b)
#pragma unroll
                for (int m = 0; m < 4; ++m)
#pragma unroll
                    for (int n = 0; n < 2; ++n) acc[a][b][m][n] = (f32x4){0.f, 0.f, 0.f, 0.f};
        }
        cur = nxt; cA = nA; cB = nB; ++ui; vc[0][0] = vn[0][0]; vc[0][1] = vn[0][1]; vc[1][0] = vn[1][0]; vc[1][1] = vn[1][1];
        if constexpr (ALIGN_EPI) { if (wr == 1) PG8_BAR; }
    }
    PG8_WAIT_V(0);
    if constexpr (!ALIGN_EPI) { if (wr == 0) PG8_BAR; }
    PG8_BAR;
#undef PG8_AOFF
#undef PG8_SEL
#undef PG8_SA
#undef PG8_SB
#undef PG8_STAGE
#undef PG8_LDA
#undef PG8_LDB
#undef PG8_MMA
#undef PG8_WAIT_V
#undef PG8_WAIT_L
#undef PG8_BAR
#undef PG8_SCHED
}
}

struct SWin {
    const bf16_t* U; const bf16_t* W; int G, c;
    __device__ __forceinline__ bool next(int i, pg8::Unit& u) const { const int L = i * G + c; if (L < 128 * 19) { pg8::grid_order(L, 128, 19, u.pm, u.pn); u.aux = 0; return true; }
        const int r = L - 128 * 19; if (r >= 72) return false; u.pm = 128 + (r & 7); u.pn = r >> 3; u.aux = 0; return true; }
    __device__ __forceinline__ const char* a_base(const pg8::Unit& u) const { return (const char*)(U + (size_t)u.pm * 256 * D); }
    __device__ __forceinline__ unsigned a_rowoff(const pg8::Unit&, int r, int K) const { return (unsigned)(r * K) * 2u; }
    __device__ __forceinline__ const char* b_base(const pg8::Unit& u) const { return (const char*)(W + (size_t)u.pn * 256 * D); }
};
struct EWin {
    static constexpr bool PERM = true; static constexpr bool CHAIN = false;
    bf16_t* RW; bf16_t* XB; bf16_t* GB; bf16_t* GT; bf16_t* SIDE;
    __device__ __forceinline__ void operator()(const f32x4 (&acc)[2][2][4][2], const pg8::Unit& u, int wr, int wc, int fr, int fq) const {
        const int row0 = u.pm * 256 + wr * 64 + fr, colt = u.pn * 256, cl = wc * 32 + 8 * fq;
        bf16_t* base; int ldc, act;
        if (colt < 1792) { base = RW + colt; ldc = RW_COLS; act = 0; } else if (colt < 2304) { base = XB + (colt - 1792); ldc = LWD; act = 0; }
        else if (colt < 2816) { base = GB + (colt - 2304); ldc = LWD; act = 1; } else { base = GT + (colt - 2816); ldc = 2048; act = 2; }
        if (act == 2) {
            const int t_ = (colt - 2816) >> 8;
#pragma unroll
            for (int ai = 0; ai < 2; ++ai)
#pragma unroll
                for (int m = 0; m < 4; ++m) { bf16_t* rowp = GT + (size_t)(row0 + ai * 128 + m * 16) * 2048 + t_ * 128 + cl; float ra[8], sb[8];
#pragma unroll
                    for (int j = 0; j < 4; ++j) { const float b0_ = fsigmoid(acc[ai][1][m][0][j]), b1_ = fsigmoid(acc[ai][1][m][1][j]); sb[j] = b0_; sb[4 + j] = b1_;
                        ra[j] = fsigmoid(acc[ai][0][m][0][j]) * __builtin_amdgcn_rcpf(fmaxf(b0_, 1e-20f)); ra[4 + j] = fsigmoid(acc[ai][0][m][1][j]) * __builtin_amdgcn_rcpf(fmaxf(b1_, 1e-20f)); }
                    u32x4 wr_, wb_; wr_.x = pk2(ra[0], ra[1]); wr_.y = pk2(ra[2], ra[3]); wr_.z = pk2(ra[4], ra[5]); wr_.w = pk2(ra[6], ra[7]); wb_.x = pk2(sb[0], sb[1]); wb_.y = pk2(sb[2], sb[3]); wb_.z = pk2(sb[4], sb[5]); wb_.w = pk2(sb[6], sb[7]);
                    __builtin_nontemporal_store(wr_, (u32x4*)rowp); __builtin_nontemporal_store(wb_, (u32x4*)(rowp + 1024)); }
            return; }
#pragma unroll
        for (int ai = 0; ai < 2; ++ai)
#pragma unroll
            for (int m = 0; m < 4; ++m) { bf16_t* rowp = base + (size_t)(row0 + ai * 128 + m * 16) * ldc + cl;
#pragma unroll
                for (int bj = 0; bj < 2; ++bj) { f32x4 v0 = acc[ai][bj][m][0], v1 = acc[ai][bj][m][1];
                    if (act == 1) {
#pragma unroll
                        for (int j = 0; j < 4; ++j) { v0[j] = fgelu_tanh(v0[j]); v1[j] = fgelu_tanh(v1[j]); } }
                    u32x4 w; w.x = pk2(v0[0], v0[1]); w.y = pk2(v0[2], v0[3]); w.z = pk2(v1[0], v1[1]); w.w = pk2(v1[2], v1[3]);
                    __builtin_nontemporal_store(w, (u32x4*)(rowp + bj * 128));
                    if (colt < 1792 && fr == ((m & 1) ? 15 : 0)) { const int r = row0 + ai * 128 + m * 16;
                        *(u32x4*)(SIDE + ((size_t)(r >> 5) * 2 + (m & 1)) * RW_COLS + colt + cl + bj * 128) = w; } } }
    }
};
struct SProj {
    const bf16_t* O; const bf16_t* HL; const bf16_t* Wr; const bf16_t* Wl; int G, c;
    __device__ __forceinline__ bool next(int i, pg8::Unit& u) const { const int L = (i >> 1) * G + c; if (L >= 128 * 4) return false; pg8::grid_order(L, 128, 4, u.pm, u.pn); u.aux = i & 1; return true; }
    __device__ __forceinline__ const char* a_base(const pg8::Unit& u) const { return (const char*)((u.aux ? HL : O) + (size_t)u.pm * 256 * 512); }
    __device__ __forceinline__ unsigned a_rowoff(const pg8::Unit&, int r, int K) const { return (unsigned)(r * K) * 2u; }
    __device__ __forceinline__ const char* b_base(const pg8::Unit& u) const { return (const char*)((u.aux ? Wl : Wr) + (size_t)u.pn * 256 * 512); }
};
struct EProj {
    static constexpr bool PERM = true; static constexpr bool CHAIN = true;
    const bf16_t* GT; bf16_t* MG;
    __device__ __forceinline__ void operator()(f32x4 (&acc)[2][2][4][2], const pg8::Unit& u, int wr, int wc, int fr, int fq) const {
        const int row0 = u.pm * 256 + wr * 64 + fr, col0 = u.pn * 256 + wc * 32 + 8 * fq;
        const bool first = u.aux == 0; const bf16_t* __restrict__ gt = GT + (first ? 0 : 1024); bf16_t* __restrict__ mg = MG;
#pragma unroll
        for (int ai = 0; ai < 2; ++ai) {
            u32x4 gq[4][2];
#pragma unroll
            for (int m = 0; m < 4; ++m) { const size_t r = (size_t)(row0 + ai * 128 + m * 16);
#pragma unroll
                for (int bj = 0; bj < 2; ++bj) gq[m][bj] = *(const u32x4*)(gt + r * 2048 + col0 + bj * 128); }
            asm volatile("" ::: "memory");
#pragma unroll
            for (int m = 0; m < 4; ++m) { const size_t r = (size_t)(row0 + ai * 128 + m * 16);
#pragma unroll
                for (int bj = 0; bj < 2; ++bj) { const int cc = col0 + bj * 128; float g[8]; { const u32x4 a_ = gq[m][bj];
#pragma unroll
                        for (int e = 0; e < 4; ++e) { g[2 * e] = __builtin_bit_cast(float, a_[e] << 16); g[2 * e + 1] = __builtin_bit_cast(float, a_[e] & 0xffff0000u); } }
                    if (first) {
#pragma unroll
                        for (int j = 0; j < 4; ++j) { acc[ai][bj][m][0][j] *= g[j]; acc[ai][bj][m][1][j] *= g[4 + j]; }
                    } else {
                        const f32x4 a0_ = acc[ai][bj][m][0], a1_ = acc[ai][bj][m][1];
                        u32x4 w; w.x = pk2(fmaxf(g[0], 1e-20f) * a0_[0], fmaxf(g[1], 1e-20f) * a0_[1]); w.y = pk2(fmaxf(g[2], 1e-20f) * a0_[2], fmaxf(g[3], 1e-20f) * a0_[3]);
                        w.z = pk2(fmaxf(g[4], 1e-20f) * a1_[0], fmaxf(g[5], 1e-20f) * a1_[1]); w.w = pk2(fmaxf(g[6], 1e-20f) * a1_[2], fmaxf(g[7], 1e-20f) * a1_[3]);
                        *(u32x4*)(mg + r * D + cc) = w; } } } }
    }
};
struct SWout {
    const bf16_t* MG; const bf16_t* W; int G, c;
    __device__ __forceinline__ bool next(int i, pg8::Unit& u) const { const int L = i * G + c; if (L >= 128 * 4) return false; pg8::grid_order(L, 128, 4, u.pm, u.pn); u.aux = 0; return true; }
    __device__ __forceinline__ const char* a_base(const pg8::Unit& u) const { return (const char*)(MG + (size_t)u.pm * 256 * D); }
    __device__ __forceinline__ unsigned a_rowoff(const pg8::Unit&, int r, int K) const { return (unsigned)(r * K) * 2u; }
    __device__ __forceinline__ const char* b_base(const pg8::Unit& u) const { return (const char*)(W + (size_t)u.pn * 256 * D); }
};
struct EWout {
    static constexpr bool PERM = false; static constexpr bool CHAIN = false;
    const float* x; const float* MOD; float* XMID; float* SSQ;
    __device__ __forceinline__ void operator()(const f32x4 (&acc)[2][2][4][2], const pg8::Unit& u, int wr, int wc, int fr, int fq) const {
        const int row0 = u.pm * 256 + wr * 64 + fr, col0 = u.pn * 256 + wc * 32 + 4 * fq; const float* gt1 = MOD + (size_t)(u.pm >> 4) * 6144 + 2048;
        f32x4 gv[2][2];
#pragma unroll
        for (int bj = 0; bj < 2; ++bj)
#pragma unroll
            for (int n = 0; n < 2; ++n) gv[bj][n] = *(const f32x4*)(gt1 + col0 + bj * 128 + n * 16);
        const float* __restrict__ xin = x; float* __restrict__ xo = XMID; float* __restrict__ sq = SSQ;
#pragma unroll
        for (int ai = 0; ai < 2; ++ai)
#pragma unroll
            for (int mp = 0; mp < 4; mp += 2) {
                f32x4 xv[2][2][2];
#pragma unroll
                for (int mm = 0; mm < 2; ++mm) { const size_t off = (size_t)(row0 + ai * 128 + (mp + mm) * 16) * D + col0;
#pragma unroll
                    for (int bj = 0; bj < 2; ++bj)
#pragma unroll
                        for (int n = 0; n < 2; ++n) xv[mm][bj][n] = *(const f32x4*)(xin + off + bj * 128 + n * 16); }
                asm volatile("" ::: "memory");
#pragma unroll
                for (int mm = 0; mm < 2; ++mm) { const int m = mp + mm; const size_t row = (size_t)(row0 + ai * 128 + m * 16), off = row * D + col0; float ss = 0.f;
#pragma unroll
                    for (int bj = 0; bj < 2; ++bj)
#pragma unroll
                        for (int n = 0; n < 2; ++n) { const f32x4 v = xv[mm][bj][n] + gv[bj][n] * acc[ai][bj][m][n]; __builtin_nontemporal_store(v, (f32x4*)(xo + off + bj * 128 + n * 16)); ss += (v.x * v.x + v.y * v.y) + (v.z * v.z + v.w * v.w); }
                    ss += __shfl_xor(ss, 16); ss += __shfl_xor(ss, 32);
                    if (fq == 0) sq[row * 16 + u.pn * 4 + wc] = ss; } }
    }
};
struct SMoe1 {
    const bf16_t* H2; const bf16_t* W13; const int* IDX; int G, c;
    __device__ __forceinline__ bool next(int i, pg8::Unit& u) const { const int L = i * G + c; if (L >= 256 * 8) return false; pg8::grid_order(L, 256, 8, u.pm, u.pn); u.aux = (u.pm >> 1) & 15; return true; }
    __device__ __forceinline__ const char* a_base(const pg8::Unit&) const { return (const char*)H2; }
    __device__ __forceinline__ unsigned a_rowoff(const pg8::Unit& u, int r, int K) const { return (unsigned)((u.pm >> 5) * T + IDX[u.pm * 256 + r]) * (unsigned)(K * 2); }
    __device__ __forceinline__ const char* b_base(const pg8::Unit& u) const { return (const char*)(W13 + ((size_t)u.aux * 2048 + (size_t)u.pn * 256) * D); }
};
struct EMoe1 {
    static constexpr bool PERM = true; static constexpr bool CHAIN = false;
    bf16_t* HID;
    __device__ __forceinline__ void operator()(const f32x4 (&acc)[2][2][4][2], const pg8::Unit& u, int wr, int wc, int fr, int fq) const {
        const int row0 = u.pm * 256 + wr * 64 + fr, col0 = u.pn * 128 + wc * 32 + 8 * fq;
#pragma unroll
        for (int ai = 0; ai < 2; ++ai)
#pragma unroll
            for (int m = 0; m < 4; ++m) { bf16_t* rowp = HID + (size_t)(row0 + ai * 128 + m * 16) * DE + col0;
                const f32x4 a0 = acc[ai][0][m][0], a1 = acc[ai][0][m][1], b0 = acc[ai][1][m][0], b1 = acc[ai][1][m][1]; u32x4 w;
                w.x = pk2(fsilu(a0[0]) * b0[0], fsilu(a0[1]) * b0[1]); w.y = pk2(fsilu(a0[2]) * b0[2], fsilu(a0[3]) * b0[3]); w.z = pk2(fsilu(a1[0]) * b1[0], fsilu(a1[1]) * b1[1]); w.w = pk2(fsilu(a1[2]) * b1[2], fsilu(a1[3]) * b1[3]);
                __builtin_nontemporal_store(w, (u32x4*)rowp); }
    }
};
struct SMoe2 {
    const bf16_t* HID; const bf16_t* W2; int G, c;
    __device__ __forceinline__ bool next(int i, pg8::Unit& u) const { const int L = i * G + c; if (L >= 256 * 4) return false; pg8::grid_order(L, 256, 4, u.pm, u.pn); u.aux = (u.pm >> 1) & 15; return true; }
    __device__ __forceinline__ const char* a_base(const pg8::Unit& u) const { return (const char*)(HID + (size_t)u.pm * 256 * DE); }
    __device__ __forceinline__ unsigned a_rowoff(const pg8::Unit&, int r, int K) const { return (unsigned)(r * K) * 2u; }
    __device__ __forceinline__ const char* b_base(const pg8::Unit& u) const { return (const char*)(W2 + ((size_t)u.aux * D + (size_t)u.pn * 256) * DE); }
};
struct EMoe2 {
    static constexpr bool PERM = true; static constexpr bool CHAIN = false;
    const float* GATE; bf16_t* YE;
    __device__ __forceinline__ void operator()(const f32x4 (&acc)[2][2][4][2], const pg8::Unit& u, int wr, int wc, int fr, int fq) const {
        const int row0 = u.pm * 256 + wr * 64 + fr, col0 = u.pn * 256 + wc * 32 + 8 * fq;
        float gts[2][4]; { const float* __restrict__ gp_ = GATE;
#pragma unroll
            for (int ai = 0; ai < 2; ++ai)
#pragma unroll
                for (int m = 0; m < 4; ++m) gts[ai][m] = gp_[row0 + ai * 128 + m * 16]; }
        asm volatile("" ::: "memory");
#pragma unroll
        for (int ai = 0; ai < 2; ++ai)
#pragma unroll
            for (int m = 0; m < 4; ++m) { const int r = row0 + ai * 128 + m * 16; const float gt = gts[ai][m]; bf16_t* rowp = YE + (size_t)r * D + col0;
#pragma unroll
                for (int bj = 0; bj < 2; ++bj) { const f32x4 v0 = acc[ai][bj][m][0] * gt, v1 = acc[ai][bj][m][1] * gt;
                    u32x4 w; w.x = pk2(v0[0], v0[1]); w.y = pk2(v0[2], v0[3]); w.z = pk2(v1[0], v1[1]); w.w = pk2(v1[2], v1[3]);
                    __builtin_nontemporal_store(w, (u32x4*)(rowp + bj * 128)); } }
    }
};
#ifndef PROBE
#define PROBE (-1)
#endif
#define LAS __attribute__((address_space(3)))
__device__ __forceinline__ int otid() { int t = threadIdx.x; asm volatile("" : "+v"(t)); return t; }
#define XB_TMO      128
#define XB_XCNT(j)  (256  + 64 * (j))
#define XB_XSUB(j)  (1280 + 64 * (j))
#define XB_XGEN(j)  (2304 + 64 * (j))
#define XB_TOP      3328
#define XB_TOPGEN   3392
#define XCD_BAR_WORDS 3456
#define XB_SPIN_CAP (1u << 22)
__device__ __forceinline__ unsigned xb_ld(unsigned* p)              { return __hip_atomic_load(p, __ATOMIC_RELAXED, __HIP_MEMORY_SCOPE_AGENT); }
__device__ __forceinline__ unsigned xb_add(unsigned* p, unsigned v) { return __hip_atomic_fetch_add(p, v, __ATOMIC_RELAXED, __HIP_MEMORY_SCOPE_AGENT); }
__device__ __forceinline__ unsigned xb_xcc_id() { return (unsigned)__builtin_amdgcn_s_getreg((3 << 11) | 20) & 0xFu; }
#define XB_SPIN(cond, bar) do { unsigned _sp = 0; while (cond) { __builtin_amdgcn_s_sleep(1); \
    if ((++_sp & 255u) == 0u) { if (xb_ld(&(bar)[XB_TMO])) break; if (_sp > XB_SPIN_CAP) { atomicAdd(&(bar)[XB_TMO], 1u); break; } } } } while (0)
struct XcdBarrier { unsigned* bar; unsigned x; volatile LAS unsigned* st; };
__device__ __forceinline__ XcdBarrier xcd_barrier_post(unsigned* bar, volatile LAS unsigned* st) {
    XcdBarrier b; b.bar = bar; b.x = xb_xcc_id(); b.st = st;
    if (threadIdx.x == 0) (void)xb_add(&bar[XB_XCNT(b.x)], 1u);
    return b;
}
__device__ __forceinline__ void xcd_barrier_complete(unsigned* bar, unsigned x, unsigned& nloc, unsigned& nx) {
    const unsigned G = gridDim.x * gridDim.y * gridDim.z;
    unsigned sum, cnt, mine, sp = 0u;
    for (;;) {
        sum = 0u; cnt = 0u; mine = 0u;
#pragma unroll
        for (unsigned j = 0; j < 16; ++j) { const unsigned c = xb_ld(&bar[XB_XCNT(j)]); sum += c; cnt += (c > 0u) ? 1u : 0u; mine = (j == x) ? c : mine; }
        if (sum == G) break;
        __builtin_amdgcn_s_sleep(1);
        if ((++sp & 255u) == 0u) { if (xb_ld(&bar[XB_TMO])) break; if (sp > XB_SPIN_CAP) { atomicAdd(&bar[XB_TMO], 1u); break; } }
    }
    nloc = mine > 0u ? mine : 1u; nx = cnt > 0u ? cnt : 1u;
}
__device__ __forceinline__ void xcd_barrier(const XcdBarrier& b) {
    asm volatile("s_waitcnt vmcnt(0)" ::: "memory");
    __syncthreads();
    if (threadIdx.x == 0) {
        unsigned* bar = b.bar;
        __builtin_amdgcn_s_waitcnt(0);
        unsigned nloc = b.st[0], nx = b.st[1];
        if (nloc == 0u) { xcd_barrier_complete(bar, b.x, nloc, nx); b.st[0] = nloc; b.st[1] = nx; }
        const unsigned old = xb_add(&bar[XB_XSUB(b.x)], 1u);
        const unsigned gen = old / nloc;
        if (old + 1u == (gen + 1u) * nloc) {
            __builtin_amdgcn_fence(__ATOMIC_RELEASE, "agent");
            asm volatile("s_waitcnt vmcnt(0)" ::: "memory");
            const unsigned og = xb_add(&bar[XB_TOP], 1u);
            const unsigned tg = og / nx;
            if (og + 1u == (tg + 1u) * nx) xb_add(&bar[XB_TOPGEN], 1u);
            else XB_SPIN(xb_ld(&bar[XB_TOPGEN]) == tg, bar);
            __builtin_amdgcn_fence(__ATOMIC_ACQUIRE, "agent");
            xb_add(&bar[XB_XGEN(b.x)], 1u);
            asm volatile("s_waitcnt vmcnt(0)" ::: "memory");
        } else {
            XB_SPIN(xb_ld(&bar[XB_XGEN(b.x)]) == gen, bar);
            __builtin_amdgcn_fence(__ATOMIC_ACQUIRE, "agent");
            asm volatile("s_waitcnt vmcnt(0)" ::: "memory");
        }
    }
    __syncthreads();
}

struct Args { const float* in[35]; float* out; unsigned char* ws; };

__device__ __forceinline__ void phase_modvec(const float* __restrict__ c, const float* __restrict__ c_ctx, const float* __restrict__ w_mod, const float* __restrict__ b_mod, float* __restrict__ MOD, unsigned char* lds, int bid, int nb) {
    float (*sv)[1024] = (float (*)[1024])lds; float (*red)[9][32] = (float (*)[9][32])(lds + 9 * 1024 * 4);
    const int tid = otid(), lane = tid & 63, w = tid >> 6;
    if (bid >= 192) return;
    for (int i = tid; i < 9 * 1024; i += 512) { const int r = i >> 10, k = i & 1023; const float v = r < 8 ? c[r * 1024 + k] : c_ctx[k]; sv[r][k] = siluf_(v); }
    __syncthreads();
    for (int item = bid; item < 192; item += nb) {
        const int col = item * 32 + (lane & 31), kg = w * 2 + (lane >> 5);
        float acc[9];
#pragma unroll
        for (int r = 0; r < 9; ++r) acc[r] = 0.f;
        float wvv[64];
#pragma unroll
        for (int kk = 0; kk < 64; ++kk) wvv[kk] = w_mod[(size_t)(kg * 64 + kk) * 6144 + col];
        asm volatile("" ::: "memory");
#pragma unroll
        for (int kk = 0; kk < 64; ++kk) { const int k = kg * 64 + kk;
#pragma unroll
            for (int r = 0; r < 9; ++r) acc[r] += sv[r][k] * wvv[kk]; }
#pragma unroll
        for (int r = 0; r < 9; ++r) red[kg][r][lane & 31] = acc[r];
        __syncthreads();
        if (tid < 288) { const int r = tid >> 5, cc = tid & 31; float s = b_mod[item * 32 + cc];
#pragma unroll
            for (int g = 0; g < 16; ++g) s += red[g][r][cc];
            MOD[r * 6144 + item * 32 + cc] = s; }
        __syncthreads();
    }
}
__device__ __forceinline__ void phase_wconv(const float* __restrict__ src0, bf16_t* __restrict__ dst0, int K, int N, int rmul, int radd, int nbatch, size_t sstride, size_t dstride, unsigned char* lds, int bid, int nb, int gsplit = -1) {
    const int tid = otid(), lane = tid & 63, wv = tid >> 6, gw = bid * 8 + wv, NGW = nb * 8, nkt = K / 64, nnt = N / 64, per = nkt * nnt;
    u32x4* wl = (u32x4*)(lds + wv * 9216);
    for (int it = gw; it < per * nbatch; it += NGW) {
        const int bt = it / per, r = it % per; const float* src = src0 + (size_t)bt * sstride; bf16_t* dst = dst0 + (size_t)bt * dstride;
        const int k0 = (r / nnt) * 64, n0 = (r % nnt) * 64;
        const float* sp = src + (size_t)k0 * N + n0 + lane; float v[64];
#pragma unroll
        for (int i = 0; i < 64; ++i) v[i] = sp[(size_t)i * N];
#pragma unroll
        for (int c = 0; c < 8; ++c) { u32x4 o; o.x = pk2(v[8 * c], v[8 * c + 1]); o.y = pk2(v[8 * c + 2], v[8 * c + 3]); o.z = pk2(v[8 * c + 4], v[8 * c + 5]); o.w = pk2(v[8 * c + 6], v[8 * c + 7]); wl[lane * 9 + c] = o; }
        asm volatile("s_waitcnt lgkmcnt(0)" ::: "memory");
#pragma unroll
        for (int j = 0; j < 8; ++j) { const int n = (lane >> 3) + 8 * j, c = lane & 7; const u32x4 o = wl[n * 9 + c];
            const int nn = n0 + n; int row = (nn >> 2) * rmul + (nn & 3) + radd;
            if (gsplit >= 0 && nn >= gsplit) { const int g_ = nn - gsplit, gg = g_ & 1023; row = gsplit + (gg >> 7) * 256 + (g_ >> 10) * 128 + (gg & 127); }
            *(u32x4*)(dst + (size_t)row * K + k0 + 8 * c) = o; }
        asm volatile("s_waitcnt lgkmcnt(0)" ::: "memory");
    }
}
__device__ __forceinline__ void phase_normmod(const float* __restrict__ x, const float* __restrict__ ctx, const float* __restrict__ g1, const float* __restrict__ MOD, bf16_t* __restrict__ U, int bid, int nb) {
    const int tid = otid(), lane = tid & 63, gw = bid * 8 + (tid >> 6), NGW = nb * 8;
    for (int r0 = gw * 4; r0 < NTOK; r0 += NGW * 4) {
        const float* src = r0 < NLAT ? x + (size_t)r0 * D : ctx + (size_t)(r0 - NLAT) * D;
        f32x4 v[4][4]; float ss[4];
#pragma unroll
        for (int q = 0; q < 4; ++q) { ss[q] = 0.f;
#pragma unroll
            for (int j = 0; j < 4; ++j) { v[q][j] = __builtin_nontemporal_load(&((const f32x4*)(src + (size_t)q * D))[lane + 64 * j]); } }
#pragma unroll
        for (int q = 0; q < 4; ++q) {
#pragma unroll
            for (int j = 0; j < 4; ++j) ss[q] += (v[q][j].x * v[q][j].x + v[q][j].y * v[q][j].y) + (v[q][j].z * v[q][j].z + v[q][j].w * v[q][j].w); }
        const float* mr = MOD + (size_t)(r0 < NLAT ? r0 / T : 8) * 6144;
        f32x4 gq[4], shq[4], scq[4];
#pragma unroll
        for (int j = 0; j < 4; ++j) { gq[j] = ((const f32x4*)g1)[lane + 64 * j]; shq[j] = ((const f32x4*)mr)[lane + 64 * j]; scq[j] = ((const f32x4*)(mr + 1024))[lane + 64 * j]; }
        asm volatile("" ::: "memory");
#pragma unroll
        for (int q = 0; q < 4; ++q) { const int r = r0 + q;
            const float rstd = rsqrtf(wave_sum(ss[q]) * (1.f / D) + RMS_EPS);
#pragma unroll
            for (int j = 0; j < 4; ++j) { const f32x4 o = (v[q][j] * rstd * gq[j]) * (scq[j] + 1.f) + shq[j]; u32x2 w; w.x = pk2(o.x, o.y); w.y = pk2(o.z, o.w);
                ((u32x2*)(U + (size_t)r * D))[lane + 64 * j] = w; } }
    }
}
template <int CTRL> __device__ __forceinline__ float dpp_mov(float x) { return __builtin_bit_cast(float, __builtin_amdgcn_update_dpp(0, __builtin_bit_cast(int, x), CTRL, 0xF, 0xF, true)); }
__device__ __forceinline__ float red16(float x) { x += dpp_mov<0xB1>(x); x += dpp_mov<0x4E>(x); x += dpp_mov<0x141>(x); x += dpp_mov<0x140>(x); return x; }
__device__ __forceinline__ float fmul_s(float a, float b) { float r; asm("v_mul_f32_e32 %0, %1, %2" : "=v"(r) : "v"(a), "v"(b)); return r; }
__device__ __forceinline__ float ffma_s(float a, float b, float c) { float r; asm("v_fma_f32 %0, %1, %2, %3" : "=v"(r) : "v"(a), "v"(b), "v"(c)); return r; }
__device__ __forceinline__ float fnma_s(float a, float b, float c) { float r; asm("v_fma_f32 %0, -%1, %2, %3" : "=v"(r) : "v"(a), "v"(b), "v"(c)); return r; }
__device__ __forceinline__ float ftanh(float x) { return 2.f * fsigmoid(2.f * x) - 1.f; }
__device__ __forceinline__ void unpack8(const u32x4 v, float (&f)[8]) {
    f[0] = __builtin_bit_cast(float, v.x << 16); f[1] = __builtin_bit_cast(float, v.x & 0xffff0000u); f[2] = __builtin_bit_cast(float, v.y << 16); f[3] = __builtin_bit_cast(float, v.y & 0xffff0000u);
    f[4] = __builtin_bit_cast(float, v.z << 16); f[5] = __builtin_bit_cast(float, v.z & 0xffff0000u); f[6] = __builtin_bit_cast(float, v.w << 16); f[7] = __builtin_bit_cast(float, v.w & 0xffff0000u); }
__device__ __forceinline__ void phase_lru_seq(const bf16_t* __restrict__ XB, bf16_t* __restrict__ H0, bf16_t* __restrict__ H1, const float* __restrict__ conv_w, const float* __restrict__ conv_b, const bf16_t* __restrict__ WAT,
                                              const float* __restrict__ ba, const bf16_t* __restrict__ WXT, const float* __restrict__ bx, const float* __restrict__ lam, const bf16_t* __restrict__ GB, bf16_t* __restrict__ HL, const bool fuse, unsigned char* lds, int bid, int nb) {
    const int tid = otid(), lane = tid & 63, w = __builtin_amdgcn_readfirstlane(tid >> 6), fr = lane & 15, fq = lane >> 4;
    bf16_t* RAW = (bf16_t*)(lds + w * 18944);
    bf16_t* XC = (bf16_t*)(lds + w * 18944 + 9728);
    float* CW = (float*)(lds + 151552);
    float* TOT = (float*)(lds + 152832);
    for (int item = bid; item < 256; item += nb) {
        const int blk = item & 127, d = item >> 7, b = blk >> 4, g = (blk >> 1) & 7, half = blk & 1;
        bf16_t* Hd = d ? H1 : H0;
        asm volatile("s_waitcnt vmcnt(0)" ::: "memory");
        __syncthreads();
        float cwr[5][8];
#pragma unroll
        for (int k = 0; k < 5; ++k)
#pragma unroll
            for (int e = 0; e < 8; ++e) cwr[k][e] = k < 4 ? conv_w[(d * 4 + k) * 512 + g * 64 + 8 * (lane & 7) + e] : conv_b[d * 512 + g * 64 + 8 * (lane & 7) + e];
        bf16x8 waf[2][2], wxf[2][2]; float bav[2], bxv[2], spv[2], hcar[2];
#pragma unroll
        for (int mt = 0; mt < 2; ++mt) { const int co = half * 32 + 16 * mt + fr, cg = d * 512 + g * 64 + co; bav[mt] = ba[cg]; bxv[mt] = bx[cg]; spv[mt] = softplusf_(-lam[cg]); hcar[mt] = 0.f;
#pragma unroll
            for (int ks = 0; ks < 2; ++ks) { const size_t off = (((size_t)d * 8 + g) * 64 + co) * 64 + ks * 32 + fq * 8; waf[mt][ks] = *(const bf16x8*)(WAT + off); wxf[mt][ks] = *(const bf16x8*)(WXT + off); } }
        __syncthreads();
        for (int sc = 0; sc < 9; ++sc) {
            const int ch = sc * 8 + w; const bool active = ch < 68; const bool isctx = ch < 4; const int len = isctx ? TC : T; const int s0 = isctx ? ch * 64 : (ch - 4) * 64;
            float Atot[2] = {1.f, 1.f}, Btot[2] = {0.f, 0.f}, Aex[2] = {1.f, 1.f}, Bex[2] = {0.f, 0.f};
            float av[2][16], bv[2][16];
            if (active) {
                { const int lr = lane >> 3, lc = lane & 7; const u32x4 z = {0u, 0u, 0u, 0u}; u32x4 rr9[9];
#pragma unroll
                  for (int g8 = 0; g8 < 9; ++g8) { const int rrow = 8 * g8 + lr < 67 ? 8 * g8 + lr : 66, sh = s0 - 3 + rrow, shc = sh >= 0 ? sh : 0; const int i = d ? len - 1 - shc : shc;
                      const unsigned row = isctx ? (unsigned)(NLAT + b * TC + i) : (unsigned)(b * T + ((i & 63) * 64 + (i >> 6)));
                      const u32x4 ld_ = *(const u32x4*)((const char*)XB + (row * (unsigned)(LWD * 2) + (unsigned)(g * 128 + 16 * lc))); rr9[g8] = sh >= 0 ? ld_ : z; }
#pragma unroll
                  for (int g8 = 0; g8 < 9; ++g8) { const int rrow = 8 * g8 + lr; if (rrow < 67) *(u32x4*)(RAW + rrow * 72 + 8 * lc) = rr9[g8]; } }
                { const int j8 = lane & 7, p0 = 8 * (lane >> 3); float win[4][8];
#pragma unroll
                  for (int q = 0; q < 3; ++q) unpack8(*(const u32x4*)(RAW + (p0 + q) * 72 + 8 * j8), win[q]);
#pragma unroll
                  for (int q = 0; q < 8; ++q) { const int s = p0 + q, rho = 16 * ((s >> 2) & 3) + 4 * (s >> 4) + (s & 3); unpack8(*(const u32x4*)(RAW + (s + 3) * 72 + 8 * j8), win[(q + 3) & 3]);
                      float o[8];
#pragma unroll
                      for (int e = 0; e < 8; ++e) o[e] = cwr[4][e] + cwr[0][e] * win[q & 3][e] + cwr[1][e] * win[(q + 1) & 3][e] + cwr[2][e] * win[(q + 2) & 3][e] + cwr[3][e] * win[(q + 3) & 3][e];
                      u32x4 pk; pk.x = pk2(o[0], o[1]); pk.y = pk2(o[2], o[3]); pk.z = pk2(o[4], o[5]); pk.w = pk2(o[6], o[7]); *(u32x4*)(XC + rho * 72 + 8 * j8) = pk; } }
                f32x4 pa[2][4], px[2][4];
#pragma unroll
                for (int mt = 0; mt < 2; ++mt)
#pragma unroll
                    for (int nt = 0; nt < 4; ++nt) { pa[mt][nt] = (f32x4){0.f, 0.f, 0.f, 0.f}; px[mt][nt] = (f32x4){0.f, 0.f, 0.f, 0.f}; }
#pragma unroll
                for (int nt = 0; nt < 4; ++nt)
#pragma unroll
                    for (int ks = 0; ks < 2; ++ks) { const bf16x8 xf = *(const bf16x8*)(XC + (16 * nt + fr) * 72 + ks * 32 + fq * 8);
#pragma unroll
                        for (int mt = 0; mt < 2; ++mt) { pa[mt][nt] = __builtin_amdgcn_mfma_f32_16x16x32_bf16(xf, waf[mt][ks], pa[mt][nt], 0, 0, 0); px[mt][nt] = __builtin_amdgcn_mfma_f32_16x16x32_bf16(xf, wxf[mt][ks], px[mt][nt], 0, 0, 0); } }
#pragma unroll
                for (int mt = 0; mt < 2; ++mt) { float A = 1.f, B = 0.f;
#pragma unroll
                    for (int nt = 0; nt < 4; ++nt)
#pragma unroll
                        for (int j = 0; j < 4; ++j) { const float xc = bf2f(XC[(16 * nt + 4 * fq + j) * 72 + half * 32 + 16 * mt + fr]);
                            const float rg = fsigmoid(pa[mt][nt][j] + bav[mt]), ig = fsigmoid(px[mt][nt][j] + bxv[mt]); const float a = __expf(-8.f * rg * spv[mt]); const float bt = sqrtf((1.f - a) * (1.f + a)) * (ig * xc);
                            av[mt][nt * 4 + j] = a; bv[mt][nt * 4 + j] = bt; B = a * B + bt; A = A * a; }
                    { const float Al = __shfl_up(A, 16), Bl = __shfl_up(B, 16); if (fq >= 1) { B = A * Bl + B; A = A * Al; } }
                    { const float Al = __shfl_up(A, 32), Bl = __shfl_up(B, 32); if (fq >= 2) { B = A * Bl + B; A = A * Al; } }
                    { const float Al = __shfl_up(A, 16), Bl = __shfl_up(B, 16); Aex[mt] = fq >= 1 ? Al : 1.f; Bex[mt] = fq >= 1 ? Bl : 0.f; }
                    Atot[mt] = __shfl(A, 48 + fr); Btot[mt] = __shfl(B, 48 + fr); }
            }
            if (fq == 3) {
#pragma unroll
                for (int mt = 0; mt < 2; ++mt) { TOT[(w * 32 + 16 * mt + fr) * 2] = Atot[mt]; TOT[(w * 32 + 16 * mt + fr) * 2 + 1] = Btot[mt]; } }
            __syncthreads();
            float hin[2];
#pragma unroll
            for (int mt = 0; mt < 2; ++mt) { float h = hcar[mt]; hin[mt] = h;
#pragma unroll
                for (int ww = 0; ww < 8; ++ww) { const float At = TOT[(ww * 32 + 16 * mt + fr) * 2], Bt = TOT[(ww * 32 + 16 * mt + fr) * 2 + 1]; h = At * h + Bt; if (ww + 1 == w) hin[mt] = h; }
                hcar[mt] = h; }
            if (active && !isctx) {
                bf16_t* OUT = RAW;
#pragma unroll
                for (int mt = 0; mt < 2; ++mt) { float h = Aex[mt] * hin[mt] + Bex[mt];
#pragma unroll
                    for (int q = 0; q < 16; ++q) { h = av[mt][q] * h + bv[mt][q]; OUT[(16 * fq + q) * 40 + 16 * mt + fr] = (bf16_t)f2bf(h); } }
                if (fuse && d == 1) {
                    u32x4 h0q[4], gbq[4];
#pragma unroll
                    for (int j = 0; j < 4; ++j) { const int ps = 16 * j + (lane >> 2), lc = lane & 3; const int sseg = s0 + ps; const int i = len - 1 - sseg; const size_t k = ((size_t)b * T + (size_t)((i & 63) * 64 + (i >> 6))) * LWD + g * 64 + half * 32 + 8 * lc;
                        h0q[j] = *(const u32x4*)(H0 + k); gbq[j] = *(const u32x4*)(GB + k); }
#pragma unroll
                    for (int j = 0; j < 4; ++j) { const int ps = 16 * j + (lane >> 2), lc = lane & 3; const int sseg = s0 + ps; const int i = len - 1 - sseg; const size_t k = ((size_t)b * T + (size_t)((i & 63) * 64 + (i >> 6))) * LWD + g * 64 + half * 32 + 8 * lc;
                        float fa[8], fc[8], fg[8]; unpack8(h0q[j], fa); unpack8(*(const u32x4*)(OUT + ps * 40 + 8 * lc), fc); unpack8(gbq[j], fg); u32x4 o;
                        o.x = pk2((fa[0] + fc[0]) * fg[0], (fa[1] + fc[1]) * fg[1]); o.y = pk2((fa[2] + fc[2]) * fg[2], (fa[3] + fc[3]) * fg[3]); o.z = pk2((fa[4] + fc[4]) * fg[4], (fa[5] + fc[5]) * fg[5]); o.w = pk2((fa[6] + fc[6]) * fg[6], (fa[7] + fc[7]) * fg[7]);
                        *(u32x4*)(HL + k) = o; }
                } else {
#pragma unroll
                for (int j = 0; j < 4; ++j) { const int ps = 16 * j + (lane >> 2), lc = lane & 3; const int sseg = s0 + ps; const int i = d ? len - 1 - sseg : sseg; const size_t row = (size_t)b * T + (size_t)((i & 63) * 64 + (i >> 6));
                    *(u32x4*)(Hd + row * LWD + g * 64 + half * 32 + 8 * lc) = *(const u32x4*)(OUT + ps * 40 + 8 * lc); }
                }
            }
            __syncthreads();
        }
    }
}

constexpr int NSTRIP = NTOK / 32, NCHUNK = RW_COLS / 8;
__device__ __forceinline__ void phase_mixA(const bf16_t* __restrict__ RW, bf16_t* __restrict__ SIDE, int bid, int nb) {
    const int tid = otid(), lane = tid & 63, gw = bid * 8 + (tid >> 6), NGW = nb * 8;
    for (int it = gw; it < NSTRIP * 2; it += NGW) { const int sidx = it >> 1, wh = it & 1; const u32x4* src = (const u32x4*)(RW + (size_t)(sidx * 32 + wh * 31) * RW_COLS); u32x4* dst = (u32x4*)(SIDE + (size_t)it * RW_COLS);
        for (int ch = lane; ch < NCHUNK; ch += 64) dst[ch] = src[ch]; }
}
__device__ __forceinline__ void phase_mixB(bf16_t* __restrict__ RW, const bf16_t* __restrict__ SIDE, const float* __restrict__ mu, const float* __restrict__ k_k, float* __restrict__ KN, int bid, int nb) {
    const int tid = otid();
    for (int it = bid * 512 + tid; it < NSTRIP * NCHUNK; it += nb * 512) {
        const int sidx = it / NCHUNK, ch = it - sidx * NCHUNK, r0 = sidx * 32;
        const bool first = r0 < NLAT ? (r0 & (T - 1)) == 0 : ((r0 - NLAT) & (TC - 1)) == 0, last = r0 < NLAT ? ((r0 + 32) & (T - 1)) == 0 : ((r0 + 32 - NLAT) & (TC - 1)) == 0;
        const int act = (ch >= 192 && ch < 200) ? 1 : (ch >= 208 ? 2 : 0);
        const f32x4 mu0 = *(const f32x4*)(mu + 8 * ch), mu1 = *(const f32x4*)(mu + 8 * ch + 4); const float mm[8] = {mu0.x, mu0.y, mu0.z, mu0.w, mu1.x, mu1.y, mu1.z, mu1.w};
        const bool isk = ch >= 64 && ch < 128; const int kc = isk ? 8 * (ch - 64) : 0; const f32x4 kk0 = *(const f32x4*)(k_k + kc), kk1 = *(const f32x4*)(k_k + kc + 4); const float kkc[8] = {kk0.x, kk0.y, kk0.z, kk0.w, kk1.x, kk1.y, kk1.z, kk1.w};
        const u32x4 z = {0u, 0u, 0u, 0u};
        u32x4* col = (u32x4*)(RW + (size_t)r0 * RW_COLS + 8 * ch);
        u32x4 prev = first ? z : *(const u32x4*)(SIDE + ((size_t)(sidx - 1) * 2 + 1) * RW_COLS + 8 * ch);
        const u32x4 after = last ? z : *(const u32x4*)(SIDE + ((size_t)(sidx + 1) * 2) * RW_COLS + 8 * ch);
#pragma unroll 1
        for (int sb = 0; sb < 4; ++sb) { u32x4 rw[9];
#pragma unroll
            for (int j = 0; j < 8; ++j) rw[j] = col[(size_t)(sb * 8 + j) * NCHUNK];
            rw[8] = sb < 3 ? col[(size_t)(sb * 8 + 8) * NCHUNK] : after;
#pragma unroll
            for (int j = 0; j < 8; ++j) { float p_[8], m_[8], n_[8]; unpack8(rw[j], p_); unpack8(j == 0 ? prev : rw[j - 1], m_); unpack8(rw[j + 1], n_); float o[8];
#pragma unroll
                for (int e = 0; e < 8; ++e) { float v = p_[e] + mm[e] * (0.5f * (m_[e] + n_[e]) - p_[e]); o[e] = act == 1 ? ftanh(v) : act == 2 ? fsigmoid(v) : v; }
                u32x4 pk; pk.x = pk2(o[0], o[1]); pk.y = pk2(o[2], o[3]); pk.z = pk2(o[4], o[5]); pk.w = pk2(o[6], o[7]); col[(size_t)(sb * 8 + j) * NCHUNK] = pk;
                float ss = 0.f;
#pragma unroll
                for (int e = 0; e < 8; ++e) { const float kv = o[e] * kkc[e]; ss += kv * kv; }
                ss += __shfl_xor(ss, 1); ss += __shfl_xor(ss, 2); ss += __shfl_xor(ss, 4);
                if (isk && (ch & 7) == 0) KN[(size_t)(r0 + sb * 8 + j) * 8 + ((ch - 64) >> 3)] = 1.f / fmaxf(sqrtf(ss), 1e-12f); }
            prev = rw[7]; }
    }
}
__device__ __forceinline__ void phase_rwkv_full(const bf16_t* __restrict__ RW, const float* __restrict__ KN, bf16_t* __restrict__ Y0, bf16_t* __restrict__ Y1, const float* __restrict__ w0, const bf16_t* __restrict__ W2T,
                                                const float* __restrict__ a0, const bf16_t* __restrict__ A2T, const float* __restrict__ k_k, const float* __restrict__ k_a,
                                                const float* __restrict__ mw1, const float* __restrict__ mw3, const float* __restrict__ mw2, bf16_t* __restrict__ W13, bf16_t* __restrict__ W2, unsigned char* lds, int bid, int nb) {
    const int tid0 = otid(), w = __builtin_amdgcn_readfirstlane(tid0 >> 6);
    constexpr int CH = 32, NCH = (TC + T) / CH, NCX = TC / CH;
    constexpr int A_BYTES = 256;
    constexpr int B_BYTES = 3 * CH * 144 + 64 * 80;
    constexpr int E_BYTES = CH * 144 + 2 * 64 * 80;
    constexpr int C_BYTES = 64 * 80 + 64 * 144;
    constexpr int D_BYTES = 5 * CH * 144 + 128;
    constexpr int OFF_B = 2 * A_BYTES, OFF_C = OFF_B + 3 * B_BYTES, OFF_D = OFF_C + 2 * C_BYTES, OFF_E = OFF_D + 2 * D_BYTES;
    constexpr int OFF_X = OFF_E + 2 * E_BYTES, OFF_FLG = 163584 + 192;
    static_assert(OFF_X + 1024 <= 163584, "LDS");
    for (int item = bid; item < 128; item += nb) {
        const int chain = item, b = chain >> 4, h = (chain >> 1) & 7, d = chain & 1;
        bf16_t* Yd = d ? Y1 : Y0;
        auto tok_row = [&](int cc, int j) -> size_t { const bool ic = cc < NCX; const int ln = ic ? TC : T; const int ss = (ic ? cc : cc - NCX) * CH + j, t = d == 0 ? ss : ln - 1 - ss; return (ic ? (size_t)NLAT + (size_t)b * TC : (size_t)b * T) + t; };
        auto tok_ri = [&](int cc, int j) -> unsigned { const bool ic = cc < NCX; const int ln = ic ? TC : T; const int ss = (ic ? cc : cc - NCX) * CH + j, t = d == 0 ? ss : ln - 1 - ss; return (unsigned)((ic ? NLAT + b * TC : b * T) + t); };
        struct RawL { u32x4 p[20]; float kn; };
        auto ld_issue = [&](int cc, int lane, RawL& R) {
            const char* RWb = (const char*)RW;
#pragma unroll
            for (int it = 0; it < 8; ++it) { const int tok = it * 4 + (lane >> 4), p = lane & 15; R.p[it] = *(const u32x4*)(RWb + (tok_ri(cc, tok) * (unsigned)(RW_COLS * 2) + (unsigned)(3072 + 16 * p))); }
#pragma unroll
            for (int it = 0; it < 4; ++it) { const int tok = it * 8 + (lane >> 3), p = lane & 7; const unsigned o_ = tok_ri(cc, tok) * (unsigned)(RW_COLS * 2) + (unsigned)(h * 128 + 16 * p); R.p[8 + it] = *(const u32x4*)(RWb + o_); R.p[12 + it] = *(const u32x4*)(RWb + (o_ + 1024u)); }
#pragma unroll
            for (int it = 0; it < 4; ++it) { const int tok = it * 8 + (lane >> 3), p = lane & 7; R.p[16 + it] = *(const u32x4*)(RWb + (tok_ri(cc, tok) * (unsigned)(RW_COLS * 2) + (unsigned)(2048 + h * 128 + 16 * p))); }
            R.kn = *(const float*)((const char*)KN + (tok_ri(cc, lane & 31) * 32u + (unsigned)(h * 4)));
            asm volatile("" ::: "memory");
        };
        auto ld_commit = [&](int cc, int lane, const RawL& R) {
            bf16_t* WD = (bf16_t*)(lds + OFF_D + (cc & 1) * D_BYTES); bf16_t* RI = WD + 2 * CH * 72; bf16_t* KI = RI + CH * 72; bf16_t* VI = KI + CH * 72; float* KNs = (float*)(VI + CH * 72);
#pragma unroll
            for (int it = 0; it < 8; ++it) { const int tok = it * 4 + (lane >> 4), p = lane & 15; *(u32x4*)(WD + (p >> 3) * (CH * 72) + tok * 72 + 8 * (p & 7)) = R.p[it]; }
#pragma unroll
            for (int it = 0; it < 4; ++it) { const int tok = it * 8 + (lane >> 3), p = lane & 7; *(u32x4*)(RI + tok * 72 + 8 * p) = R.p[8 + it]; *(u32x4*)(KI + tok * 72 + 8 * p) = R.p[12 + it]; }
#pragma unroll
            for (int it = 0; it < 4; ++it) { const int tok = it * 8 + (lane >> 3), p = lane & 7; *(u32x4*)(VI + tok * 72 + 8 * p) = R.p[16 + it]; }
            if (lane < 32) KNs[lane] = R.kn;
        };
        auto wt_src = [&](int it, int& k0, int& n0, int& rmul, int& radd, bf16_t*& dst) -> const float* {
            const int m = it >> 12, r = it & 4095, e = r >> 8, tt = r & 255; k0 = (tt >> 4) * 64; n0 = (tt & 15) * 64;
            const float* src = (m == 0 ? mw1 : m == 1 ? mw3 : mw2) + (size_t)e * 1024 * 1024; rmul = m == 2 ? 128 : 256; radd = m == 1 ? 128 : 0; dst = m == 2 ? W2 + (size_t)e * 1024 * 1024 : W13 + (size_t)e * 2048 * 1024;
            return src + (size_t)k0 * 1024 + n0; };
        auto wt_issue = [&](int it, int lane, float (&v)[64]) { int k0, n0, rmul, radd; bf16_t* dst; const float* sp = wt_src(it, k0, n0, rmul, radd, dst); const unsigned lo = (unsigned)lane * 4u;
            const unsigned long long pb = (unsigned long long)sp; const __attribute__((address_space(1))) char* sb = (const __attribute__((address_space(1))) char*)(((unsigned long long)(unsigned)__builtin_amdgcn_readfirstlane((int)(pb >> 32)) << 32) | (unsigned)__builtin_amdgcn_readfirstlane((int)pb));
#pragma unroll
            for (int i = 0; i < 64; ++i) v[i] = *(const __attribute__((address_space(1))) float*)(sb + ((unsigned)(i * 4096) + lo));
            asm volatile("" ::: "memory"); };
        auto wt_finish = [&](int it, int lane, const float (&v)[64]) { int k0, n0, rmul, radd; bf16_t* dst; (void)wt_src(it, k0, n0, rmul, radd, dst);
            const int nn = n0 + lane, row = (nn >> 7) * rmul + (nn & 127) + radd; bf16_t* dp = dst + (size_t)row * 1024 + k0;
#pragma unroll
            for (int c = 0; c < 8; ++c) { u32x4 o; o.x = pk2(v[8 * c], v[8 * c + 1]); o.y = pk2(v[8 * c + 2], v[8 * c + 3]); o.z = pk2(v[8 * c + 4], v[8 * c + 5]); o.w = pk2(v[8 * c + 6], v[8 * c + 7]); *(u32x4*)(dp + 8 * c) = o; } };
        struct PCst { bf16x8 bw[2], ba[2]; f32x4 w0c, a0c, kkc, kac; };
        PCst PC_;
        if (w >= 4) { const int lane = tid0 & 63, pw = w - 4, fr = lane & 15, fq = lane >> 4, i0 = 16 * pw + 4 * fq;
#pragma unroll
            for (int ks = 0; ks < 2; ++ks) { const size_t off = ((size_t)d * 512 + h * 64 + 16 * pw + fr) * 64 + ks * 32 + fq * 8; PC_.bw[ks] = *(const bf16x8*)(W2T + off); PC_.ba[ks] = *(const bf16x8*)(A2T + off); }
            PC_.w0c = -1.4426950408889634f * *(const f32x4*)(w0 + d * 512 + h * 64 + i0); PC_.a0c = -1.4426950408889634f * *(const f32x4*)(a0 + d * 512 + h * 64 + i0); PC_.kkc = *(const f32x4*)(k_k + h * 64 + i0); PC_.kac = *(const f32x4*)(k_a + h * 64 + i0); }
        auto prep = [&](int cc, int lane, int pw) {
            float* PCV = (float*)(lds + (cc & 1) * A_BYTES);
            const bf16_t* WD = (const bf16_t*)(lds + OFF_D + (cc & 1) * D_BYTES); const bf16_t* AD = WD + CH * 72; const bf16_t* RI = AD + CH * 72; const bf16_t* KI = RI + CH * 72; const bf16_t* VI = KI + CH * 72; const float* KNs = (const float*)(VI + CH * 72);
            bf16_t* RBp = (bf16_t*)(lds + OFF_B + (cc % 3) * B_BYTES); bf16_t* KBp = RBp + CH * 72; bf16_t* BBp = KBp + CH * 72; bf16_t* VTp = BBp + CH * 72; bf16_t* KKp = (bf16_t*)(lds + OFF_E + (cc & 1) * E_BYTES); bf16_t* KTp = KKp + CH * 72; bf16_t* BTp = KTp + 64 * 40;
            const int fr = lane & 15, fq = lane >> 4, i0 = 16 * pw + 4 * fq;
            if (pw >= 2) {
#pragma unroll
              for (int it = 0; it < 2; ++it) { const int ptid = ((pw - 2) * 64 + lane) * 2 + it, tk = ptid >> 3, part = ptid & 7; const u32x4 raw = *(const u32x4*)(VI + tk * 72 + 8 * part);
                bf16_t* vt = VTp + (8 * part) * 40 + tk; vt[0] = (bf16_t)raw.x; vt[40] = (bf16_t)(raw.x >> 16); vt[80] = (bf16_t)raw.y; vt[120] = (bf16_t)(raw.y >> 16); vt[160] = (bf16_t)raw.z; vt[200] = (bf16_t)(raw.z >> 16); vt[240] = (bf16_t)raw.w; vt[280] = (bf16_t)(raw.w >> 16); } }
            const f32x4 w0c = PC_.w0c, a0c = PC_.a0c, kkc = PC_.kkc, kac = PC_.kac;
            bf16x8 fw[2][2], fa[2][2]; u32x2 rr[2], kr[2]; float inv[2];
#pragma unroll
            for (int mt = 0; mt < 2; ++mt) { const int tk = 16 * mt + fr;
#pragma unroll
                for (int ks = 0; ks < 2; ++ks) { fw[mt][ks] = *(const bf16x8*)(WD + tk * 72 + ks * 32 + fq * 8); fa[mt][ks] = *(const bf16x8*)(AD + tk * 72 + ks * 32 + fq * 8); }
                rr[mt] = *(const u32x2*)(RI + tk * 72 + i0); kr[mt] = *(const u32x2*)(KI + tk * 72 + i0); inv[mt] = KNs[tk]; }
            f32x4 aw[2], aa[2];
#pragma unroll
            for (int mt = 0; mt < 2; ++mt) { aw[mt] = (f32x4){0.f, 0.f, 0.f, 0.f}; aa[mt] = (f32x4){0.f, 0.f, 0.f, 0.f};
#pragma unroll
                for (int ks = 0; ks < 2; ++ks) { aw[mt] = __builtin_amdgcn_mfma_f32_16x16x32_bf16(PC_.bw[ks], fw[mt][ks], aw[mt], 0, 0, 0); aa[mt] = __builtin_amdgcn_mfma_f32_16x16x32_bf16(PC_.ba[ks], fa[mt][ks], aa[mt], 0, 0, 0); } }
            f32x4 Lq[2], aq[2], cs[2], tot0;
#pragma unroll
            for (int mt = 0; mt < 2; ++mt)
#pragma unroll
                for (int r = 0; r < 4; ++r) { Lq[mt][r] = -0.8750387749145276f * __builtin_amdgcn_rcpf(1.f + __builtin_amdgcn_exp2f(__builtin_fmaf(aw[mt][r], -1.4426950408889634f, w0c[r]))); aq[mt][r] = 1.f + __builtin_amdgcn_exp2f(__builtin_fmaf(aa[mt][r], -1.4426950408889634f, a0c[r])); }
#pragma unroll
            for (int mt = 0; mt < 2; ++mt)
#pragma unroll
                for (int r = 0; r < 4; ++r) { float c_ = Lq[mt][r]; c_ += dpp_mov<0x111>(c_); c_ += dpp_mov<0x112>(c_); c_ += dpp_mov<0x114>(c_); c_ += dpp_mov<0x118>(c_); cs[mt][r] = c_; }
#pragma unroll
            for (int r = 0; r < 4; ++r) tot0[r] = dpp_mov<0x15F>(cs[0][r]);
            f32x4 run = {0.f, 0.f, 0.f, 0.f}, e1p = {1.f, 1.f, 1.f, 1.f};
#pragma unroll
            for (int mt = 0; mt < 2; ++mt) { const int tk = 16 * mt + fr;
                const f32x4 r4 = {__builtin_bit_cast(float, rr[mt].x << 16), __builtin_bit_cast(float, rr[mt].x & 0xffff0000u), __builtin_bit_cast(float, rr[mt].y << 16), __builtin_bit_cast(float, rr[mt].y & 0xffff0000u)};
                const f32x4 k4 = {__builtin_bit_cast(float, kr[mt].x << 16), __builtin_bit_cast(float, kr[mt].x & 0xffff0000u), __builtin_bit_cast(float, kr[mt].y << 16), __builtin_bit_cast(float, kr[mt].y & 0xffff0000u)};
                f32x4 kkt, bt, kt, rt;
#pragma unroll
                for (int r = 0; r < 4; ++r) { const float qa = aq[mt][r];
                    const float cum = cs[mt][r] + run[r]; const float e1 = __builtin_amdgcn_exp2f(cum);
                    const float fill = mt == 0 ? 1.f : dpp_mov<0x15F>(e1p[r]);
                    const float e0 = __builtin_bit_cast(float, __builtin_amdgcn_update_dpp(__builtin_bit_cast(int, fill), __builtin_bit_cast(int, e1), 0x111, 0xF, 0xF, false));
                    const float ae = __builtin_amdgcn_rcpf(qa * e1), ei = qa * ae;
                    const float kkn = k4[r] * kkc[r] * inv[mt];
                    kkt[r] = kkn * e0; bt[r] = kkn * ae; kt[r] = k4[r] * __builtin_fmaf(ae - ei, kac[r], ei); rt[r] = r4[r] * e1; e1p[r] = e1; }
                if (mt == 0) run = tot0;
                const u32x2 kp = {pk2(kt.x, kt.y), pk2(kt.z, kt.w)}, bp = {pk2(bt.x, bt.y), pk2(bt.z, bt.w)};
                *(u32x2*)(RBp + tk * 72 + i0) = (u32x2){pk2(rt.x, rt.y), pk2(rt.z, rt.w)}; *(u32x2*)(KBp + tk * 72 + i0) = kp; *(u32x2*)(BBp + tk * 72 + i0) = bp; *(u32x2*)(KKp + tk * 72 + i0) = (u32x2){pk2(kkt.x, kkt.y), pk2(kkt.z, kkt.w)};
                bf16_t* ktc = KTp + i0 * 40 + tk; ktc[0] = (bf16_t)kp.x; ktc[40] = (bf16_t)(kp.x >> 16); ktc[80] = (bf16_t)kp.y; ktc[120] = (bf16_t)(kp.y >> 16);
                bf16_t* btc = BTp + i0 * 40 + tk; btc[0] = (bf16_t)bp.x; btc[40] = (bf16_t)(bp.x >> 16); btc[80] = (bf16_t)bp.y; btc[120] = (bf16_t)(bp.y >> 16);
            }
            { f32x4 tl;
#pragma unroll
              for (int r = 0; r < 4; ++r) tl[r] = __builtin_amdgcn_exp2f(cs[1][r] + tot0[r]);
              if (fr == 15) *(f32x4*)(PCV + i0) = tl; }
        };
        auto ycomp1 = [&](int cc, int lane, int mt) {
            const bf16_t* RBp = (const bf16_t*)(lds + OFF_B + (cc % 3) * B_BYTES); const bf16_t* KBp = RBp + CH * 72; const bf16_t* BBp = KBp + CH * 72; const bf16_t* VTp = BBp + CH * 72;
            const bf16_t* SAF = (const bf16_t*)(lds + OFF_C + (cc & 1) * C_BYTES); const bf16_t* S0B = (const bf16_t*)(lds + OFF_C + (cc & 1) * C_BYTES + 64 * 80);
            const int fr = lane & 15, q = lane >> 4;
            const bf16x8 r0 = *(const bf16x8*)(RBp + (16 * mt + fr) * 72 + 8 * q), r1 = *(const bf16x8*)(RBp + (16 * mt + fr) * 72 + 32 + 8 * q);
            const f32x4 z4 = {0.f, 0.f, 0.f, 0.f};
            f32x4 gk0, gb0, gk1 = z4, gb1 = z4;
            { const bf16x8 k0 = *(const bf16x8*)(KBp + fr * 72 + 8 * q), k1 = *(const bf16x8*)(KBp + fr * 72 + 32 + 8 * q), b0 = *(const bf16x8*)(BBp + fr * 72 + 8 * q), b1 = *(const bf16x8*)(BBp + fr * 72 + 32 + 8 * q);
              gk0 = __builtin_amdgcn_mfma_f32_16x16x32_bf16(k0, r0, z4, 0, 0, 0); gk0 = __builtin_amdgcn_mfma_f32_16x16x32_bf16(k1, r1, gk0, 0, 0, 0);
              gb0 = __builtin_amdgcn_mfma_f32_16x16x32_bf16(b0, r0, z4, 0, 0, 0); gb0 = __builtin_amdgcn_mfma_f32_16x16x32_bf16(b1, r1, gb0, 0, 0, 0); }
            if (mt == 1) {
              const bf16x8 k0 = *(const bf16x8*)(KBp + (16 + fr) * 72 + 8 * q), k1 = *(const bf16x8*)(KBp + (16 + fr) * 72 + 32 + 8 * q), b0 = *(const bf16x8*)(BBp + (16 + fr) * 72 + 8 * q), b1 = *(const bf16x8*)(BBp + (16 + fr) * 72 + 32 + 8 * q);
              gk1 = __builtin_amdgcn_mfma_f32_16x16x32_bf16(k0, r0, z4, 0, 0, 0); gk1 = __builtin_amdgcn_mfma_f32_16x16x32_bf16(k1, r1, gk1, 0, 0, 0);
              gb1 = __builtin_amdgcn_mfma_f32_16x16x32_bf16(b0, r0, z4, 0, 0, 0); gb1 = __builtin_amdgcn_mfma_f32_16x16x32_bf16(b1, r1, gb1, 0, 0, 0);
#pragma unroll
              for (int r = 0; r < 4; ++r) { const bool keep = 4 * q + r <= fr; gk1[r] = keep ? gk1[r] : 0.f; gb1[r] = keep ? gb1[r] : 0.f; }
            } else {
#pragma unroll
              for (int r = 0; r < 4; ++r) { const bool keep = 4 * q + r <= fr; gk0[r] = keep ? gk0[r] : 0.f; gb0[r] = keep ? gb0[r] : 0.f; }
            }
            const u32x4 gkp = {pk2(gk0[0], gk0[1]), pk2(gk0[2], gk0[3]), pk2(gk1[0], gk1[1]), pk2(gk1[2], gk1[3])};
            const u32x4 gbp = {pk2(-gb0[0], -gb0[1]), pk2(-gb0[2], -gb0[3]), pk2(-gb1[0], -gb1[1]), pk2(-gb1[2], -gb1[3])};
            bf16_t* yrow = Yd + tok_row(cc, 16 * mt + fr) * RWD + h * 64 + 4 * q;
#pragma unroll
            for (int nt = 0; nt < 4; ++nt) { const int ri = 16 * nt + fr;
                const u32x2 v0 = *(const u32x2*)(VTp + ri * 40 + 4 * q), v1 = *(const u32x2*)(VTp + ri * 40 + 16 + 4 * q);
                const u32x2 s0 = *(const u32x2*)(SAF + ri * 40 + 4 * q), s1 = *(const u32x2*)(SAF + ri * 40 + 16 + 4 * q);
                const u32x4 vtp = {v0.x, v0.y, v1.x, v1.y}, sap = {s0.x, s0.y, s1.x, s1.y};
                const bf16x8 z0 = *(const bf16x8*)(S0B + ri * 72 + 8 * q), z1 = *(const bf16x8*)(S0B + ri * 72 + 32 + 8 * q);
                f32x4 y = __builtin_amdgcn_mfma_f32_16x16x32_bf16(__builtin_bit_cast(bf16x8, vtp), __builtin_bit_cast(bf16x8, gkp), z4, 0, 0, 0);
                y = __builtin_amdgcn_mfma_f32_16x16x32_bf16(__builtin_bit_cast(bf16x8, sap), __builtin_bit_cast(bf16x8, gbp), y, 0, 0, 0);
                y = __builtin_amdgcn_mfma_f32_16x16x32_bf16(z0, r0, y, 0, 0, 0); y = __builtin_amdgcn_mfma_f32_16x16x32_bf16(z1, r1, y, 0, 0, 0);
                *(u32x2*)(yrow + 16 * nt) = (u32x2){pk2(y[0], y[1]), pk2(y[2], y[3])}; }
        };
        auto ycomp = [&](int cc, int lane) { ycomp1(cc, lane, 0); ycomp1(cc, lane, 1); };
        f32x4 ST[4][2];
#pragma unroll
        for (int u = 0; u < 4; ++u) { ST[u][0] = (f32x4){0.f, 0.f, 0.f, 0.f}; ST[u][1] = (f32x4){0.f, 0.f, 0.f, 0.f}; }
        if (tid0 == 0) *(volatile LAS unsigned*)(lds + OFF_FLG) = 0u;
        __syncthreads();
        if (w == 3) {
#pragma unroll 1
            for (int cc = 0; cc < 2; ++cc) { int tidp = tid0; asm volatile("" : "+v"(tidp)); RawL rl; ld_issue(cc, tidp & 63, rl); ld_commit(cc, tidp & 63, rl); } }
        __syncthreads();
        if (w >= 4) prep(0, tid0 & 63, w - 4);
        __syncthreads();
        if (w == 3) {
            for (int c = 0; c < NCH; c += 2) {
                int tid = tid0; asm volatile("" : "+v"(tid));
                const int lane = tid & 63, wit = item + 128 * (c >> 1); const bool hw = true;
                float wv[64];
                { RawL ra; ld_issue(c + 2 < NCH ? c + 2 : NCH - 1, lane, ra); if (hw) wt_issue(wit, lane, wv); ld_commit(c + 2, lane, ra); }
                __syncthreads();
                { RawL rb; ld_issue(c + 3 < NCH ? c + 3 : NCH - 1, lane, rb); if (hw) wt_finish(wit, lane, wv); ld_commit(c + 3, lane, rb); }
                __syncthreads();
            }
        } else
        for (int c = 0; c < NCH; ++c) {
            int tid = tid0; asm volatile("" : "+v"(tid));
            const int lane = tid & 63;
            if (w < 3) __builtin_amdgcn_s_setprio(2);
            if (w < 2) {
                const int rb = w;
                const float* PCV = (const float*)(lds + (c & 1) * A_BYTES);
                const bf16_t* RBp = (const bf16_t*)(lds + OFF_B + (c % 3) * B_BYTES); const bf16_t* KBp = RBp + CH * 72; const bf16_t* BBp = KBp + CH * 72; const bf16_t* VTp = BBp + CH * 72; const bf16_t* KKp = (const bf16_t*)(lds + OFF_E + (c & 1) * E_BYTES); const bf16_t* KTp = KKp + CH * 72; const bf16_t* BTp = KTp + 64 * 40;
                bf16_t* SAF = (bf16_t*)(lds + OFF_C + (c & 1) * C_BYTES); bf16_t* S0B = (bf16_t*)(lds + OFF_C + (c & 1) * C_BYTES + 64 * 80);
                const int fr = lane & 15, q = lane >> 4;
                const f32x4 z4 = {0.f, 0.f, 0.f, 0.f};
                auto mf = [](bf16x8 a_, bf16x8 b_, f32x4 c_) -> f32x4 { return __builtin_amdgcn_mfma_f32_16x16x32_bf16(a_, b_, c_, 0, 0, 0); };
                auto opA = [](f32x4 x) -> bf16x8 { const u32x4 v = {pk2(x[0], x[1]), pk2(x[2], x[3]), 0u, 0u}; return __builtin_bit_cast(bf16x8, v); };
                auto opN = [](f32x4 x) -> bf16x8 { const u32x4 v = {pk2(-x[0], -x[1]), pk2(-x[2], -x[3]), 0u, 0u}; return __builtin_bit_cast(bf16x8, v); };
                typedef short bf16x4_ __attribute__((ext_vector_type(4)));
                auto m16 = [](bf16x4_ a_, bf16x4_ b_, f32x4 c_) -> f32x4 { return __builtin_amdgcn_mfma_f32_16x16x16bf16_1k(a_, b_, c_, 0, 0, 0); };
                auto o4 = [](f32x4 x) -> bf16x4_ { const u32x2 v = {pk2(x[0], x[1]), pk2(x[2], x[3])}; return __builtin_bit_cast(bf16x4_, v); };
                auto o4n = [](f32x4 x) -> bf16x4_ { const u32x2 v = {pk2(-x[0], -x[1]), pk2(-x[2], -x[3])}; return __builtin_bit_cast(bf16x4_, v); };
                auto op2 = [](f32x4 lo, f32x4 hi) -> bf16x8 { const u32x4 v = {pk2(lo[0], lo[1]), pk2(lo[2], lo[3]), pk2(hi[0], hi[1]), pk2(hi[2], hi[3])}; return __builtin_bit_cast(bf16x8, v); };
                auto op2n = [](f32x4 lo, f32x4 hi) -> bf16x8 { const u32x4 v = {pk2(-lo[0], -lo[1]), pk2(-lo[2], -lo[3]), pk2(-hi[0], -hi[1]), pk2(-hi[2], -hi[3])}; return __builtin_bit_cast(bf16x8, v); };
                auto rf = [&](const bf16_t* X, int stride, int r0, int k0) -> bf16x8 { return *(const bf16x8*)(X + (r0 + fr) * stride + k0 + 8 * q); };
                auto pf = [&](const bf16_t* X, int stride, int r0, int k0) -> bf16x8 { const u32x2 a_ = *(const u32x2*)(X + (r0 + fr) * stride + k0 + 4 * q), b_ = *(const u32x2*)(X + (r0 + fr) * stride + k0 + 16 + 4 * q);
                    const u32x4 v = {a_.x, a_.y, b_.x, b_.y}; return __builtin_bit_cast(bf16x8, v); };
                bf16x8 kkf[2][2], bbf[2][2], kf[2][2];
#pragma unroll
                for (int a_ = 0; a_ < 2; ++a_)
#pragma unroll
                    for (int ks = 0; ks < 2; ++ks) { kkf[a_][ks] = rf(KKp, 72, 16 * a_, 32 * ks); bbf[a_][ks] = rf(BBp, 72, 16 * a_, 32 * ks); kf[a_][ks] = rf(KBp, 72, 16 * a_, 32 * ks); }
                auto gram = [&](const bf16x8 (&P)[2], const bf16x8 (&Q)[2]) -> f32x4 { return mf(P[1], Q[1], mf(P[0], Q[0], z4)); };
                bool lo_[4], up_[4], dg_[4];
#pragma unroll
                for (int r = 0; r < 4; ++r) { lo_[r] = fr < 4 * q + r; up_[r] = 4 * q + r < fr; dg_[r] = 4 * q + r == fr; }
                const f32x4 L21T = gram(bbf[0], kkf[1]);
                f32x4 AkT00 = gram(kf[0], kkf[0]), AkT10 = gram(kf[0], kkf[1]), AkT11 = gram(kf[1], kkf[1]);
#pragma unroll
                for (int r = 0; r < 4; ++r) { AkT00[r] = up_[r] ? AkT00[r] : 0.f; AkT11[r] = up_[r] ? AkT11[r] : 0.f; }
                f32x4 RH[2][2];
                { const bf16x8 a0op = opA(AkT00), a1op = op2(AkT10, AkT11);
#pragma unroll
                  for (int cI = 0; cI < 2; ++cI) { const bf16x8 vp_ = pf(VTp, 40, 32 * rb + 16 * cI, 0); RH[0][cI] = mf(a0op, vp_, z4); RH[1][cI] = mf(a1op, vp_, z4); } }
                bf16x8 sop[2][2];
#pragma unroll
                for (int ks = 0; ks < 2; ++ks)
#pragma unroll
                    for (int cI = 0; cI < 2; ++cI) { sop[ks][cI] = op2(ST[2 * ks][cI], ST[2 * ks + 1][cI]); const u32x4 sv = __builtin_bit_cast(u32x4, sop[ks][cI]);
                        *(u32x2*)(S0B + (32 * rb + 16 * cI + fr) * 72 + 32 * ks + 4 * q) = (u32x2){sv.x, sv.y}; *(u32x2*)(S0B + (32 * rb + 16 * cI + fr) * 72 + 32 * ks + 16 + 4 * q) = (u32x2){sv.z, sv.w}; }
#pragma unroll
                for (int a_ = 0; a_ < 2; ++a_)
#pragma unroll
                    for (int ks = 0; ks < 2; ++ks) { const bf16x8 kp_ = pf(KKp, 72, 16 * a_, 32 * ks); RH[a_][0] = mf(kp_, sop[ks][0], RH[a_][0]); RH[a_][1] = mf(kp_, sop[ks][1], RH[a_][1]); }
                bf16x8 nsa[2];
                { volatile LAS unsigned* FLG = (volatile LAS unsigned*)(lds + OFF_FLG); while (*FLG != (unsigned)(c + 1)) __builtin_amdgcn_s_sleep(1); }
                asm volatile("" ::: "memory");
                { const u32x2* XCH = (const u32x2*)(lds + OFF_X); const bf16x4_ t0op = __builtin_bit_cast(bf16x4_, XCH[lane]), t1op = __builtin_bit_cast(bf16x4_, XCH[64 + lane]), l21n = o4n(L21T);
#pragma unroll
                  for (int cI = 0; cI < 2; ++cI) { const f32x4 sa0 = m16(t0op, o4(RH[0][cI]), z4); const f32x4 r2 = m16(l21n, o4(sa0), RH[1][cI]); const f32x4 sa1 = m16(t1op, o4(r2), z4);
                      *(u32x2*)(SAF + (32 * rb + 16 * cI + fr) * 40 + 4 * q) = (u32x2){pk2(sa0[0], sa0[1]), pk2(sa0[2], sa0[3])}; *(u32x2*)(SAF + (32 * rb + 16 * cI + fr) * 40 + 16 + 4 * q) = (u32x2){pk2(sa1[0], sa1[1]), pk2(sa1[2], sa1[3])}; nsa[cI] = op2n(sa0, sa1); } }
                { const bf16x8 vr0 = rf(VTp, 40, 32 * rb, 0), vr1 = rf(VTp, 40, 32 * rb + 16, 0);
#pragma unroll
                  for (int u = 0; u < 4; ++u) { const bf16x8 kt_ = rf(KTp, 40, 16 * u, 0), bt_ = pf(BTp, 40, 16 * u, 0); const f32x4 pc = *(const f32x4*)(PCV + 16 * u + 4 * q);
                      ST[u][0] = mf(bt_, nsa[0], mf(kt_, vr0, ST[u][0])) * pc; ST[u][1] = mf(bt_, nsa[1], mf(kt_, vr1, ST[u][1])) * pc; } }
            } else if (w == 2) {
                { const bf16_t* BBp = (const bf16_t*)(lds + OFF_B + (c % 3) * B_BYTES) + 2 * CH * 72; const bf16_t* KKp = (const bf16_t*)(lds + OFF_E + (c & 1) * E_BYTES);
                  const int fr = lane & 15, q = lane >> 4; const f32x4 z4 = {0.f, 0.f, 0.f, 0.f};
                  typedef short bf16x4_ __attribute__((ext_vector_type(4)));
                  auto m16 = [](bf16x4_ a_, bf16x4_ b_, f32x4 c_) -> f32x4 { return __builtin_amdgcn_mfma_f32_16x16x16bf16_1k(a_, b_, c_, 0, 0, 0); };
                  auto o4 = [](f32x4 x) -> bf16x4_ { const u32x2 v = {pk2(x[0], x[1]), pk2(x[2], x[3])}; return __builtin_bit_cast(bf16x4_, v); };
                  u32x2* XCH = (u32x2*)(lds + OFF_X);
#pragma unroll
                  for (int bl = 0; bl < 2; ++bl) {
                      const bf16x8 k0 = *(const bf16x8*)(KKp + (16 * bl + fr) * 72 + 8 * q), k1 = *(const bf16x8*)(KKp + (16 * bl + fr) * 72 + 32 + 8 * q), b0 = *(const bf16x8*)(BBp + (16 * bl + fr) * 72 + 8 * q), b1 = *(const bf16x8*)(BBp + (16 * bl + fr) * 72 + 32 + 8 * q);
                      f32x4 N = __builtin_amdgcn_mfma_f32_16x16x32_bf16(k1, b1, __builtin_amdgcn_mfma_f32_16x16x32_bf16(k0, b0, z4, 0, 0, 0), 0, 0, 0);
                      f32x4 NT = __builtin_amdgcn_mfma_f32_16x16x32_bf16(b1, k1, __builtin_amdgcn_mfma_f32_16x16x32_bf16(b0, k0, z4, 0, 0, 0), 0, 0, 0), PT;
#pragma unroll
                      for (int r = 0; r < 4; ++r) { N[r] = fr < 4 * q + r ? -N[r] : 0.f; NT[r] = 4 * q + r < fr ? -NT[r] : 0.f; PT[r] = NT[r] + (4 * q + r == fr ? 1.f : 0.f); }
                      const f32x4 N2 = m16(o4(NT), o4(N), z4), N2T = m16(o4(N), o4(NT), z4); PT = m16(o4(N2), o4(PT), PT);
                      const f32x4 N4 = m16(o4(N2T), o4(N2), z4), N4T = m16(o4(N2), o4(N2T), z4); PT = m16(o4(N4), o4(PT), PT);
                      const f32x4 N8 = m16(o4(N4T), o4(N4), z4); PT = m16(o4(N8), o4(PT), PT);
                      XCH[64 * bl + lane] = __builtin_bit_cast(u32x2, o4(PT)); }
                  asm volatile("s_waitcnt lgkmcnt(0)" ::: "memory");
                  if (lane == 0) *(volatile LAS unsigned*)(lds + OFF_FLG) = (unsigned)(c + 1); }
                if (c - 1 >= NCX) ycomp(c - 1, lane);
            } else {
                if (c + 1 < NCH) prep(c + 1, lane, w - 4);
            }
            __syncthreads();
        }
        __builtin_amdgcn_s_setprio(0);
        if (w == 2) ycomp(NCH - 1, tid0 & 63);
    }
}
__device__ __forceinline__ void phase_rwkv_final2(const bf16_t* __restrict__ RW, const bf16_t* __restrict__ Y0, const bf16_t* __restrict__ Y1, const float* __restrict__ a0, const bf16_t* __restrict__ A2T,
                                                  const bf16_t* __restrict__ G2T, const float* __restrict__ k_a, const float* __restrict__ r_k, const float* __restrict__ lnx_g, const float* __restrict__ lnx_b, bf16_t* __restrict__ O, unsigned char* lds, int bid, int nb) {
    const int tid0 = otid(), w = __builtin_amdgcn_readfirstlane(tid0 >> 6);
    bf16_t* const WA = (bf16_t*)lds;
    bf16_t* const WG = (bf16_t*)(lds + 18432);
    float* const CST = (float*)(lds + 18432 + 17408);
    bf16_t* const IM = (bf16_t*)(lds + 18432 + 17408 + 1536 + w * 11520);
    for (int item = bid; item < 512; item += nb) {
        int tid = tid0; asm volatile("" : "+v"(tid));
        const int lane = tid & 63, fr = lane & 15, fq = lane >> 4, lr = lane >> 3, lc = lane & 7;
        const int h = item & 7, strip = item >> 3;
        __syncthreads();
        for (int p = tid; p < 1024; p += 512) { const int rw_ = p >> 3, pc = p & 7; *(u32x4*)(WA + rw_ * 72 + 8 * pc) = *(const u32x4*)(A2T + ((size_t)((rw_ >> 6) * 512 + h * 64 + (rw_ & 63))) * 64 + 8 * pc); }
        for (int p = tid; p < 1024; p += 512) { const int rw_ = p >> 4, pc = p & 15; *(u32x4*)(WG + rw_ * 136 + 8 * pc) = *(const u32x4*)(G2T + ((size_t)(h * 64 + rw_)) * 128 + 8 * pc); }
        if (tid < 384) { const int g_ = tid >> 6, cch = h * 64 + (tid & 63); CST[tid] = g_ == 0 ? a0[cch] : g_ == 1 ? a0[512 + cch] : g_ == 2 ? k_a[cch] : g_ == 3 ? r_k[cch] : g_ == 4 ? lnx_g[cch] : lnx_b[cch]; }
        __syncthreads();
        const size_t row_strip = (size_t)strip * 512 + w * 64;
        struct TL { u32x4 r[2], k[2], v[2], y0[2], y1[2]; bf16x8 fa[2], fg[4]; };
        auto tload = [&](int mt, TL& L) { const size_t rowb = row_strip + 16 * mt;
#pragma unroll
            for (int g = 0; g < 2; ++g) { const size_t row = rowb + 8 * g + lr; const bf16_t* p0 = RW + row * RW_COLS + h * 64 + 8 * lc;
                L.r[g] = *(const u32x4*)(p0); L.k[g] = *(const u32x4*)(p0 + 512); L.v[g] = *(const u32x4*)(p0 + 1024); L.y0[g] = *(const u32x4*)(Y0 + row * RWD + h * 64 + 8 * lc); L.y1[g] = *(const u32x4*)(Y1 + row * RWD + h * 64 + 8 * lc); }
            const bf16_t* pa = RW + (rowb + fr) * RW_COLS;
#pragma unroll
            for (int ks = 0; ks < 2; ++ks) L.fa[ks] = *(const bf16x8*)(pa + 1600 + ks * 32 + fq * 8);
#pragma unroll
            for (int ks = 0; ks < 4; ++ks) L.fg[ks] = *(const bf16x8*)(pa + 1664 + ks * 32 + fq * 8);
            asm volatile("" ::: "memory"); };
        TL cur; tload(0, cur);
#pragma unroll
        for (int mt = 0; mt < 4; ++mt) {
            const size_t rowb = row_strip + 16 * mt;
            asm volatile("s_waitcnt lgkmcnt(0)" ::: "memory");
#pragma unroll
            for (int g = 0; g < 2; ++g) { const int lo = (8 * g + lr) * 72 + 8 * lc;
                *(u32x4*)(IM + lo) = cur.r[g]; *(u32x4*)(IM + 1152 + lo) = cur.k[g]; *(u32x4*)(IM + 2304 + lo) = cur.v[g]; *(u32x4*)(IM + 3456 + lo) = cur.y0[g]; *(u32x4*)(IM + 4608 + lo) = cur.y1[g]; }
            TL nxt; if (mt < 3) tload(mt + 1, nxt);
            asm volatile("s_waitcnt lgkmcnt(0)" ::: "memory");
            float bsum = 0.f, ysum = 0.f, ysq = 0.f; f32x4 yv[4];
#pragma unroll
            for (int nt = 0; nt < 4; ++nt) {
                const int cl = 16 * nt + 4 * fq, lo = fr * 72 + 16 * nt + 4 * fq; f32x4 aa0 = {0.f, 0.f, 0.f, 0.f}, aa1 = {0.f, 0.f, 0.f, 0.f};
#pragma unroll
                for (int ks = 0; ks < 2; ++ks) { const bf16x8 b0 = *(const bf16x8*)(WA + (16 * nt + fr) * 72 + ks * 32 + fq * 8), b1 = *(const bf16x8*)(WA + (64 + 16 * nt + fr) * 72 + ks * 32 + fq * 8);
                    aa0 = __builtin_amdgcn_mfma_f32_16x16x32_bf16(b0, cur.fa[ks], aa0, 0, 0, 0); aa1 = __builtin_amdgcn_mfma_f32_16x16x32_bf16(b1, cur.fa[ks], aa1, 0, 0, 0); }
                const f32x4 r = ld_bf16x4(IM + lo), k = ld_bf16x4(IM + 1152 + lo); yv[nt] = ld_bf16x4(IM + 3456 + lo) + ld_bf16x4(IM + 4608 + lo);
                const f32x4 a00 = *(const f32x4*)(CST + cl), a01 = *(const f32x4*)(CST + 64 + cl), ka = *(const f32x4*)(CST + 128 + cl), rk = *(const f32x4*)(CST + 192 + cl);
#pragma unroll
                for (int j = 0; j < 4; ++j) { const float av0 = fsigmoid(aa0[j] + a00[j]), av1 = fsigmoid(aa1[j] + a01[j]); const float ksum = k[j] * (2.f + (av0 + av1 - 2.f) * ka[j]); bsum += r[j] * ksum * rk[j]; ysum += yv[nt][j]; ysq += yv[nt][j] * yv[nt][j]; }
            }
            bsum += __shfl_xor(bsum, 16); bsum += __shfl_xor(bsum, 32); ysum += __shfl_xor(ysum, 16); ysum += __shfl_xor(ysum, 32); ysq += __shfl_xor(ysq, 16); ysq += __shfl_xor(ysq, 32);
            const float mean = ysum * (1.f / 64.f); const float var = fmaxf(ysq * (1.f / 64.f) - mean * mean, 0.f); const float rstd = rsqrtf(var + LNX_EPS);
#pragma unroll
            for (int nt = 0; nt < 4; ++nt) {
                const int cl = 16 * nt + 4 * fq, lo = fr * 72 + 16 * nt + 4 * fq; f32x4 gg = {0.f, 0.f, 0.f, 0.f};
#pragma unroll
                for (int ks = 0; ks < 4; ++ks) { const bf16x8 bg = *(const bf16x8*)(WG + (16 * nt + fr) * 136 + ks * 32 + fq * 8); gg = __builtin_amdgcn_mfma_f32_16x16x32_bf16(bg, cur.fg[ks], gg, 0, 0, 0); }
                const f32x4 v = ld_bf16x4(IM + 2304 + lo); const f32x4 lg = *(const f32x4*)(CST + 256 + cl), lb = *(const f32x4*)(CST + 320 + cl); f32x4 o;
#pragma unroll
                for (int j = 0; j < 4; ++j) o[j] = ((yv[nt][j] - mean) * rstd * lg[j] + lb[j] + bsum * v[j]) * gg[j];
                st_bf16x4(IM + lo, o);
            }
            asm volatile("s_waitcnt lgkmcnt(0)" ::: "memory");
#pragma unroll
            for (int g = 0; g < 2; ++g) { const size_t row = rowb + 8 * g + lr; *(u32x4*)(O + row * RWD + h * 64 + 8 * lc) = *(const u32x4*)(IM + (8 * g + lr) * 72 + 8 * lc); }
            cur = nxt;
        }
    }
}
__device__ __forceinline__ void phase_lru_final(const bf16_t* __restrict__ H0, const bf16_t* __restrict__ H1, const bf16_t* __restrict__ GB, bf16_t* __restrict__ HL, int bid, int nb) {
    const size_t n8 = (size_t)NLAT * LWD / 8, stride = (size_t)nb * 512;
    for (size_t i = (size_t)bid * 512 + otid(); i < n8; i += 4 * stride) { u32x4 a[4], c[4], g[4];
#pragma unroll
        for (int q = 0; q < 4; ++q) { const size_t k = i + q * stride; if (k < n8) { a[q] = ((const u32x4*)H0)[k]; c[q] = ((const u32x4*)H1)[k]; g[q] = ((const u32x4*)GB)[k]; } }
#pragma unroll
        for (int q = 0; q < 4; ++q) { const size_t k = i + q * stride; if (k < n8) { float fa[8], fc[8], fg[8]; unpack8(a[q], fa); unpack8(c[q], fc); unpack8(g[q], fg); u32x4 o;
            o.x = pk2((fa[0] + fc[0]) * fg[0], (fa[1] + fc[1]) * fg[1]); o.y = pk2((fa[2] + fc[2]) * fg[2], (fa[3] + fc[3]) * fg[3]); o.z = pk2((fa[4] + fc[4]) * fg[4], (fa[5] + fc[5]) * fg[5]); o.w = pk2((fa[6] + fc[6]) * fg[6], (fa[7] + fc[7]) * fg[7]);
            ((u32x4*)HL)[k] = o; } }
    }
}
template <int CTRL> __device__ __forceinline__ float dpp_max(float x) { return fmaxf(x, __builtin_bit_cast(float, __builtin_amdgcn_update_dpp(0, __builtin_bit_cast(int, x), CTRL, 0xF, 0xF, true))); }
__device__ __forceinline__ float max16(float x) { x = dpp_max<0xB1>(x); x = dpp_max<0x4E>(x); x = dpp_max<0x141>(x); x = dpp_max<0x140>(x); return x; }
__device__ __forceinline__ void phase_router(const float* __restrict__ XMID, const float* __restrict__ g2n, const float* __restrict__ MOD, const float* __restrict__ router, float* __restrict__ AFF, const float* __restrict__ SSQ, bf16_t* __restrict__ H2, unsigned char* lds, int bid, int nb) {
    const int tid = otid(), lane = tid & 63, w = __builtin_amdgcn_readfirstlane(tid >> 6), e = lane & 15, q = lane >> 4;
    float* IMG = (float*)(lds + w * 16640);
    for (int tile = bid * 8 + w; tile < NLAT / 16; tile += nb * 8) {
        const int row0 = tile * 16, b = row0 / T;
        float rstd; { const f32x4* sp_ = (const f32x4*)(SSQ + (size_t)(row0 + e) * 16); const f32x4 s0 = sp_[0], s1 = sp_[1], s2 = sp_[2], s3 = sp_[3];
            const float ssq = (((s0.x + s0.y) + (s0.z + s0.w)) + ((s1.x + s1.y) + (s1.z + s1.w))) + (((s2.x + s2.y) + (s2.z + s2.w)) + ((s3.x + s3.y) + (s3.z + s3.w))); rstd = rsqrtf(ssq * (1.f / D) + RMS_EPS); }
        const float* xr = XMID + (size_t)row0 * D + 4 * lane; const float* gp = g2n + 4 * lane; const float* scp = MOD + (size_t)b * 6144 + 4096 + 4 * lane; const float* shp = MOD + (size_t)b * 6144 + 3072 + 4 * lane; const float* rp = router + (4 * q) * 16 + e;
        bf16_t* hp = H2 + (size_t)row0 * D + 4 * lane;
        f32x4 acc = {0.f, 0.f, 0.f, 0.f};
#pragma unroll 1
        for (int kc = 0; kc < D; kc += 256) {
            f32x4 xq[16];
#pragma unroll
            for (int r = 0; r < 16; ++r) xq[r] = __builtin_nontemporal_load((const f32x4*)(xr + (size_t)r * D + kc));
            const f32x4 gv = *(const f32x4*)(gp + kc), sv = *(const f32x4*)(scp + kc), hv = *(const f32x4*)(shp + kc);
#pragma unroll
            for (int r = 0; r < 16; ++r) { const float rs = __builtin_bit_cast(float, __builtin_amdgcn_readlane(__builtin_bit_cast(int, rstd), r));
                const f32x4 av = (xq[r] * rs * gv) * (sv + 1.f) + hv;
                u32x2 o; o.x = pk2(av.x, av.y); o.y = pk2(av.z, av.w); *(u32x2*)(hp + (size_t)r * D + kc) = o;
                *(f32x4*)(IMG + r * 260 + 4 * lane) = av; }
            float rv[64];
#pragma unroll
            for (int u = 0; u < 16; ++u)
#pragma unroll
                for (int c = 0; c < 4; ++c) rv[4 * u + c] = rp[(kc + 16 * u + c) * 16];
            asm volatile("s_waitcnt lgkmcnt(0)" ::: "memory");
#pragma unroll
            for (int u = 0; u < 16; ++u) { const int kb = 16 * u; const f32x4 av = *(const f32x4*)(IMG + e * 260 + kb + 4 * q);
#pragma unroll
                for (int c = 0; c < 4; ++c) acc = __builtin_amdgcn_mfma_f32_16x16x4f32(av[c], rv[4 * u + c], acc, 0, 0, 0); }
            asm volatile("s_waitcnt lgkmcnt(0)" ::: "memory");
        }
#pragma unroll
        for (int r = 0; r < 4; ++r) { const int tok = 4 * q + r; const float lg = acc[r];
            const float mx = max16(lg); const float ex = __expf(lg - mx); const float sm = red16(ex);
            AFF[((size_t)b * NE + e) * T + (row0 & (T - 1)) + tok] = ex / sm; }
    }
}
__device__ __forceinline__ void phase_topk(const float* __restrict__ AFF, int* __restrict__ IDX, float* __restrict__ GATE, int* __restrict__ SLOT, unsigned char* lds, int bid, int nb) {
    unsigned* hist = (unsigned*)lds;
    unsigned* sel = (unsigned*)(lds + 1024);
    unsigned* wsum = (unsigned*)(lds + 1040);
    const int tid = otid(), lane = tid & 63, w = tid >> 6;
    for (int be = bid; be < NB * NE; be += nb) {
        const int b = be >> 4, e = be & 15;
        unsigned key[8];
        { const u32x4* src = (const u32x4*)(AFF + (size_t)be * T + tid * 8); const u32x4 v0 = src[0], v1 = src[1]; key[0] = v0.x; key[1] = v0.y; key[2] = v0.z; key[3] = v0.w; key[4] = v1.x; key[5] = v1.y; key[6] = v1.z; key[7] = v1.w; }
#pragma unroll
        for (int q = 0; q < 8; ++q) key[q] = (key[q] < 0x3FFFFFFFu ? key[q] : 0x3FFFFFFFu) << 2;
        unsigned prefix = 0u, kk = CAP;
#pragma unroll 1
        for (int pass = 0; pass < 4; ++pass) {
            const int shift = 24 - 8 * pass; const unsigned himask = pass == 0 ? 0u : (0xffffffffu << (shift + 8));
            __syncthreads();
            if (tid < 256) hist[tid] = 0u;
            __syncthreads();
#pragma unroll
            for (int q = 0; q < 8; ++q) if ((key[q] & himask) == prefix) atomicAdd(&hist[(key[q] >> shift) & 255u], 1u);
            __syncthreads();
            if (w == 0) {
                unsigned c[4]; unsigned tot = 0u;
#pragma unroll
                for (int j = 0; j < 4; ++j) { c[j] = hist[255 - 4 * lane - j]; tot += c[j]; }
                unsigned inc = tot;
#pragma unroll
                for (int o = 1; o < 64; o <<= 1) { const unsigned t = __shfl_up(inc, o); if (lane >= o) inc += t; }
                unsigned before = inc - tot;
#pragma unroll
                for (int j = 0; j < 4; ++j) { if (before < kk && kk <= before + c[j]) { sel[0] = (unsigned)(255 - 4 * lane - j); sel[1] = kk - before; } before += c[j]; }
            }
            __syncthreads();
            prefix |= sel[0] << shift; kk = sel[1];
        }
        unsigned ngt = 0u, neq = 0u;
#pragma unroll
        for (int q = 0; q < 8; ++q) { ngt += key[q] > prefix ? 1u : 0u; neq += key[q] == prefix ? 1u : 0u; }
        unsigned pk = (ngt << 16) | neq, inc = pk;
#pragma unroll
        for (int o = 1; o < 64; o <<= 1) { const unsigned t = __shfl_up(inc, o); if (lane >= o) inc += t; }
        __syncthreads();
        if (lane == 63) wsum[w] = inc;
        __syncthreads();
        unsigned base = 0u;
#pragma unroll
        for (int ww = 0; ww < 8; ++ww) if (ww < w) base += wsum[ww];
        unsigned ex = base + inc - pk; unsigned gt_before = ex >> 16, eq_before = ex & 0xffffu;
#pragma unroll
        for (int q = 0; q < 8; ++q) { const int i = tid * 8 + q; const bool isgt = key[q] > prefix, iseq = key[q] == prefix; const bool take = isgt || (iseq && eq_before < kk);
            const unsigned slot = gt_before + (eq_before < kk ? eq_before : kk);
            if (take) { IDX[(size_t)be * CAP + slot] = i; GATE[(size_t)be * CAP + slot] = __builtin_bit_cast(float, key[q] >> 2); }
            SLOT[((size_t)b * T + i) * NE + e] = take ? (int)slot : -1;
            gt_before += isgt ? 1u : 0u; eq_before += iseq ? 1u : 0u; }
    }
}
__device__ __forceinline__ void phase_final(const float* __restrict__ XMID, const bf16_t* __restrict__ YE, const int* __restrict__ SLOT, const float* __restrict__ MOD, const float* __restrict__ fg, float* __restrict__ out, int bid, int nb) {
    const int tid = otid(), lane = tid & 63, p = lane & 15, gq = bid * 32 + (tid >> 4), NGQ = nb * 32;
    for (int r = gq; r < NLAT; r += NGQ) {
        const int b = r / T; const float* mr = MOD + (size_t)b * 6144 + 5120;
        const int4 s0 = *(const int4*)(SLOT + (size_t)r * NE), s1 = *(const int4*)(SLOT + (size_t)r * NE + 4), s2 = *(const int4*)(SLOT + (size_t)r * NE + 8), s3 = *(const int4*)(SLOT + (size_t)r * NE + 12);
        const int sl[16] = {s0.x, s0.y, s0.z, s0.w, s1.x, s1.y, s1.z, s1.w, s2.x, s2.y, s2.z, s2.w, s3.x, s3.y, s3.z, s3.w};
        int ro[4] = {-1, -1, -1, -1}, n = 0, elast = -1;
#pragma unroll
        for (int e = 0; e < NE; ++e) { const bool v = sl[e] >= 0; const int row = (b * NE + e) * CAP + sl[e];
            ro[0] = (v && n == 0) ? row : ro[0]; ro[1] = (v && n == 1) ? row : ro[1]; ro[2] = (v && n == 2) ? row : ro[2]; ro[3] = (v && n == 3) ? row : ro[3]; elast = (v && n == 3) ? e : elast; n += v ? 1 : 0; }
        u32x2 ye[4][16];
#pragma unroll
        for (int k = 0; k < 4; ++k) { const u32x2 z = {0u, 0u};
#pragma unroll
            for (int j = 0; j < 16; ++j) ye[k][j] = z;
            if (ro[k] >= 0) { const u32x2* yr = (const u32x2*)(YE + (size_t)ro[k] * D) + p;
#pragma unroll
                for (int j = 0; j < 16; ++j) ye[k][j] = __builtin_nontemporal_load(&yr[16 * j]); } }
        asm volatile("" ::: "memory");
        f32x4 acc[16];
#pragma unroll
        for (int j = 0; j < 16; ++j) acc[j] = (f32x4){0.f, 0.f, 0.f, 0.f};
#pragma unroll
        for (int k = 0; k < 4; ++k)
#pragma unroll
            for (int j = 0; j < 16; ++j) { const u32x2 v = ye[k][j];
                acc[j] += (f32x4){__builtin_bit_cast(float, v.x << 16), __builtin_bit_cast(float, v.x & 0xffff0000u), __builtin_bit_cast(float, v.y << 16), __builtin_bit_cast(float, v.y & 0xffff0000u)}; }
        if (n > 4) {
#pragma unroll 1
            for (int e = 0; e < NE; ++e) if (e > elast && sl[e] >= 0) { const u32x2* yr = (const u32x2*)(YE + ((size_t)(b * NE + e) * CAP + sl[e]) * D) + p;
#pragma unroll
                for (int j = 0; j < 16; ++j) { const u32x2 v = yr[16 * j];
                    acc[j] += (f32x4){__builtin_bit_cast(float, v.x << 16), __builtin_bit_cast(float, v.x & 0xffff0000u), __builtin_bit_cast(float, v.y << 16), __builtin_bit_cast(float, v.y & 0xffff0000u)}; } } }
        float s = 0.f;
#pragma unroll
        for (int j = 0; j < 16; ++j) { const int f4 = p + 16 * j;
            acc[j] = __builtin_nontemporal_load(&((const f32x4*)(XMID + (size_t)r * D))[f4]) + ((const f32x4*)mr)[f4] * acc[j]; s += (acc[j].x * acc[j].x + acc[j].y * acc[j].y) + (acc[j].z * acc[j].z + acc[j].w * acc[j].w); }
        const float rstd = rsqrtf(red16(s) * (1.f / D) + RMS_EPS);
#pragma unroll
        for (int j = 0; j < 16; ++j) { const int f4 = p + 16 * j; ((f32x4*)(out + (size_t)r * D))[f4] = acc[j] * rstd * ((const f32x4*)fg)[f4]; }
    }
}

__device__ __forceinline__ void phase_wconv_moe_rest(const float* __restrict__ mw1, const float* __restrict__ mw3, const float* __restrict__ mw2, bf16_t* __restrict__ W13, bf16_t* __restrict__ W2, int t0, unsigned char* lds, int bid, int nb) {
    const int tid = otid(), lane = tid & 63, wv = tid >> 6, gw = bid * 8 + wv, NGW = nb * 8;
    u32x4* wl = (u32x4*)(lds + wv * 9216);
    for (int it = t0 + gw; it < 12288; it += NGW) {
        const int m = it >> 12, r = it & 4095, e = r >> 8, tt = r & 255, k0 = (tt >> 4) * 64, n0 = (tt & 15) * 64, rmul = m == 2 ? 128 : 256, radd = m == 1 ? 128 : 0;
        const float* src = (m == 0 ? mw1 : m == 1 ? mw3 : mw2) + (size_t)e * 1024 * 1024; bf16_t* dst = m == 2 ? W2 + (size_t)e * 1024 * 1024 : W13 + (size_t)e * 2048 * 1024;
        const float* sp = src + (size_t)k0 * 1024 + n0 + lane; float v[64];
#pragma unroll
        for (int i = 0; i < 64; ++i) v[i] = sp[(size_t)i * 1024];
#pragma unroll
        for (int c = 0; c < 8; ++c) { u32x4 o; o.x = pk2(v[8 * c], v[8 * c + 1]); o.y = pk2(v[8 * c + 2], v[8 * c + 3]); o.z = pk2(v[8 * c + 4], v[8 * c + 5]); o.w = pk2(v[8 * c + 6], v[8 * c + 7]); wl[lane * 9 + c] = o; }
        asm volatile("s_waitcnt lgkmcnt(0)" ::: "memory");
#pragma unroll
        for (int j = 0; j < 8; ++j) { const int n = (lane >> 3) + 8 * j, c = lane & 7; const u32x4 o = wl[n * 9 + c];
            const int nn = n0 + n, row = (nn >> 7) * rmul + (nn & 127) + radd; *(u32x4*)(dst + (size_t)row * 1024 + k0 + 8 * c) = o; }
        asm volatile("s_waitcnt lgkmcnt(0)" ::: "memory");
    }
}
constexpr int RING_BYTES = 131072, LDS_BYTES = 163840, MISC_OFF = LDS_BYTES - 256;
constexpr int CW_BAR = 4096;
constexpr size_t CTL_ZERO_BYTES = 65536;
__global__ __launch_bounds__(512, 2) void mega(Args a) {
    extern __shared__ __attribute__((aligned(16))) unsigned char lds[];
    const int bid = blockIdx.x, nb = gridDim.x, tid = threadIdx.x;
    unsigned char* ws = a.ws;
    const float* x = a.in[0]; const float* c = a.in[1]; const float* ctx = a.in[2]; const float* c_ctx = a.in[3]; const float* w_mod = a.in[4]; const float* b_mod = a.in[5];
    const float* norm1_g = a.in[6]; const float* norm2_g = a.in[7]; const float* w_in = a.in[8]; const float* mu = a.in[9]; const float* rw0 = a.in[10]; const float* rw2 = a.in[11];
    const float* ra0 = a.in[12]; const float* ra2 = a.in[13]; const float* rg2 = a.in[14]; const float* rkk = a.in[15]; const float* rka = a.in[16]; const float* rrk = a.in[17];
    const float* lnx_g = a.in[18]; const float* lnx_b = a.in[19]; const float* w_pr = a.in[20]; const float* conv_w = a.in[21]; const float* conv_b = a.in[22]; const float* lwa = a.in[23];
    const float* lba = a.in[24]; const float* lwx = a.in[25]; const float* lbx = a.in[26]; const float* llam = a.in[27]; const float* w_pl = a.in[28]; const float* w_out = a.in[29];
    const float* router = a.in[30]; const float* mw1 = a.in[31]; const float* mw3 = a.in[32]; const float* mw2 = a.in[33]; const float* final_g = a.in[34];
    float* MOD = (float*)(ws + WS_MOD); bf16_t* WIN = (bf16_t*)(ws + WS_WIN); bf16_t* WPR = (bf16_t*)(ws + WS_WPR); bf16_t* WPL = (bf16_t*)(ws + WS_WPL); bf16_t* WOUT = (bf16_t*)(ws + WS_WOUT);
    bf16_t* GT = (bf16_t*)(ws + WS_GT); float* XMID = (float*)(ws + WS_XMID); bf16_t* U = (bf16_t*)(ws + WS_U); float* Y = (float*)(ws + WS_Y); bf16_t* RW = (bf16_t*)(ws + WS_RW);
    bf16_t* MG = (bf16_t*)(ws + WS_MERGED); bf16_t* XB = (bf16_t*)(ws + WS_XB); bf16_t* GB = (bf16_t*)(ws + WS_GB); float* H = (float*)(ws + WS_H); bf16_t* O = (bf16_t*)(ws + WS_O); bf16_t* HL = (bf16_t*)(ws + WS_HL);
    bf16_t* W2 = (bf16_t*)a.out; bf16_t* W13 = (bf16_t*)((unsigned char*)a.out + 32 * MiB);
    bf16_t* const HLo = (bf16_t*)((unsigned char*)a.out + 96 * MiB);
     bf16_t* H2 = (bf16_t*)(ws + WS_H2); bf16_t* HID = (bf16_t*)(ws + WS_HID); bf16_t* YE = (bf16_t*)(ws + WS_YE); bf16_t* XS = (bf16_t*)(ws + WS_XS);
    bf16_t* W2T = (bf16_t*)(ws + WS_W2T); bf16_t* A2T = (bf16_t*)(ws + WS_A2T); bf16_t* WAT = (bf16_t*)(ws + WS_WAT); bf16_t* WXT = (bf16_t*)(ws + WS_WXT); bf16_t* G2T = (bf16_t*)(ws + WS_G2T); bf16_t* H0 = (bf16_t*)(ws + WS_H); bf16_t* H1 = (bf16_t*)(ws + WS_H + 32 * MiB); bf16_t* Y0 = (bf16_t*)(ws + WS_Y); bf16_t* Y1 = (bf16_t*)(ws + WS_Y + 32 * MiB);
    float* AFF = (float*)(ws + TAB_AFF); int* IDX = (int*)(ws + TAB_IDX); float* GATE = (float*)(ws + TAB_GATE); int* SLOT = (int*)(ws + TAB_SLOT); float* KN = (float*)(ws + TAB_RSTD); bf16_t* SIDE = (bf16_t*)(ws + TAB_SIDE); float* SSQ = (float*)(ws + TAB_SSQ);

    for (int u = tid; u < (LDS_BYTES - MISC_OFF) / 4; u += 512) ((LAS unsigned*)(lds + MISC_OFF))[u] = 0u;
    __syncthreads();
    const XcdBarrier bar = xcd_barrier_post((unsigned*)(ws + WS_CTL) + CW_BAR, (volatile LAS unsigned*)(lds + MISC_OFF) + 8);
    PG8_LAS unsigned char* ring = (PG8_LAS unsigned char*)lds;

#define PH(k) for (int rep_ = 0; rep_ < (PROBE == (k) ? 3 : 1); ++rep_)
    PH(0) {
    phase_modvec(c, c_ctx, w_mod, b_mod, MOD, lds, bid, nb);
    if (nb == 256) { if (bid >= 192) phase_wconv(w_in, WIN, 1024, IN_COLS, 4, 0, 1, 0, 0, lds, bid - 192, 64, 2816); }
    else phase_wconv(w_in, WIN, 1024, IN_COLS, 4, 0, 1, 0, 0, lds, bid, nb, 2816);
    { auto rot = [&](int off) { return (bid + nb - off % nb) % nb; };
    phase_wconv(rw2, W2T, 64, 512, 4, 0, 2, (size_t)64 * 512, (size_t)512 * 64, lds, rot(216), nb);
    phase_wconv(ra2, A2T, 64, 512, 4, 0, 2, (size_t)64 * 512, (size_t)512 * 64, lds, rot(218), nb);
    phase_wconv(lwa, WAT, 64, 64, 4, 0, 16, (size_t)64 * 64, (size_t)64 * 64, lds, rot(220), nb);
    phase_wconv(lwx, WXT, 64, 64, 4, 0, 16, (size_t)64 * 64, (size_t)64 * 64, lds, rot(222), nb); }
    xcd_barrier(bar); }
    PH(1) { phase_normmod(x, ctx, norm1_g, MOD, U, bid, nb); xcd_barrier(bar); }
    PH(2) { SWin S{U, WIN, nb, bid}; EWin E{RW, XB, GB, GT, SIDE}; pg8::gemm_phase<EWin, SWin, true>(ring, 1024, S, E); xcd_barrier(bar); }
    PH(16) { phase_mixB(RW, SIDE, mu, rkk, KN, bid, nb); xcd_barrier(bar); }
    PH(3) { const int hb = nb >> 1;
        if (bid < hb) phase_rwkv_full(RW, KN, Y0, Y1, rw0, W2T, ra0, A2T, rkk, rka, mw1, mw3, mw2, W13, W2, lds, bid, hb);
        else { phase_lru_seq(XB, H0, H1, conv_w, conv_b, WAT, lba, WXT, lbx, llam, GB, HLo, nb == 256, lds, bid - hb, nb - hb); __syncthreads(); phase_wconv_moe_rest(mw1, mw3, mw2, W13, W2, 128 * 68, lds, bid - hb, nb - hb);
            { const int lb = bid - hb, ln = nb - hb; auto rot = [&](int off) { return (lb + ln - off % ln) % ln; };
            phase_wconv(w_pr, WPR, 512, 1024, 4, 0, 1, 0, 0, lds, rot(64), ln); phase_wconv(w_pl, WPL, 512, 1024, 4, 0, 1, 0, 0, lds, rot(80), ln);
            phase_wconv(w_out, WOUT, 1024, 1024, 4, 0, 1, 0, 0, lds, rot(96), ln); phase_wconv(rg2, G2T, 128, 512, 4, 0, 1, 0, 0, lds, rot(0), ln); } }
        xcd_barrier(bar); }
    PH(5) { phase_rwkv_final2(RW, Y0, Y1, ra0, A2T, G2T, rka, rrk, lnx_g, lnx_b, O, lds, bid, nb); if (PROBE == 5) xcd_barrier(bar); }
    PH(14) { if (nb != 256) phase_lru_final(H0, H1, GB, HLo, bid, nb); xcd_barrier(bar); }
    PH(6) { SProj S{O, HLo, WPR, WPL, nb, bid}; EProj E{GT, MG}; pg8::gemm_phase<EProj, SProj, true>(ring, 512, S, E); xcd_barrier(bar); }
    PH(7) { SWout S{MG, WOUT, nb, bid}; EWout E{x, MOD, XMID, SSQ}; pg8::gemm_phase<EWout, SWout, true>(ring, 1024, S, E); xcd_barrier(bar); }
    PH(8) {
    if (PROBE == 8) xcd_barrier(bar); }
    PH(15) { phase_router(XMID, norm2_g, MOD, router, AFF, SSQ, H2, lds, bid, nb); xcd_barrier(bar); }
    PH(9) { phase_topk(AFF, IDX, GATE, SLOT, lds, bid, nb); xcd_barrier(bar); }
    PH(11) { SMoe1 S{H2, W13, IDX, nb, bid}; EMoe1 E{HID}; pg8::gemm_phase<EMoe1, SMoe1, true>(ring, 1024, S, E); xcd_barrier(bar); }
    PH(12) { SMoe2 S{HID, W2, nb, bid}; EMoe2 E{GATE, YE}; pg8::gemm_phase<EMoe2, SMoe2, true>(ring, 1024, S, E); xcd_barrier(bar); }
    PH(13) { phase_final(XMID, YE, SLOT, MOD, final_g, a.out, bid, nb); if (PROBE == 13) xcd_barrier(bar); }
#undef PH
}

extern "C" void kernel_launch(void* const* d_in, const int* in_sizes, int n_in, void* d_out, int out_size, void* d_ws, size_t ws_size, hipStream_t stream) {
    static int grid = 0;
    if (grid == 0) {
        if (n_in != 35 || ws_size < WS_END || out_size != NLAT * D) { fprintf(stderr, "kernel_launch: unexpected problem (n_in %d, ws %zu, out %d)\n", n_in, ws_size, out_size); grid = -1; return; }
        int dev = 0, cus = 0;
        if (hipGetDevice(&dev) != hipSuccess || hipDeviceGetAttribute(&cus, hipDeviceAttributeMultiprocessorCount, dev) != hipSuccess || cus <= 0) { fprintf(stderr, "kernel_launch: device query failed\n"); grid = -1; return; }
        if (hipFuncSetAttribute((const void*)mega, hipFuncAttributeMaxDynamicSharedMemorySize, LDS_BYTES) != hipSuccess) { fprintf(stderr, "kernel_launch: hipFuncSetAttribute failed\n"); grid = -1; return; }
        int per_cu = 0;
        if (hipOccupancyMaxActiveBlocksPerMultiprocessor(&per_cu, (const void*)mega, 512, LDS_BYTES) != hipSuccess || per_cu < 1) fprintf(stderr, "kernel_launch: occupancy query reports %d blocks per CU\n", per_cu);
        (void)hipGetLastError();
        grid = cus;
    }
    if (grid < 0) return;
    (void)hipMemsetAsync((char*)d_ws + WS_CTL, 0, CTL_ZERO_BYTES, stream);
    Args a{};
    for (int i = 0; i < 35; ++i) a.in[i] = (const float*)d_in[i];
    a.out = (float*)d_out; a.ws = (unsigned char*)d_ws;
    hipLaunchKernelGGL(mega, dim3(grid), dim3(512), LDS_BYTES, stream, a);
}
```
